# Optimizing an MI355X kernel written in HIP

```python
import jax, jax.numpy as jnp
from jax import lax
import numpy as np

D_MODEL = 1024
BATCH = 8
SEQ = 4096
DEPTH = 1

HEAD_DIM = 64
RET_HEADS = 8
SWA_Q_HEADS = 8
SWA_KV_HEADS = 2
SWA_GROUP = SWA_Q_HEADS // SWA_KV_HEADS
RET_WIDTH = RET_HEADS * HEAD_DIM
SWA_WIDTH = SWA_Q_HEADS * HEAD_DIM
KV_WIDTH = SWA_KV_HEADS * HEAD_DIM
MIX_WIDTH = RET_WIDTH + SWA_WIDTH
IN_WIDTH = 4 * RET_WIDTH + SWA_WIDTH + 2 * KV_WIDTH
CHUNK = 128
WINDOW = 128
RET_THETA = 10000.0
SWA_THETA = 500000.0
SWA_ROT_DIM = HEAD_DIM // 4
N_EXPERTS = 64
TOP_K = 8
N_GROUPS = 8
TOPK_GROUPS = 4
EXPERT_DIM = 256
SHARED_DIM = 256
ROUTED_SCALE = 2.5
PLE_DIM = 256
LN_EPS = 1e-5
GN_EPS = 1e-6
NEG_INF = -1e30
DEEPNORM_ALPHA = (2.0 * DEPTH) ** 0.25
DEEPNORM_BETA = (8.0 * DEPTH) ** -0.25

kernel_name = "hymba_retnet_swa_sink_moe_deepnorm"


def rope(x, rot_dim, theta):
    s = x.shape[1]
    half = rot_dim // 2
    inv_freq = theta ** (-jnp.arange(half, dtype=jnp.float32) / half)
    ang = jnp.arange(s, dtype=jnp.float32)[:, None] * inv_freq[None, :]
    cos = jnp.cos(ang)[None, :, None, :].astype(x.dtype)
    sin = jnp.sin(ang)[None, :, None, :].astype(x.dtype)
    x1, x2, rest = x[..., :half], x[..., half:rot_dim], x[..., rot_dim:]
    return jnp.concatenate([x1 * cos - x2 * sin, x2 * cos + x1 * sin, rest], axis=-1)


def layer_norm(x, g, b):
    xf = x.astype(jnp.float32)
    mu = jnp.mean(xf, axis=-1, keepdims=True)
    var = jnp.mean(jnp.square(xf - mu), axis=-1, keepdims=True)
    y = (xf - mu) * lax.rsqrt(var + LN_EPS)
    return (y * g.astype(jnp.float32) + b.astype(jnp.float32)).astype(x.dtype)


def head_group_norm(y, gain):
    yf = y.astype(jnp.float32)
    mu = jnp.mean(yf, axis=-1, keepdims=True)
    var = jnp.mean(jnp.square(yf - mu), axis=-1, keepdims=True)
    yn = ((yf - mu) * lax.rsqrt(var + GN_EPS)).astype(y.dtype)
    b, s, h, d = y.shape
    return yn.reshape(b, s, h * d) * gain


def retention_chunkwise(q, k, v):
    b, s, h, d = q.shape
    n = s // CHUNK
    k = k * (d ** -0.5)
    q, k, v = [t.reshape(b, n, CHUNK, h, d) for t in (q, k, v)]
    log_g = jnp.log1p(-(2.0 ** (-5.0 - jnp.arange(h, dtype=jnp.float32))))
    idx = jnp.arange(CHUNK, dtype=jnp.float32)
    diff = idx[:, None] - idx[None, :]
    intra_decay = jnp.where(diff[None] >= 0,
                            jnp.exp(jnp.maximum(diff, 0.0)[None] * log_g[:, None, None]), 0.0)
    scores = jnp.einsum('bnqhd,bnkhd->bnhqk', q, k) * intra_decay.astype(q.dtype)
    intra = jnp.einsum('bnhqk,bnkhd->bnqhd', scores, v)
    k_w = jnp.exp((CHUNK - 1 - idx)[:, None] * log_g[None, :]).astype(k.dtype)
    q_w = jnp.exp((idx + 1)[:, None] * log_g[None, :]).astype(q.dtype)
    chunk_decay = jnp.exp(CHUNK * log_g)
    kv = jnp.einsum('bnkhd,bnkhe->nbhde', k * k_w[:, :, None], v)

    def step(state, kv_n):
        return state * chunk_decay[None, :, None, None].astype(state.dtype) + kv_n, state

    _, states = lax.scan(step, jnp.zeros_like(kv[0]), kv)
    inter = jnp.einsum('bnqhd,nbhde->bnqhe', q * q_w[:, :, None], states)
    return (intra + inter).reshape(b, s, h, d)


def swa_with_sinks(q, k, v, sinks):
    b, s, hq, d = q.shape
    n = s // WINDOW
    c = WINDOW
    q = q.reshape(b, n, c, SWA_KV_HEADS, SWA_GROUP, d)

    def band(t):
        t = t.reshape(b, n, c, SWA_KV_HEADS, d)
        prev = jnp.concatenate([jnp.zeros_like(t[:, :1]), t[:, :-1]], axis=1)
        return jnp.concatenate([prev, t], axis=2)

    kb, vb = band(k), band(v)
    scores = jnp.einsum('bnqhgd,bnkhd->bhgnqk', q, kb).astype(jnp.float32) * (d ** -0.5)
    qi = jnp.arange(c)[:, None]
    kj = jnp.arange(2 * c)[None, :]
    rel = c + qi - kj
    blk = jnp.arange(n)[:, None, None]
    valid = (rel >= 0) & (rel < WINDOW) & (blk * c + kj - c >= 0)
    scores = jnp.where(valid, scores, NEG_INF)
    sink = jnp.broadcast_to(sinks.astype(jnp.float32).reshape(1, SWA_KV_HEADS, SWA_GROUP, 1, 1, 1),
                            scores.shape[:-1] + (1,))
    probs = jax.nn.softmax(jnp.concatenate([scores, sink], axis=-1), axis=-1)[..., :-1]
    out = jnp.einsum('bhgnqk,bnkhd->bnqhgd', probs.astype(v.dtype), vb)
    return out.reshape(b, s, hq * d)


def hybrid_mixer(x, w_in, ret_gn_gain, attn_scale, sinks, w_out):
    b, s, _ = x.shape
    proj = x @ w_in
    splits = [RET_WIDTH, 2 * RET_WIDTH, 3 * RET_WIDTH, 4 * RET_WIDTH,
              4 * RET_WIDTH + SWA_WIDTH, 4 * RET_WIDTH + SWA_WIDTH + KV_WIDTH]
    rq, rk, rv, rg, aq, ak, av = jnp.split(proj, splits, axis=-1)
    rq = rope(rq.reshape(b, s, RET_HEADS, HEAD_DIM), HEAD_DIM, RET_THETA)
    rk = rope(rk.reshape(b, s, RET_HEADS, HEAD_DIM), HEAD_DIM, RET_THETA)
    rv = rv.reshape(b, s, RET_HEADS, HEAD_DIM)
    ret = retention_chunkwise(rq, rk, rv)
    ret = jax.nn.silu(rg) * head_group_norm(ret, ret_gn_gain)
    aq = rope(aq.reshape(b, s, SWA_Q_HEADS, HEAD_DIM), SWA_ROT_DIM, SWA_THETA)
    ak = rope(ak.reshape(b, s, SWA_KV_HEADS, HEAD_DIM), SWA_ROT_DIM, SWA_THETA)
    av = av.reshape(b, s, SWA_KV_HEADS, HEAD_DIM)
    att = swa_with_sinks(aq, ak, av, sinks) * attn_scale
    return jnp.concatenate([ret, att], axis=-1) @ w_out


def moe_ffn(x, w_router, router_bias, w1, w3, w2, ws1, ws3, ws2):
    b, s, d = x.shape
    t = x.reshape(b * s, d)
    scores = jax.nn.sigmoid((t @ w_router).astype(jnp.float32))
    biased = scores + router_bias.astype(jnp.float32)
    grp = biased.reshape(-1, N_GROUPS, N_EXPERTS // N_GROUPS)
    grp_score = jnp.sum(lax.top_k(grp, 2)[0], axis=-1)
    _, top_grp = lax.top_k(grp_score, TOPK_GROUPS)
    grp_mask = jnp.sum(jax.nn.one_hot(top_grp, N_GROUPS, dtype=jnp.float32), axis=1) > 0
    expert_mask = jnp.repeat(grp_mask, N_EXPERTS // N_GROUPS, axis=1)
    _, idx = lax.top_k(jnp.where(expert_mask, biased, NEG_INF), TOP_K)
    w = jnp.take_along_axis(scores, idx, axis=1)
    w = w / jnp.sum(w, axis=-1, keepdims=True) * ROUTED_SCALE
    combine = jnp.sum(jax.nn.one_hot(idx, N_EXPERTS, dtype=jnp.float32) * w[..., None],
                      axis=1).astype(x.dtype)

    def expert_step(acc, params):
        e1, e3, e2, c = params
        h = jax.nn.silu(t @ e1) * (t @ e3)
        return acc + c[:, None] * (h @ e2), None

    routed, _ = lax.scan(expert_step, jnp.zeros_like(t), (w1, w3, w2, combine.T))
    shared = (jax.nn.silu(t @ ws1) * (t @ ws3)) @ ws2
    return (routed + shared).reshape(b, s, d)


def setup_inputs(seed: int = 0) -> dict:
    key = jax.random.key(seed)
    ks = jax.random.split(key, 24)
    L, D, E, F, SF = DEPTH, D_MODEL, N_EXPERTS, EXPERT_DIM, SHARED_DIM
    nrm = lambda k, shape, scale: jax.random.normal(k, shape, jnp.float32) * scale
    return {
        "x": nrm(ks[0], (BATCH, SEQ, D), 1.0),
        "p": nrm(ks[1], (L, BATCH, SEQ, PLE_DIM), 1.0),
        "w_in": nrm(ks[2], (L, D, IN_WIDTH), D ** -0.5),
        "ret_gn_gain": 1.0 + nrm(ks[3], (L, RET_WIDTH), 0.02),
        "attn_scale": 1.0 + nrm(ks[4], (L, SWA_WIDTH), 0.02),
        "sinks": nrm(ks[5], (L, SWA_Q_HEADS), 0.5),
        "w_out": nrm(ks[6], (L, MIX_WIDTH, D), MIX_WIDTH ** -0.5 * DEEPNORM_BETA),
        "ln1_g": 1.0 + nrm(ks[7], (L, D), 0.02),
        "ln1_b": nrm(ks[8], (L, D), 0.02),
        "w_router": nrm(ks[9], (L, D, E), D ** -0.5),
        "router_bias": nrm(ks[10], (L, E), 0.01),
        "w1": nrm(ks[11], (L, E, D, F), D ** -0.5),
        "w3": nrm(ks[12], (L, E, D, F), D ** -0.5),
        "w2": nrm(ks[13], (L, E, F, D), F ** -0.5 * DEEPNORM_BETA),
        "ws1": nrm(ks[14], (L, D, SF), D ** -0.5),
        "ws3": nrm(ks[15], (L, D, SF), D ** -0.5),
        "ws2": nrm(ks[16], (L, SF, D), SF ** -0.5 * DEEPNORM_BETA),
        "w_ple_gate": nrm(ks[17], (L, D, D), D ** -0.5),
        "b_ple_gate": nrm(ks[18], (L, D), 0.02),
        "w_ple_proj": nrm(ks[19], (L, PLE_DIM, D), PLE_DIM ** -0.5 * DEEPNORM_BETA),
        "ln2_g": 1.0 + nrm(ks[20], (L, D), 0.02),
        "ln2_b": nrm(ks[21], (L, D), 0.02),
    }


def reference(x, p, w_in, ret_gn_gain, attn_scale, sinks, w_out, ln1_g, ln1_b,
              w_router, router_bias, w1, w3, w2, ws1, ws3, ws2,
              w_ple_gate, b_ple_gate, w_ple_proj, ln2_g, ln2_b):
    h = x
    for i in range(DEPTH):
        mix = hybrid_mixer(h, w_in[i], ret_gn_gain[i], attn_scale[i], sinks[i], w_out[i])
        h = layer_norm(DEEPNORM_ALPHA * h + mix, ln1_g[i], ln1_b[i])
        ffn = moe_ffn(h, w_router[i], router_bias[i], w1[i], w3[i], w2[i], ws1[i], ws3[i], ws2[i])
        ple = jax.nn.sigmoid(h @ w_ple_gate[i] + b_ple_gate[i]) * (p[i] @ w_ple_proj[i])
        h = layer_norm(DEEPNORM_ALPHA * h + ffn + ple, ln2_g[i], ln2_b[i])
    return h
```

```cpp
#include <hip/hip_runtime.h>
#include <cstdio>
#include <cstdint>

#define LAS __attribute__((address_space(3)))
typedef unsigned short bf16;
typedef short bf16x8 __attribute__((ext_vector_type(8)));
typedef short bf16x4 __attribute__((ext_vector_type(4)));
typedef float f32x4 __attribute__((ext_vector_type(4)));
typedef unsigned u32x4 __attribute__((ext_vector_type(4)));
typedef unsigned u32x2 __attribute__((ext_vector_type(2)));

constexpr int D = 1024, BATCH = 8, SEQ = 4096, T = BATCH * SEQ;
constexpr int HD = 64, RH = 8, QH = 8, KVH = 2;
constexpr int INW = 2816;
constexpr int C_RQ = 0, C_RK = 512, C_RV = 1024, C_RG = 1536, C_AQ = 2048, C_AK = 2560, C_AV = 2688;
constexpr int CH = 128, NCH = SEQ / CH;
constexpr int SEGC = 8, NSEG = NCH / SEGC;
constexpr int NE = 64, TOPK = 8, EDIM = 256, SDIM = 256, PLE = 256;
constexpr float LN_EPS = 1e-5f, GN_EPS = 1e-6f;
constexpr float ALPHA = 1.189207115002721f;
constexpr float ROUTED_SCALE = 2.5f;
constexpr int NH = 4, TC = T / NH;
constexpr int RMAX = TC * TOPK + NE * 256;
constexpr int MAXTILES = RMAX / 256;
constexpr int NTHREADS = 512;

constexpr size_t MiB = 1u << 20;
constexpr size_t al(size_t x) { return (x + 255) & ~(size_t)255; }
constexpr size_t WS_CTL = 0, CTL_BYTES = 1 * MiB;
constexpr size_t WS_WINT = WS_CTL + CTL_BYTES;
constexpr size_t WS_WOUTT = WS_WINT + al((size_t)INW * D * 2);
constexpr size_t WS_W13T = WS_WOUTT + al((size_t)D * D * 2);
constexpr size_t WS_W2T = WS_W13T + al((size_t)NE * 512 * D * 2);
constexpr size_t WS_WS13T = WS_W2T + al((size_t)NE * D * EDIM * 2);
constexpr size_t WS_WS2T = WS_WS13T + al((size_t)512 * D * 2);
constexpr size_t WS_WGT = WS_WS2T + al((size_t)D * SDIM * 2);
constexpr size_t WS_WPT = WS_WGT + al((size_t)D * D * 2);
constexpr size_t WS_WRT = WS_WPT + al((size_t)D * PLE * 2);
constexpr size_t WS_TAB = WS_WRT + al((size_t)NE * D * 2);
constexpr size_t TAB_BYTES = (size_t)SEQ * (32 + 32 + 8 + 8) * 4;
constexpr size_t WS_SEGT = WS_TAB + al(TAB_BYTES);
constexpr size_t WS_ROUT = WS_SEGT + al((size_t)BATCH * RH * NSEG * 64 * 64 * 4);
constexpr size_t RO_RIDX = 0, RO_RW = RO_RIDX + (size_t)T * 8 * 4, RO_CNT = RO_RW + (size_t)T * 8 * 4, RO_STOK = RO_CNT + 256 * 64 * 4;
constexpr size_t RO_DEST = RO_STOK + (size_t)NH * RMAX * 4, RO_RSC = RO_DEST + (size_t)NH * RMAX * 4, RO_TILE = RO_RSC + (size_t)NH * RMAX * 4;
constexpr size_t RO_END = RO_TILE + (size_t)NH * 512 * 4;
constexpr size_t WS_XB = WS_ROUT + al(RO_END);
constexpr size_t WS_PB = WS_XB + al((size_t)T * D * 2);
constexpr size_t WS_BIG = WS_PB + al((size_t)T * PLE * 2);
constexpr size_t WS_MIXO = WS_BIG + al((size_t)T * INW * 2);
constexpr size_t WS_END1 = WS_MIXO + al((size_t)T * D * 2);
constexpr size_t WS_HS = WS_BIG;
constexpr size_t WS_PP = WS_HS + al((size_t)T * SDIM * 2);
constexpr size_t WS_HSORT = WS_PP + al((size_t)T * D * 2);
constexpr size_t WS_CONTRIB = WS_HSORT + al((size_t)RMAX * EDIM * 2);
constexpr size_t WS_END2 = WS_CONTRIB + al(((size_t)TC * 8 + 1) * D * 2);
constexpr size_t WS_NEED = WS_END1 > WS_END2 ? WS_END1 : WS_END2;
static_assert(WS_NEED <= 512 * MiB, "workspace map exceeds 512 MiB");

__device__ __forceinline__ float bf2f(unsigned v) { return __uint_as_float(v << 16); }
__device__ __forceinline__ unsigned cvt_pk_bf16(float lo, float hi) { unsigned r; asm volatile("v_cvt_pk_bf16_f32 %0, %1, %2" : "=v"(r) : "v"(lo), "v"(hi)); return r; }
__device__ __forceinline__ bf16 f2bf(float f) { return (bf16)(cvt_pk_bf16(f, 0.f) & 0xffffu); }
__device__ __forceinline__ float sigmoidf_(float x) { return 1.0f / (1.0f + __expf(-x)); }
__device__ __forceinline__ float siluf_(float x) { return x / (1.0f + __expf(-x)); }

struct Args {
    const float* in[22];
    float* out;
    unsigned char* ws;
    int ph_lo, ph_hi;
};
enum { I_X = 0, I_P, I_WIN, I_GN, I_ASC, I_SINK, I_WOUT, I_LN1G, I_LN1B, I_WR, I_RB, I_W1, I_W3, I_W2, I_WS1, I_WS3, I_WS2, I_WG, I_BG, I_WP, I_LN2G, I_LN2B };

__device__ __forceinline__ void transpose_tile(const float* __restrict__ src, int ld_src, int sc0, bf16* __restrict__ dst, int ld_dst, int dn0, int k0, LAS float* tile) {
    const int tid = threadIdx.x;
#pragma unroll
    for (int i = 0; i < 2; ++i) {
        const int q = tid + i * NTHREADS, r = q >> 4, c4 = (q & 15) * 4;
        const f32x4 v = *(const f32x4*)(src + (size_t)(k0 + r) * ld_src + sc0 + c4);
        tile[r * 65 + c4 + 0] = v[0]; tile[r * 65 + c4 + 1] = v[1]; tile[r * 65 + c4 + 2] = v[2]; tile[r * 65 + c4 + 3] = v[3];
    }
    __syncthreads();
    {
        const int n = tid >> 3, kc = (tid & 7) * 8;
        u32x4 w;
        w.x = cvt_pk_bf16(tile[(kc + 0) * 65 + n], tile[(kc + 1) * 65 + n]);
        w.y = cvt_pk_bf16(tile[(kc + 2) * 65 + n], tile[(kc + 3) * 65 + n]);
        w.z = cvt_pk_bf16(tile[(kc + 4) * 65 + n], tile[(kc + 5) * 65 + n]);
        w.w = cvt_pk_bf16(tile[(kc + 6) * 65 + n], tile[(kc + 7) * 65 + n]);
        *(u32x4*)(dst + (size_t)(dn0 + n) * ld_dst + k0 + kc) = w;
    }
    __syncthreads();
}
__device__ __forceinline__ void transpose_job(const float* src, int ld_src, int sc0, bf16* dst, int ld_dst, int dn0, int K, int N, int& tctr, int bid, int nb, LAS float* tile) {
    const int nk = K / 64, nn = N / 64;
    for (int t = 0; t < nk * nn; ++t, ++tctr) {
        if ((tctr % nb) != bid) continue;
        const int kt = t % nk, nt = t / nk;
        transpose_tile(src, ld_src, sc0 + nt * 64, dst, ld_dst, dn0 + nt * 64, kt * 64, tile);
    }
}

__device__ void phase_prologue(const Args& a, LAS unsigned char* lds, int bid, int nb) {
    LAS float* tile = (LAS float*)lds;
    unsigned char* ws = a.ws;
    const int tid = threadIdx.x;
    {
        const int ntile = NE * 8 * 16;
        for (int t = bid; t < ntile; t += nb) {
            const int e = t / 128, rem = t % 128, db = rem / 16, kt = rem % 16;
            const int piece = db >> 1, which = piece & 1, pn = piece >> 1, sc0 = pn * 128 + (db & 1) * 64;
            const float* src = (which ? a.in[I_W3] : a.in[I_W1]) + (size_t)e * D * EDIM;
            transpose_tile(src, EDIM, sc0, (bf16*)(ws + WS_W13T) + (size_t)e * 512 * D, D, db * 64, kt * 64, tile);
        }
    }
    {
        const int ntile = NE * 16 * 4;
        for (int t = bid; t < ntile; t += nb) {
            const int e = t / 64, rem = t % 64, nt = rem / 4, kt = rem % 4;
            transpose_tile(a.in[I_W2] + (size_t)e * EDIM * D, D, nt * 64, (bf16*)(ws + WS_W2T) + (size_t)e * D * EDIM, EDIM, nt * 64, kt * 64, tile);
        }
    }
    int tctr = 0;
    transpose_job(a.in[I_WIN], INW, 0, (bf16*)(ws + WS_WINT), D, 0, D, INW, tctr, bid, nb, tile);
    transpose_job(a.in[I_WOUT], D, 0, (bf16*)(ws + WS_WOUTT), D, 0, D, D, tctr, bid, nb, tile);
    for (int pn = 0; pn < 2; ++pn) {
        transpose_job(a.in[I_WS1], SDIM, pn * 128, (bf16*)(ws + WS_WS13T), D, pn * 256, D, 128, tctr, bid, nb, tile);
        transpose_job(a.in[I_WS3], SDIM, pn * 128, (bf16*)(ws + WS_WS13T), D, pn * 256 + 128, D, 128, tctr, bid, nb, tile);
    }
    transpose_job(a.in[I_WS2], D, 0, (bf16*)(ws + WS_WS2T), SDIM, 0, SDIM, D, tctr, bid, nb, tile);
    transpose_job(a.in[I_WG], D, 0, (bf16*)(ws + WS_WGT), D, 0, D, D, tctr, bid, nb, tile);
    transpose_job(a.in[I_WP], D, 0, (bf16*)(ws + WS_WPT), PLE, 0, PLE, D, tctr, bid, nb, tile);
    transpose_job(a.in[I_WR], NE, 0, (bf16*)(ws + WS_WRT), D, 0, D, NE, tctr, bid, nb, tile);
    {
        const size_t n8 = (size_t)T * D / 8;
        const float* x = a.in[I_X]; bf16* xb = (bf16*)(ws + WS_XB);
        for (size_t i = (size_t)bid * NTHREADS + tid; i < n8; i += (size_t)nb * NTHREADS) {
            const f32x4 v0 = *(const f32x4*)(x + i * 8), v1 = *(const f32x4*)(x + i * 8 + 4);
            u32x4 w; w.x = cvt_pk_bf16(v0[0], v0[1]); w.y = cvt_pk_bf16(v0[2], v0[3]); w.z = cvt_pk_bf16(v1[0], v1[1]); w.w = cvt_pk_bf16(v1[2], v1[3]);
            *(u32x4*)(xb + i * 8) = w;
        }
        const size_t m8 = (size_t)T * PLE / 8;
        const float* p = a.in[I_P]; bf16* pb = (bf16*)(ws + WS_PB);
        for (size_t i = (size_t)bid * NTHREADS + tid; i < m8; i += (size_t)nb * NTHREADS) {
            const f32x4 v0 = *(const f32x4*)(p + i * 8), v1 = *(const f32x4*)(p + i * 8 + 4);
            u32x4 w; w.x = cvt_pk_bf16(v0[0], v0[1]); w.y = cvt_pk_bf16(v0[2], v0[3]); w.z = cvt_pk_bf16(v1[0], v1[1]); w.w = cvt_pk_bf16(v1[2], v1[3]);
            *(u32x4*)(pb + i * 8) = w;
        }
    }
    {
        float* tab = (float*)(ws + WS_TAB);
        float* cosr = tab, *sinr = tab + SEQ * 32, *coss = tab + SEQ * 64, *sins = tab + SEQ * 72;
        for (int i = bid * NTHREADS + tid; i < SEQ * 40; i += nb * NTHREADS) {
            const int s = i / 40, j = i % 40;
            if (j < 32) {
                const float inv = (float)pow(10000.0, -(double)j / 32.0);
                const float ang = (float)s * inv;
                cosr[s * 32 + j] = (float)cos((double)ang); sinr[s * 32 + j] = (float)sin((double)ang);
            } else {
                const int jj = j - 32;
                const float inv = (float)pow(500000.0, -(double)jj / 8.0);
                const float ang = (float)s * inv;
                coss[s * 8 + jj] = (float)cos((double)ang); sins[s * 8 + jj] = (float)sin((double)ang);
            }
        }
    }
}

__device__ __forceinline__ int perm32(int rho) { const int n = rho >> 4, i = rho & 15; return 8 * (i >> 2) + 4 * n + (i & 3); }

struct GemmPart { const bf16* A; int lda; const int* rowidx; long arow0; const bf16* Bt; int ldb; int K; };

__device__ __forceinline__ void gemm_part(f32x4 (&acc)[2][2][4][2], const GemmPart& g, int wr, int wc, int fr, int fq) {
    unsigned oa[2][4], ob[2][2];
#pragma unroll
    for (int ai = 0; ai < 2; ++ai)
#pragma unroll
        for (int m = 0; m < 4; ++m) {
            const int r = 128 * ai + 64 * wr + 16 * m + fr;
            const long gr = g.rowidx ? (long)g.rowidx[r] : g.arow0 + r;
            oa[ai][m] = (unsigned)((gr * g.lda + 8 * fq) * 2);
        }
#pragma unroll
    for (int bj = 0; bj < 2; ++bj)
#pragma unroll
        for (int n = 0; n < 2; ++n) {
            const int rb = 128 * bj + 32 * wc + perm32(16 * n + fr);
            ob[bj][n] = (unsigned)((rb * g.ldb + 8 * fq) * 2);
        }
    const char* pA = (const char*)g.A; const char* pB = (const char*)g.Bt;
#pragma unroll 1
    for (int k0 = 0; k0 < g.K; k0 += 32) {
        bf16x8 af[2][4], bfr[2][2];
#pragma unroll
        for (int ai = 0; ai < 2; ++ai)
#pragma unroll
            for (int m = 0; m < 4; ++m) af[ai][m] = *(const bf16x8*)(pA + oa[ai][m]);
#pragma unroll
        for (int bj = 0; bj < 2; ++bj)
#pragma unroll
            for (int n = 0; n < 2; ++n) bfr[bj][n] = *(const bf16x8*)(pB + ob[bj][n]);
#pragma unroll
        for (int ai = 0; ai < 2; ++ai)
#pragma unroll
            for (int bj = 0; bj < 2; ++bj)
#pragma unroll
                for (int m = 0; m < 4; ++m)
#pragma unroll
                    for (int n = 0; n < 2; ++n)
                        acc[ai][bj][m][n] = __builtin_amdgcn_mfma_f32_16x16x32_bf16(bfr[bj][n], af[ai][m], acc[ai][bj][m][n], 0, 0, 0);
        pA += 64; pB += 64;
    }
}
__device__ __forceinline__ void zero_acc(f32x4 (&acc)[2][2][4][2]) {
#pragma unroll
    for (int a = 0; a < 2; ++a)
#pragma unroll
        for (int b = 0; b < 2; ++b)
#pragma unroll
            for (int m = 0; m < 4; ++m)
#pragma unroll
                for (int n = 0; n < 2; ++n) acc[a][b][m][n] = (f32x4){0.f, 0.f, 0.f, 0.f};
}
#define WAVE_IDS() const int tid = threadIdx.x, wid = __builtin_amdgcn_readfirstlane(tid >> 6), lane = tid & 63, wr = wid >> 2, wc = wid & 3, fr = lane & 15, fq = lane >> 4; (void)lane; (void)wr; (void)wc; (void)fr; (void)fq

__device__ __forceinline__ void epi_bf16(const f32x4 (&acc)[2][2][4][2], bf16* O, int ldo, long row0, int col0, int wr, int wc, int fr, int fq) {
#pragma unroll
    for (int ai = 0; ai < 2; ++ai)
#pragma unroll
        for (int m = 0; m < 4; ++m) {
            bf16* rp = O + (size_t)(row0 + 128 * ai + 64 * wr + 16 * m + fr) * ldo + col0 + 32 * wc + 8 * fq;
#pragma unroll
            for (int bj = 0; bj < 2; ++bj) {
                const f32x4 v0 = acc[ai][bj][m][0], v1 = acc[ai][bj][m][1];
                u32x4 w; w.x = cvt_pk_bf16(v0[0], v0[1]); w.y = cvt_pk_bf16(v0[2], v0[3]); w.z = cvt_pk_bf16(v1[0], v1[1]); w.w = cvt_pk_bf16(v1[2], v1[3]);
                *(u32x4*)(rp + 128 * bj) = w;
            }
        }
}
__device__ __forceinline__ void epi_gate(const f32x4 (&acc)[2][2][4][2], bf16* O, int ldo, long row0, int col0, int wr, int wc, int fr, int fq) {
#pragma unroll
    for (int ai = 0; ai < 2; ++ai)
#pragma unroll
        for (int m = 0; m < 4; ++m) {
            bf16* rp = O + (size_t)(row0 + 128 * ai + 64 * wr + 16 * m + fr) * ldo + col0 + 32 * wc + 8 * fq;
            float h[8];
#pragma unroll
            for (int n = 0; n < 2; ++n)
#pragma unroll
                for (int j = 0; j < 4; ++j) h[4 * n + j] = siluf_(acc[ai][0][m][n][j]) * acc[ai][1][m][n][j];
            u32x4 w; w.x = cvt_pk_bf16(h[0], h[1]); w.y = cvt_pk_bf16(h[2], h[3]); w.z = cvt_pk_bf16(h[4], h[5]); w.w = cvt_pk_bf16(h[6], h[7]);
            *(u32x4*)rp = w;
        }
}

__device__ void phase_proj(const Args& a, int bid, int nb) {
    WAVE_IDS();
    const bf16* xb = (const bf16*)(a.ws + WS_XB); const bf16* wt = (const bf16*)(a.ws + WS_WINT); bf16* proj = (bf16*)(a.ws + WS_BIG);
    const int nN = INW / 256, nU = (T / 256) * nN;
    for (int u = bid; u < nU; u += nb) {
        const int pm = u / nN, pn = u % nN;
        f32x4 acc[2][2][4][2]; zero_acc(acc);
        GemmPart g{xb, D, nullptr, (long)pm * 256, wt + (size_t)pn * 256 * D, D, D};
        gemm_part(acc, g, wr, wc, fr, fq);
        epi_bf16(acc, proj, INW, (long)pm * 256, pn * 256, wr, wc, fr, fq);
    }
}

constexpr int QS = 72;
constexpr int TS = 136;
constexpr int TS2 = 264;
constexpr int L_QS = 0;
constexpr int L_KS = L_QS + 128 * QS * 2;
constexpr int L_KTW = L_KS + 256 * QS * 2;
constexpr int L_VT = L_KTW + 64 * TS * 2;
constexpr int L_ST = L_VT + 64 * TS2 * 2;
constexpr int L_MIX_END = L_ST + 64 * QS * 2;
static_assert(L_MIX_END <= 128 * 1024, "mixer LDS");

__device__ __forceinline__ void stage_ret(const Args& a, LAS unsigned char* lds, int b, int h, int n, bool want_q, float l2g) {
    const int tid = threadIdx.x;
    const bf16* proj = (const bf16*)(a.ws + WS_BIG);
    const float* tab = (const float*)(a.ws + WS_TAB);
    const float* cosr = tab, *sinr = tab + SEQ * 32;
    LAS bf16* Qs = (LAS bf16*)(lds + L_QS); LAS bf16* Ks = (LAS bf16*)(lds + L_KS); LAS bf16* Ktw = (LAS bf16*)(lds + L_KTW); LAS bf16* Vt = (LAS bf16*)(lds + L_VT);
    const int row = tid >> 2, i0 = (tid & 3) * 8;
    const int pos = n * CH + row;
    const size_t t = (size_t)b * SEQ + pos;
    const bf16* prow = proj + t * INW;
    f32x4 c0 = *(const f32x4*)(cosr + pos * 32 + i0), c1 = *(const f32x4*)(cosr + pos * 32 + i0 + 4);
    f32x4 s0 = *(const f32x4*)(sinr + pos * 32 + i0), s1 = *(const f32x4*)(sinr + pos * 32 + i0 + 4);
    float cs[8] = {c0[0], c0[1], c0[2], c0[3], c1[0], c1[1], c1[2], c1[3]}, sn[8] = {s0[0], s0[1], s0[2], s0[3], s1[0], s1[1], s1[2], s1[3]};
    if (want_q) {
        const bf16x8 x1 = *(const bf16x8*)(prow + C_RQ + h * 64 + i0), x2 = *(const bf16x8*)(prow + C_RQ + h * 64 + 32 + i0);
        float o1[8], o2[8];
#pragma unroll
        for (int j = 0; j < 8; ++j) { const float a1 = bf2f((unsigned short)x1[j]), a2 = bf2f((unsigned short)x2[j]); o1[j] = a1 * cs[j] - a2 * sn[j]; o2[j] = a2 * cs[j] + a1 * sn[j]; }
        u32x4 w1, w2;
        w1.x = cvt_pk_bf16(o1[0], o1[1]); w1.y = cvt_pk_bf16(o1[2], o1[3]); w1.z = cvt_pk_bf16(o1[4], o1[5]); w1.w = cvt_pk_bf16(o1[6], o1[7]);
        w2.x = cvt_pk_bf16(o2[0], o2[1]); w2.y = cvt_pk_bf16(o2[2], o2[3]); w2.z = cvt_pk_bf16(o2[4], o2[5]); w2.w = cvt_pk_bf16(o2[6], o2[7]);
        *(LAS u32x4*)(Qs + row * QS + i0) = w1; *(LAS u32x4*)(Qs + row * QS + 32 + i0) = w2;
    }
    {
        const bf16x8 x1 = *(const bf16x8*)(prow + C_RK + h * 64 + i0), x2 = *(const bf16x8*)(prow + C_RK + h * 64 + 32 + i0);
        const float kw = exp2f((float)(CH - 1 - row) * l2g);
        float o1[8], o2[8];
#pragma unroll
        for (int j = 0; j < 8; ++j) { const float a1 = bf2f((unsigned short)x1[j]), a2 = bf2f((unsigned short)x2[j]); o1[j] = (a1 * cs[j] - a2 * sn[j]) * 0.125f; o2[j] = (a2 * cs[j] + a1 * sn[j]) * 0.125f; }
        if (want_q) {
            u32x4 w1, w2;
            w1.x = cvt_pk_bf16(o1[0], o1[1]); w1.y = cvt_pk_bf16(o1[2], o1[3]); w1.z = cvt_pk_bf16(o1[4], o1[5]); w1.w = cvt_pk_bf16(o1[6], o1[7]);
            w2.x = cvt_pk_bf16(o2[0], o2[1]); w2.y = cvt_pk_bf16(o2[2], o2[3]); w2.z = cvt_pk_bf16(o2[4], o2[5]); w2.w = cvt_pk_bf16(o2[6], o2[7]);
            *(LAS u32x4*)(Ks + row * QS + i0) = w1; *(LAS u32x4*)(Ks + row * QS + 32 + i0) = w2;
        }
#pragma unroll
        for (int j = 0; j < 8; ++j) { Ktw[(i0 + j) * TS + row] = f2bf(o1[j] * kw); Ktw[(32 + i0 + j) * TS + row] = f2bf(o2[j] * kw); }
    }
    {
        const bf16x8 v1 = *(const bf16x8*)(prow + C_RV + h * 64 + i0), v2 = *(const bf16x8*)(prow + C_RV + h * 64 + 32 + i0);
#pragma unroll
        for (int j = 0; j < 8; ++j) { Vt[(i0 + j) * TS2 + row] = (bf16)v1[j]; Vt[(32 + i0 + j) * TS2 + row] = (bf16)v2[j]; }
    }
}
__device__ __forceinline__ void ret_kv(LAS unsigned char* lds, int wid, int fr, int fq, f32x4 (&kv)[2]) {
    LAS bf16* Ktw = (LAS bf16*)(lds + L_KTW); LAS bf16* Vt = (LAS bf16*)(lds + L_VT);
#pragma unroll
    for (int i = 0; i < 2; ++i) {
        const int tl = 2 * wid + i, dt = tl >> 2, et = tl & 3;
        f32x4 c = {0.f, 0.f, 0.f, 0.f};
#pragma unroll
        for (int ks = 0; ks < 4; ++ks) {
            const bf16x8 kf = *(const LAS bf16x8*)(Ktw + (16 * dt + fr) * TS + 32 * ks + 8 * fq);
            const bf16x8 vf = *(const LAS bf16x8*)(Vt + (16 * et + fr) * TS2 + 32 * ks + 8 * fq);
            c = __builtin_amdgcn_mfma_f32_16x16x32_bf16(kf, vf, c, 0, 0, 0);
        }
        kv[i] = c;
    }
}
__device__ __forceinline__ float head_l2g(int h) { return log2f(1.0f - exp2f(-5.0f - (float)h)); }

__device__ void phase_segtot(const Args& a, LAS unsigned char* lds, int bid, int nb) {
    WAVE_IDS();
    float* segt = (float*)(a.ws + WS_SEGT);
    for (int it = bid; it < BATCH * RH * NSEG; it += nb) {
        const int seg = it % NSEG, h = (it / NSEG) % RH, b = it / (NSEG * RH);
        const float l2g = head_l2g(h), cd = exp2f(128.0f * l2g);
        f32x4 S[2] = {{0.f, 0.f, 0.f, 0.f}, {0.f, 0.f, 0.f, 0.f}};
        for (int c = 0; c < SEGC; ++c) {
            __syncthreads();
            stage_ret(a, lds, b, h, seg * SEGC + c, false, l2g);
            __syncthreads();
            f32x4 kv[2]; ret_kv(lds, wid, fr, fq, kv);
            S[0] = S[0] * cd + kv[0]; S[1] = S[1] * cd + kv[1];
        }
        float* dst = segt + (size_t)((b * RH + h) * NSEG + seg) * 4096;
#pragma unroll
        for (int i = 0; i < 2; ++i) { const int tl = 2 * wid + i, dt = tl >> 2, et = tl & 3;
#pragma unroll
            for (int j = 0; j < 4; ++j) dst[(16 * dt + 4 * fq + j) * 64 + 16 * et + fr] = S[i][j]; }
    }
}

__device__ void phase_retention(const Args& a, LAS unsigned char* lds, int bid, int nb) {
    WAVE_IDS();
    const float* segt = (const float*)(a.ws + WS_SEGT);
    const bf16* proj = (const bf16*)(a.ws + WS_BIG);
    bf16* mixo = (bf16*)(a.ws + WS_MIXO);
    const float* gain = a.in[I_GN];
    LAS bf16* Qs = (LAS bf16*)(lds + L_QS); LAS bf16* Ks = (LAS bf16*)(lds + L_KS); LAS bf16* Vt = (LAS bf16*)(lds + L_VT); LAS bf16* St = (LAS bf16*)(lds + L_ST);
    for (int it = bid; it < BATCH * RH * NSEG; it += nb) {
        const int seg = it % NSEG, h = (it / NSEG) % RH, b = it / (NSEG * RH);
        const float l2g = head_l2g(h), cd = exp2f(128.0f * l2g);
        f32x4 S[2] = {{0.f, 0.f, 0.f, 0.f}, {0.f, 0.f, 0.f, 0.f}};
        for (int sp = 0; sp < seg; ++sp) {
            const float wgt = exp2f(128.0f * l2g * (float)(SEGC * (seg - 1 - sp)));
            const float* src = segt + (size_t)((b * RH + h) * NSEG + sp) * 4096;
#pragma unroll
            for (int i = 0; i < 2; ++i) { const int tl = 2 * wid + i, dt = tl >> 2, et = tl & 3;
#pragma unroll
                for (int j = 0; j < 4; ++j) S[i][j] += wgt * src[(16 * dt + 4 * fq + j) * 64 + 16 * et + fr]; }
        }
        for (int c = 0; c < SEGC; ++c) {
            const int n = seg * SEGC + c;
            __syncthreads();
            stage_ret(a, lds, b, h, n, true, l2g);
#pragma unroll
            for (int i = 0; i < 2; ++i) { const int tl = 2 * wid + i, dt = tl >> 2, et = tl & 3;
                u32x2 w; w.x = cvt_pk_bf16(S[i][0], S[i][1]); w.y = cvt_pk_bf16(S[i][2], S[i][3]);
                *(LAS u32x2*)(St + (16 * et + fr) * QS + 16 * dt + 4 * fq) = w; }
            __syncthreads();
            bf16x8 qf[2];
#pragma unroll
            for (int ks = 0; ks < 2; ++ks) qf[ks] = *(const LAS bf16x8*)(Qs + (16 * wid + fr) * QS + 32 * ks + 8 * fq);
            f32x4 sc[8];
#pragma unroll
            for (int jt = 0; jt < 8; ++jt) {
                sc[jt] = (f32x4){0.f, 0.f, 0.f, 0.f};
                if (jt <= wid) {
#pragma unroll
                    for (int ks = 0; ks < 2; ++ks) {
                        const bf16x8 kf = *(const LAS bf16x8*)(Ks + (16 * jt + fr) * QS + 32 * ks + 8 * fq);
                        sc[jt] = __builtin_amdgcn_mfma_f32_16x16x32_bf16(kf, qf[ks], sc[jt], 0, 0, 0);
                    }
                    const int i = 16 * wid + fr;
#pragma unroll
                    for (int r = 0; r < 4; ++r) { const int j = 16 * jt + 4 * fq + r; const float dcy = exp2f((float)(i - j) * l2g); sc[jt][r] = (i >= j) ? sc[jt][r] * dcy : 0.f; }
                    asm volatile("" : "+v"(sc[jt]) :: "memory");
                }
            }
            f32x4 o[4], oi[4];
#pragma unroll
            for (int et = 0; et < 4; ++et) { o[et] = (f32x4){0.f, 0.f, 0.f, 0.f}; oi[et] = (f32x4){0.f, 0.f, 0.f, 0.f}; }
#pragma unroll
            for (int k2 = 0; k2 < 4; ++k2) {
                if (2 * k2 <= wid) {
                    bf16x8 pf; u32x4 pw;
                    pw.x = cvt_pk_bf16(sc[2 * k2][0], sc[2 * k2][1]); pw.y = cvt_pk_bf16(sc[2 * k2][2], sc[2 * k2][3]);
                    pw.z = cvt_pk_bf16(sc[2 * k2 + 1][0], sc[2 * k2 + 1][1]); pw.w = cvt_pk_bf16(sc[2 * k2 + 1][2], sc[2 * k2 + 1][3]);
                    pf = __builtin_bit_cast(bf16x8, pw);
#pragma unroll
                    for (int et = 0; et < 4; ++et) {
                        const u32x2 va = *(const LAS u32x2*)(Vt + (16 * et + fr) * TS2 + 32 * k2 + 4 * fq);
                        const u32x2 vb = *(const LAS u32x2*)(Vt + (16 * et + fr) * TS2 + 32 * k2 + 16 + 4 * fq);
                        u32x4 vw; vw.x = va.x; vw.y = va.y; vw.z = vb.x; vw.w = vb.y;
                        o[et] = __builtin_amdgcn_mfma_f32_16x16x32_bf16(__builtin_bit_cast(bf16x8, vw), pf, o[et], 0, 0, 0);
                    }
                }
            }
#pragma unroll
            for (int et = 0; et < 4; ++et)
#pragma unroll
                for (int ks = 0; ks < 2; ++ks) {
                    const bf16x8 sf = *(const LAS bf16x8*)(St + (16 * et + fr) * QS + 32 * ks + 8 * fq);
                    oi[et] = __builtin_amdgcn_mfma_f32_16x16x32_bf16(sf, qf[ks], oi[et], 0, 0, 0);
                }
            {
                const int i = 16 * wid + fr;
                const float qw = exp2f((float)(i + 1) * l2g);
                float sum = 0.f;
#pragma unroll
                for (int et = 0; et < 4; ++et)
#pragma unroll
                    for (int r = 0; r < 4; ++r) { o[et][r] += qw * oi[et][r]; sum += o[et][r]; }
                sum += __shfl_xor(sum, 16); sum += __shfl_xor(sum, 32);
                const float mean = sum * (1.0f / 64.0f);
                float q = 0.f;
#pragma unroll
                for (int et = 0; et < 4; ++et)
#pragma unroll
                    for (int r = 0; r < 4; ++r) { const float d = o[et][r] - mean; q += d * d; }
                q += __shfl_xor(q, 16); q += __shfl_xor(q, 32);
                const float rstd = rsqrtf(q * (1.0f / 64.0f) + GN_EPS);
                const size_t t = (size_t)b * SEQ + n * CH + i;
#pragma unroll
                for (int et = 0; et < 4; ++et) {
                    const int e0 = 16 * et + 4 * fq;
                    const u32x2 gw = *(const u32x2*)(proj + t * INW + C_RG + h * 64 + e0);
                    const f32x4 gn = *(const f32x4*)(gain + h * 64 + e0);
                    const float g0 = bf2f(gw.x & 0xffffu), g1 = bf2f(gw.x >> 16), g2 = bf2f(gw.y & 0xffffu), g3 = bf2f(gw.y >> 16);
                    const float y0 = (o[et][0] - mean) * rstd * gn[0] * siluf_(g0), y1 = (o[et][1] - mean) * rstd * gn[1] * siluf_(g1);
                    const float y2 = (o[et][2] - mean) * rstd * gn[2] * siluf_(g2), y3 = (o[et][3] - mean) * rstd * gn[3] * siluf_(g3);
                    u32x2 w; w.x = cvt_pk_bf16(y0, y1); w.y = cvt_pk_bf16(y2, y3);
                    *(u32x2*)(mixo + t * D + h * 64 + e0) = w;
                }
            }
            f32x4 kv[2]; ret_kv(lds, wid, fr, fq, kv);
            S[0] = S[0] * cd + kv[0]; S[1] = S[1] * cd + kv[1];
        }
    }
}

__device__ void phase_swa(const Args& a, LAS unsigned char* lds, int bid, int nb) {
    WAVE_IDS();
    const bf16* proj = (const bf16*)(a.ws + WS_BIG);
    bf16* mixo = (bf16*)(a.ws + WS_MIXO);
    const float* tab = (const float*)(a.ws + WS_TAB);
    const float* coss = tab + SEQ * 64, *sins = tab + SEQ * 72;
    const float* ascale = a.in[I_ASC]; const float* sinks = a.in[I_SINK];
    LAS bf16* Qs = (LAS bf16*)(lds + L_QS); LAS bf16* Ks = (LAS bf16*)(lds + L_KS); LAS bf16* Vt = (LAS bf16*)(lds + L_VT);
    for (int it = bid; it < BATCH * NCH * QH; it += nb) {
        const int qh = it % QH, n = (it / QH) % NCH, b = it / (QH * NCH), kvh = qh >> 2;
        __syncthreads();
        {
            const int row = tid >> 2, cg = tid & 3, pos = n * CH + row;
            const bf16* src = proj + ((size_t)b * SEQ + pos) * INW + C_AQ + qh * 64 + cg * 16;
            bf16x8 x1 = *(const bf16x8*)src, x2 = *(const bf16x8*)(src + 8);
            if (cg == 0) {
                const f32x4 c0 = *(const f32x4*)(coss + pos * 8), c1 = *(const f32x4*)(coss + pos * 8 + 4), s0 = *(const f32x4*)(sins + pos * 8), s1 = *(const f32x4*)(sins + pos * 8 + 4);
                const float cs[8] = {c0[0], c0[1], c0[2], c0[3], c1[0], c1[1], c1[2], c1[3]}, sn[8] = {s0[0], s0[1], s0[2], s0[3], s1[0], s1[1], s1[2], s1[3]};
                float o1[8], o2[8];
#pragma unroll
                for (int j = 0; j < 8; ++j) { const float a1 = bf2f((unsigned short)x1[j]), a2 = bf2f((unsigned short)x2[j]); o1[j] = a1 * cs[j] - a2 * sn[j]; o2[j] = a2 * cs[j] + a1 * sn[j]; }
                u32x4 w1, w2;
                w1.x = cvt_pk_bf16(o1[0], o1[1]); w1.y = cvt_pk_bf16(o1[2], o1[3]); w1.z = cvt_pk_bf16(o1[4], o1[5]); w1.w = cvt_pk_bf16(o1[6], o1[7]);
                w2.x = cvt_pk_bf16(o2[0], o2[1]); w2.y = cvt_pk_bf16(o2[2], o2[3]); w2.z = cvt_pk_bf16(o2[4], o2[5]); w2.w = cvt_pk_bf16(o2[6], o2[7]);
                x1 = __builtin_bit_cast(bf16x8, w1); x2 = __builtin_bit_cast(bf16x8, w2);
            }
            *(LAS bf16x8*)(Qs + row * QS + cg * 16) = x1; *(LAS bf16x8*)(Qs + row * QS + cg * 16 + 8) = x2;
        }
#pragma unroll
        for (int rep = 0; rep < 2; ++rep) {
            const int q = tid + rep * NTHREADS, kj = q >> 2, cg = q & 3, pos = n * CH - CH + kj;
            bf16x8 k1 = {0, 0, 0, 0, 0, 0, 0, 0}, k2 = k1, v1 = k1, v2 = k1;
            if (pos >= 0) {
                const bf16* srow = proj + ((size_t)b * SEQ + pos) * INW;
                k1 = *(const bf16x8*)(srow + C_AK + kvh * 64 + cg * 16); k2 = *(const bf16x8*)(srow + C_AK + kvh * 64 + cg * 16 + 8);
                v1 = *(const bf16x8*)(srow + C_AV + kvh * 64 + cg * 16); v2 = *(const bf16x8*)(srow + C_AV + kvh * 64 + cg * 16 + 8);
                if (cg == 0) {
                    const f32x4 c0 = *(const f32x4*)(coss + pos * 8), c1 = *(const f32x4*)(coss + pos * 8 + 4), s0 = *(const f32x4*)(sins + pos * 8), s1 = *(const f32x4*)(sins + pos * 8 + 4);
                    const float cs[8] = {c0[0], c0[1], c0[2], c0[3], c1[0], c1[1], c1[2], c1[3]}, sn[8] = {s0[0], s0[1], s0[2], s0[3], s1[0], s1[1], s1[2], s1[3]};
                    float o1[8], o2[8];
#pragma unroll
                    for (int j = 0; j < 8; ++j) { const float a1 = bf2f((unsigned short)k1[j]), a2 = bf2f((unsigned short)k2[j]); o1[j] = a1 * cs[j] - a2 * sn[j]; o2[j] = a2 * cs[j] + a1 * sn[j]; }
                    u32x4 w1, w2;
                    w1.x = cvt_pk_bf16(o1[0], o1[1]); w1.y = cvt_pk_bf16(o1[2], o1[3]); w1.z = cvt_pk_bf16(o1[4], o1[5]); w1.w = cvt_pk_bf16(o1[6], o1[7]);
                    w2.x = cvt_pk_bf16(o2[0], o2[1]); w2.y = cvt_pk_bf16(o2[2], o2[3]); w2.z = cvt_pk_bf16(o2[4], o2[5]); w2.w = cvt_pk_bf16(o2[6], o2[7]);
                    k1 = __builtin_bit_cast(bf16x8, w1); k2 = __builtin_bit_cast(bf16x8, w2);
                }
            }
            *(LAS bf16x8*)(Ks + kj * QS + cg * 16) = k1; *(LAS bf16x8*)(Ks + kj * QS + cg * 16 + 8) = k2;
#pragma unroll
            for (int j = 0; j < 8; ++j) { Vt[(cg * 16 + j) * TS2 + kj] = (bf16)v1[j]; Vt[(cg * 16 + 8 + j) * TS2 + kj] = (bf16)v2[j]; }
        }
        __syncthreads();
        const int jt0 = wid & ~1;
        bf16x8 qf[2];
#pragma unroll
        for (int ks = 0; ks < 2; ++ks) qf[ks] = *(const LAS bf16x8*)(Qs + (16 * wid + fr) * QS + 32 * ks + 8 * fq);
        f32x4 sc[10];
        const int i = 16 * wid + fr;
        float mx = sinks[qh];
#pragma unroll
        for (int tt = 0; tt < 10; ++tt) {
            const int jt = jt0 + tt;
            f32x4 c = {0.f, 0.f, 0.f, 0.f};
#pragma unroll
            for (int ks = 0; ks < 2; ++ks) {
                const bf16x8 kf = *(const LAS bf16x8*)(Ks + (16 * jt + fr) * QS + 32 * ks + 8 * fq);
                c = __builtin_amdgcn_mfma_f32_16x16x32_bf16(kf, qf[ks], c, 0, 0, 0);
            }
#pragma unroll
            for (int r = 0; r < 4; ++r) {
                const int kj = 16 * jt + 4 * fq + r;
                const bool valid = (kj > i) && (kj <= i + CH) && (n * CH - CH + kj >= 0);
                c[r] = valid ? c[r] * 0.125f : -1e30f;
                mx = fmaxf(mx, c[r]);
            }
            sc[tt] = c;
        }
        mx = fmaxf(mx, __shfl_xor(mx, 16)); mx = fmaxf(mx, __shfl_xor(mx, 32));
        float den = 0.f;
#pragma unroll
        for (int tt = 0; tt < 10; ++tt)
#pragma unroll
            for (int r = 0; r < 4; ++r) { const float p = (sc[tt][r] > -1e29f) ? __expf(sc[tt][r] - mx) : 0.f; sc[tt][r] = p; den += p; }
        den += __shfl_xor(den, 16); den += __shfl_xor(den, 32);
        den += __expf(sinks[qh] - mx);
        const float inv = 1.0f / den;
        f32x4 o[4];
#pragma unroll
        for (int et = 0; et < 4; ++et) o[et] = (f32x4){0.f, 0.f, 0.f, 0.f};
#pragma unroll
        for (int k2 = 0; k2 < 5; ++k2) {
            u32x4 pw;
            pw.x = cvt_pk_bf16(sc[2 * k2][0] * inv, sc[2 * k2][1] * inv); pw.y = cvt_pk_bf16(sc[2 * k2][2] * inv, sc[2 * k2][3] * inv);
            pw.z = cvt_pk_bf16(sc[2 * k2 + 1][0] * inv, sc[2 * k2 + 1][1] * inv); pw.w = cvt_pk_bf16(sc[2 * k2 + 1][2] * inv, sc[2 * k2 + 1][3] * inv);
            const bf16x8 pf = __builtin_bit_cast(bf16x8, pw);
            const int kb = 16 * (jt0 + 2 * k2);
#pragma unroll
            for (int et = 0; et < 4; ++et) {
                const u32x2 va = *(const LAS u32x2*)(Vt + (16 * et + fr) * TS2 + kb + 4 * fq);
                const u32x2 vb = *(const LAS u32x2*)(Vt + (16 * et + fr) * TS2 + kb + 16 + 4 * fq);
                u32x4 vw; vw.x = va.x; vw.y = va.y; vw.z = vb.x; vw.w = vb.y;
                o[et] = __builtin_amdgcn_mfma_f32_16x16x32_bf16(__builtin_bit_cast(bf16x8, vw), pf, o[et], 0, 0, 0);
            }
        }
        const size_t t = (size_t)b * SEQ + n * CH + i;
#pragma unroll
        for (int et = 0; et < 4; ++et) {
            const int e0 = 16 * et + 4 * fq;
            const f32x4 as = *(const f32x4*)(ascale + qh * 64 + e0);
            u32x2 w; w.x = cvt_pk_bf16(o[et][0] * as[0], o[et][1] * as[1]); w.y = cvt_pk_bf16(o[et][2] * as[2], o[et][3] * as[3]);
            *(u32x2*)(mixo + t * D + 512 + qh * 64 + e0) = w;
        }
    }
}

__device__ void phase_wout(const Args& a, int bid, int nb) {
    WAVE_IDS();
    const bf16* mixo = (const bf16*)(a.ws + WS_MIXO); const bf16* wt = (const bf16*)(a.ws + WS_WOUTT);
    const float* x = a.in[I_X]; float* y = a.out;
    const int nN = D / 256, nU = (T / 256) * nN;
    for (int u = bid; u < nU; u += nb) {
        const int pm = u / nN, pn = u % nN;
        f32x4 acc[2][2][4][2]; zero_acc(acc);
        GemmPart g{mixo, D, nullptr, (long)pm * 256, wt + (size_t)pn * 256 * D, D, D};
        gemm_part(acc, g, wr, wc, fr, fq);
#pragma unroll
        for (int ai = 0; ai < 2; ++ai)
#pragma unroll
            for (int m = 0; m < 4; ++m) {
                const size_t off = (size_t)(pm * 256 + 128 * ai + 64 * wr + 16 * m + fr) * D + pn * 256 + 32 * wc + 8 * fq;
#pragma unroll
                for (int bj = 0; bj < 2; ++bj)
#pragma unroll
                    for (int n = 0; n < 2; ++n) {
                        const f32x4 xv = *(const f32x4*)(x + off + 128 * bj + 4 * n);
                        *(f32x4*)(y + off + 128 * bj + 4 * n) = acc[ai][bj][m][n] + ALPHA * xv;
                    }
            }
    }
}

template <int MODE>
__device__ void phase_ln(const float* src, const float* g, const float* bta, bf16* dstb, float* dstf, int bid, int nb) {
    const int tid = threadIdx.x, wid = tid >> 6, lane = tid & 63;
    f32x4 gv[4], bv[4];
#pragma unroll
    for (int i = 0; i < 4; ++i) { gv[i] = *(const f32x4*)(g + 256 * i + lane * 4); bv[i] = *(const f32x4*)(bta + 256 * i + lane * 4); }
    for (int row = bid * 8 + wid; row < T; row += nb * 8) {
        const float* r = src + (size_t)row * D;
        f32x4 v[4]; float s = 0.f;
#pragma unroll
        for (int i = 0; i < 4; ++i) { v[i] = *(const f32x4*)(r + 256 * i + lane * 4); s += (v[i][0] + v[i][1]) + (v[i][2] + v[i][3]); }
#pragma unroll
        for (int o = 32; o >= 1; o >>= 1) s += __shfl_xor(s, o);
        const float mean = s * (1.0f / D);
        float q = 0.f;
#pragma unroll
        for (int i = 0; i < 4; ++i) { const f32x4 d = v[i] - mean; q += (d[0] * d[0] + d[1] * d[1]) + (d[2] * d[2] + d[3] * d[3]); }
#pragma unroll
        for (int o = 32; o >= 1; o >>= 1) q += __shfl_xor(q, o);
        const float rstd = rsqrtf(q * (1.0f / D) + LN_EPS);
#pragma unroll
        for (int i = 0; i < 4; ++i) {
            const f32x4 y = (v[i] - mean) * rstd * gv[i] + bv[i];
            if (MODE == 0) { u32x2 w; w.x = cvt_pk_bf16(y[0], y[1]); w.y = cvt_pk_bf16(y[2], y[3]); *(u32x2*)(dstb + (size_t)row * D + 256 * i + lane * 4) = w; }
            else *(f32x4*)(dstf + (size_t)row * D + 256 * i + lane * 4) = y;
        }
    }
}

__device__ void phase_router(const Args& a, LAS unsigned char* lds, int bid, int nb) {
    WAVE_IDS();
    const bf16* x1b = (const bf16*)(a.ws + WS_XB); const bf16* wrt = (const bf16*)(a.ws + WS_WRT);
    unsigned char* ro = a.ws + WS_ROUT;
    int* ridx = (int*)(ro + RO_RIDX); float* rw = (float*)(ro + RO_RW); int* cnt = (int*)(ro + RO_CNT);
    const float* rbias = a.in[I_RB];
    LAS float* lg = (LAS float*)lds;
    LAS float* bi = lg + 128 * 65;
    LAS int* hist = (LAS int*)(bi + 128 * 65);
    for (int u = bid; u < T / 128; u += nb) {
        __syncthreads();
        if (tid < 64) hist[tid] = 0;
        {
            f32x4 c[4];
#pragma unroll
            for (int et = 0; et < 4; ++et) c[et] = (f32x4){0.f, 0.f, 0.f, 0.f};
            const bf16* xa = x1b + (size_t)(u * 128 + 16 * wid + fr) * D + 8 * fq;
            for (int k0 = 0; k0 < D; k0 += 32) {
                const bf16x8 xf = *(const bf16x8*)(xa + k0);
#pragma unroll
                for (int et = 0; et < 4; ++et) {
                    const bf16x8 wf = *(const bf16x8*)(wrt + (size_t)(16 * et + fr) * D + k0 + 8 * fq);
                    c[et] = __builtin_amdgcn_mfma_f32_16x16x32_bf16(wf, xf, c[et], 0, 0, 0);
                }
            }
#pragma unroll
            for (int et = 0; et < 4; ++et)
#pragma unroll
                for (int r = 0; r < 4; ++r) {
                    const int e = 16 * et + 4 * fq + r; const float s = sigmoidf_(c[et][r]);
                    lg[(16 * wid + fr) * 65 + e] = s; bi[(16 * wid + fr) * 65 + e] = s + rbias[e];
                }
        }
        __syncthreads();
        if (tid < 128) {
            const LAS float* mb = bi + tid * 65; const LAS float* ms = lg + tid * 65;
            float gs[8];
#pragma unroll
            for (int g = 0; g < 8; ++g) {
                float m1 = -3e38f, m2 = -3e38f;
#pragma unroll
                for (int j = 0; j < 8; ++j) { const float v = mb[g * 8 + j]; if (v > m1) { m2 = m1; m1 = v; } else if (v > m2) m2 = v; }
                gs[g] = m1 + m2;
            }
            unsigned gmask = 0;
#pragma unroll
            for (int rnd = 0; rnd < 4; ++rnd) {
                float best = -3e38f; int bg = 0;
#pragma unroll
                for (int g = 0; g < 8; ++g) { const bool ok = !((gmask >> g) & 1u) && gs[g] > best; best = ok ? gs[g] : best; bg = ok ? g : bg; }
                gmask |= 1u << bg;
            }
            unsigned long long taken = 0ull;
            int sel[8]; float wsel[8]; float wsum = 0.f;
#pragma unroll
            for (int rnd = 0; rnd < 8; ++rnd) {
                float best = -3e38f; int be = 0;
#pragma unroll 1
                for (int e = 0; e < 64; ++e) {
                    const bool ok = ((gmask >> (e >> 3)) & 1u) && !((taken >> e) & 1ull);
                    const float v = mb[e];
                    if (ok && v > best) { best = v; be = e; }
                }
                taken |= 1ull << be;
                sel[rnd] = be; wsel[rnd] = ms[be]; wsum += wsel[rnd];
            }
            const float sc = ROUTED_SCALE / wsum;
            const size_t t = (size_t)u * 128 + tid;
#pragma unroll
            for (int k = 0; k < 8; ++k) { ridx[t * 8 + k] = sel[k]; rw[t * 8 + k] = wsel[k] * sc; __hip_atomic_fetch_add(&hist[sel[k]], 1, __ATOMIC_RELAXED, __HIP_MEMORY_SCOPE_WORKGROUP); }
        }
        __syncthreads();
        if (tid < 64) cnt[u * 64 + tid] = hist[tid];
    }
}

__device__ void phase_sort(const Args& a, LAS unsigned char* lds, int bid, int nb) {
    const int tid = threadIdx.x;
    unsigned char* ro = a.ws + WS_ROUT;
    const int* ridx = (const int*)(ro + RO_RIDX); const float* rw = (const float*)(ro + RO_RW); const int* cnt = (const int*)(ro + RO_CNT);
    int* stok = (int*)(ro + RO_STOK); int* dest = (int*)(ro + RO_DEST); float* rsc = (float*)(ro + RO_RSC); int* tile = (int*)(ro + RO_TILE);
    LAS int* tot = (LAS int*)lds; LAS int* pos0 = tot + 64; LAS int* lcnt = pos0 + 64; LAS int* base = lcnt + 64;
    constexpr int UPC = TC / 128;
    for (int u = bid; u < T / 128; u += nb) {
        const int c = u / UPC, ul = u % UPC;
        __syncthreads();
        if (tid < 64) {
            int tt = 0, pre = 0;
            for (int q = 0; q < UPC; ++q) { const int v = cnt[(c * UPC + q) * 64 + tid]; tt += v; pre += (q < ul) ? v : 0; }
            tot[tid] = tt; pos0[tid] = pre; lcnt[tid] = 0;
        }
        __syncthreads();
        if (tid == 0) { int acc = 0; for (int e = 0; e < 64; ++e) { base[e] = acc; acc += (tot[e] + 255) & ~255; } base[64] = acc; }
        __syncthreads();
        int* stok_c = stok + (size_t)c * RMAX; int* dest_c = dest + (size_t)c * RMAX; float* rsc_c = rsc + (size_t)c * RMAX;
#pragma unroll
        for (int rep = 0; rep < 2; ++rep) {
            const int pr = tid + rep * NTHREADS, tl = pr >> 3, k = pr & 7;
            const size_t t = (size_t)u * 128 + tl;
            const int e = ridx[t * 8 + k];
            const int rank = __hip_atomic_fetch_add(&lcnt[e], 1, __ATOMIC_RELAXED, __HIP_MEMORY_SCOPE_WORKGROUP);
            const int pos = base[e] + pos0[e] + rank;
            stok_c[pos] = (int)t; dest_c[pos] = (int)(t - (size_t)c * TC) * 8 + k; rsc_c[pos] = rw[t * 8 + k];
        }
        if (ul < 64) {
            const int e = ul, lo = base[e] + tot[e], hi = base[e + 1];
            for (int r = lo + tid; r < hi; r += NTHREADS) { stok_c[r] = c * TC; dest_c[r] = TC * 8; rsc_c[r] = 0.f; }
        }
        if (ul == 0) {
            const int ntl = base[64] / 256;
            for (int mt = tid; mt < ntl; mt += NTHREADS) { int e = 0; for (int q = 1; q < 64; ++q) e = (base[q] <= mt * 256) ? q : e; tile[c * 512 + mt] = e; }
            if (tid == 0) tile[c * 512 + 511] = ntl;
        }
    }
}

__device__ void phase_shared_pp(const Args& a, int bid, int nb) {
    WAVE_IDS();
    const bf16* x1b = (const bf16*)(a.ws + WS_XB); const bf16* pb = (const bf16*)(a.ws + WS_PB);
    const bf16* ws13 = (const bf16*)(a.ws + WS_WS13T); const bf16* wpt = (const bf16*)(a.ws + WS_WPT);
    bf16* hs = (bf16*)(a.ws + WS_HS); bf16* pp = (bf16*)(a.ws + WS_PP);
    const int nU1 = (T / 256) * 2, nU2 = (T / 256) * 4;
    for (int u = bid; u < nU1 + nU2; u += nb) {
        f32x4 acc[2][2][4][2]; zero_acc(acc);
        if (u < nU1) {
            const int pm = u / 2, pn = u % 2;
            GemmPart g{x1b, D, nullptr, (long)pm * 256, ws13 + (size_t)pn * 256 * D, D, D};
            gemm_part(acc, g, wr, wc, fr, fq);
            epi_gate(acc, hs, SDIM, (long)pm * 256, pn * 128, wr, wc, fr, fq);
        } else {
            const int v = u - nU1, pm = v / 4, pn = v % 4;
            GemmPart g{pb, PLE, nullptr, (long)pm * 256, wpt + (size_t)pn * 256 * PLE, PLE, PLE};
            gemm_part(acc, g, wr, wc, fr, fq);
            epi_bf16(acc, pp, D, (long)pm * 256, pn * 256, wr, wc, fr, fq);
        }
    }
}

__device__ void phase_moe_up(const Args& a, int c, int bid, int nb) {
    WAVE_IDS();
    unsigned char* ro = a.ws + WS_ROUT;
    const int* stok = (const int*)(ro + RO_STOK) + (size_t)c * RMAX; const int* tile = (const int*)(ro + RO_TILE) + c * 512;
    const bf16* x1b = (const bf16*)(a.ws + WS_XB); const bf16* w13 = (const bf16*)(a.ws + WS_W13T);
    bf16* hsort = (bf16*)(a.ws + WS_HSORT);
    const int ntl = tile[511];
    for (int u = bid; u < ntl * 2; u += nb) {
        const int mt = u >> 1, pn = u & 1, e = tile[mt];
        f32x4 acc[2][2][4][2]; zero_acc(acc);
        GemmPart g{x1b, D, stok + mt * 256, 0, w13 + ((size_t)e * 512 + pn * 256) * D, D, D};
        gemm_part(acc, g, wr, wc, fr, fq);
        epi_gate(acc, hsort, EDIM, (long)mt * 256, pn * 128, wr, wc, fr, fq);
    }
}
__device__ void phase_moe_down(const Args& a, int c, int bid, int nb) {
    WAVE_IDS();
    unsigned char* ro = a.ws + WS_ROUT;
    const int* dest = (const int*)(ro + RO_DEST) + (size_t)c * RMAX; const float* rsc = (const float*)(ro + RO_RSC) + (size_t)c * RMAX; const int* tile = (const int*)(ro + RO_TILE) + c * 512;
    const bf16* hsort = (const bf16*)(a.ws + WS_HSORT); const bf16* w2t = (const bf16*)(a.ws + WS_W2T);
    bf16* contrib = (bf16*)(a.ws + WS_CONTRIB);
    const int ntl = tile[511];
    for (int u = bid; u < ntl * 4; u += nb) {
        const int mt = u >> 2, pn = u & 3, e = tile[mt];
        f32x4 acc[2][2][4][2]; zero_acc(acc);
        GemmPart g{hsort, EDIM, nullptr, (long)mt * 256, w2t + ((size_t)e * D + pn * 256) * EDIM, EDIM, EDIM};
        gemm_part(acc, g, wr, wc, fr, fq);
#pragma unroll
        for (int ai = 0; ai < 2; ++ai)
#pragma unroll
            for (int m = 0; m < 4; ++m) {
                const int r = mt * 256 + 128 * ai + 64 * wr + 16 * m + fr;
                const int dr = dest[r]; const float s = rsc[r];
                bf16* rp = contrib + (size_t)dr * D + pn * 256 + 32 * wc + 8 * fq;
#pragma unroll
                for (int bj = 0; bj < 2; ++bj) {
                    const f32x4 v0 = acc[ai][bj][m][0] * s, v1 = acc[ai][bj][m][1] * s;
                    u32x4 w; w.x = cvt_pk_bf16(v0[0], v0[1]); w.y = cvt_pk_bf16(v0[2], v0[3]); w.z = cvt_pk_bf16(v1[0], v1[1]); w.w = cvt_pk_bf16(v1[2], v1[3]);
                    *(u32x4*)(rp + 128 * bj) = w;
                }
                asm volatile("" ::: "memory");
            }
    }
}
__device__ void phase_final(const Args& a, int c, int bid, int nb) {
    WAVE_IDS();
    const bf16* x1b = (const bf16*)(a.ws + WS_XB); const bf16* wgt = (const bf16*)(a.ws + WS_WGT); const bf16* ws2t = (const bf16*)(a.ws + WS_WS2T);
    const bf16* hs = (const bf16*)(a.ws + WS_HS); const bf16* pp = (const bf16*)(a.ws + WS_PP); const bf16* contrib = (const bf16*)(a.ws + WS_CONTRIB);
    const float* bg = a.in[I_BG]; float* y = a.out;
    const int nU = (TC / 256) * 4;
    for (int u = bid; u < nU; u += nb) {
        const int pml = u >> 2, pn = u & 3; const long row0 = (long)c * TC + pml * 256;
        f32x4 acc[2][2][4][2]; zero_acc(acc);
        GemmPart g0{x1b, D, nullptr, row0, wgt + (size_t)pn * 256 * D, D, D};
        gemm_part(acc, g0, wr, wc, fr, fq);
#pragma unroll
        for (int ai = 0; ai < 2; ++ai)
#pragma unroll
            for (int m = 0; m < 4; ++m) {
                const int rl = pml * 256 + 128 * ai + 64 * wr + 16 * m + fr;
                const size_t t = (size_t)c * TC + rl;
#pragma unroll
                for (int bj = 0; bj < 2; ++bj) {
                    const int col = pn * 256 + 128 * bj + 32 * wc + 8 * fq;
                    float v[8];
                    const f32x4 b0 = *(const f32x4*)(bg + col), b1 = *(const f32x4*)(bg + col + 4);
                    const u32x4 pw = *(const u32x4*)(pp + t * D + col), xw = *(const u32x4*)(x1b + t * D + col);
                    const unsigned pws[4] = {pw.x, pw.y, pw.z, pw.w}, xws[4] = {xw.x, xw.y, xw.z, xw.w};
#pragma unroll
                    for (int j = 0; j < 8; ++j) {
                        const float gacc = acc[ai][bj][m][j >> 2][j & 3] + ((j < 4) ? b0[j & 3] : b1[j & 3]);
                        const float ppv = (j & 1) ? bf2f(pws[j >> 1] >> 16) : bf2f(pws[j >> 1] & 0xffffu);
                        const float xv = (j & 1) ? bf2f(xws[j >> 1] >> 16) : bf2f(xws[j >> 1] & 0xffffu);
                        v[j] = sigmoidf_(gacc) * ppv + ALPHA * xv;
                    }
#pragma unroll
                    for (int k = 0; k < 8; ++k) {
                        if ((k & 3) == 0) asm volatile("" : "+v"(v[0]), "+v"(v[1]), "+v"(v[2]), "+v"(v[3]), "+v"(v[4]), "+v"(v[5]), "+v"(v[6]), "+v"(v[7]) :: "memory");
                        const u32x4 cw = *(const u32x4*)(contrib + ((size_t)rl * 8 + k) * D + col);
                        const unsigned cws[4] = {cw.x, cw.y, cw.z, cw.w};
#pragma unroll
                        for (int j = 0; j < 8; ++j) v[j] += (j & 1) ? bf2f(cws[j >> 1] >> 16) : bf2f(cws[j >> 1] & 0xffffu);
                    }
                    acc[ai][bj][m][0] = (f32x4){v[0], v[1], v[2], v[3]}; acc[ai][bj][m][1] = (f32x4){v[4], v[5], v[6], v[7]};
                    asm volatile("" : "+v"(acc[ai][bj][m][0]), "+v"(acc[ai][bj][m][1]) :: "memory");
                }
            }
        GemmPart g1{hs, SDIM, nullptr, row0, ws2t + (size_t)pn * 256 * SDIM, SDIM, SDIM};
        gemm_part(acc, g1, wr, wc, fr, fq);
#pragma unroll
        for (int ai = 0; ai < 2; ++ai)
#pragma unroll
            for (int m = 0; m < 4; ++m) {
                const size_t off = (size_t)(row0 + 128 * ai + 64 * wr + 16 * m + fr) * D + pn * 256 + 32 * wc + 8 * fq;
#pragma unroll
                for (int bj = 0; bj < 2; ++bj)
#pragma unroll
                    for (int n = 0; n < 2; ++n) *(f32x4*)(y + off + 128 * bj + 4 * n) = acc[ai][bj][m][n];
            }
    }
}

constexpr int PH_PROLOGUE = 0, PH_PROJ = 1, PH_MIX_A = 2, PH_MIX_B = 3, PH_WOUT = 4, PH_LN1 = 5, PH_ROUTER = 6, PH_SORT = 7, PH_SHARED = 8, PH_MOE0 = 9, PH_LN2 = PH_MOE0 + 3 * NH, PH_END = PH_LN2 + 1;
constexpr int LDS_BYTES = 147456;

__global__ void __launch_bounds__(NTHREADS, 2) fwd(Args a) {
    extern __shared__ __attribute__((aligned(16))) unsigned char lds_raw[];
    LAS unsigned char* lds = (LAS unsigned char*)lds_raw;
    const int bid = blockIdx.x, nb = gridDim.x;
    const int lo = a.ph_lo, hi = a.ph_hi;
#ifndef PHMASK
#define PHMASK 0xffffffffu
#endif
#define IN(k) (((PHMASK >> ((k) < PH_MOE0 ? (k) : ((k) >= PH_LN2 ? 12 : 9 + ((k) - PH_MOE0) % 3))) & 1u) && lo <= (k) && (k) < hi)
    if (IN(PH_PROLOGUE)) phase_prologue(a, lds, bid, nb);
    if (IN(PH_PROJ)) phase_proj(a, bid, nb);
    if (IN(PH_MIX_A)) { phase_segtot(a, lds, bid, nb); phase_swa(a, lds, bid, nb); }
    if (IN(PH_MIX_B)) phase_retention(a, lds, bid, nb);
    if (IN(PH_WOUT)) phase_wout(a, bid, nb);
    if (IN(PH_LN1)) phase_ln<0>(a.out, a.in[I_LN1G], a.in[I_LN1B], (bf16*)(a.ws + WS_XB), nullptr, bid, nb);
    if (IN(PH_ROUTER)) phase_router(a, lds, bid, nb);
    if (IN(PH_SORT)) phase_sort(a, lds, bid, nb);
    if (IN(PH_SHARED)) phase_shared_pp(a, bid, nb);
    for (int c = 0; c < NH; ++c) {
        if (IN(PH_MOE0 + 3 * c)) phase_moe_up(a, c, bid, nb);
        if (IN(PH_MOE0 + 3 * c + 1)) phase_moe_down(a, c, bid, nb);
        if (IN(PH_MOE0 + 3 * c + 2)) phase_final(a, c, bid, nb);
    }
    if (IN(PH_LN2)) phase_ln<1>(a.out, a.in[I_LN2G], a.in[I_LN2B], nullptr, a.out, bid, nb);
#undef IN
}

extern "C" void kernel_launch(void* const* d_in, const int* in_sizes, int n_in, void* d_out, int out_size, void* d_ws, size_t ws_size, hipStream_t stream) {
    static int grid = 0;
    if (grid == 0) {
        if (n_in != 22 || out_size != T * D || ws_size < WS_NEED) { fprintf(stderr, "kernel_launch: unexpected shapes: n_in %d out %d ws %zu (need %zu)\n", n_in, out_size, ws_size, (size_t)WS_NEED); grid = -1; return; }
        int dev = 0, cus = 0;
        (void)hipGetDevice(&dev); (void)hipDeviceGetAttribute(&cus, hipDeviceAttributeMultiprocessorCount, dev);
        if (hipFuncSetAttribute((const void*)fwd, hipFuncAttributeMaxDynamicSharedMemorySize, LDS_BYTES) != hipSuccess) { fprintf(stderr, "hipFuncSetAttribute failed\n"); grid = -1; return; }
        (void)hipGetLastError();
        grid = cus > 0 ? cus : 256;
    }
    if (grid < 0) return;
    Args a{};
    for (int i = 0; i < 22; ++i) a.in[i] = (const float*)d_in[i];
    a.out = (float*)d_out; a.ws = (unsigned char*)d_ws;
    for (int ph = 0; ph < PH_END; ++ph) {
        a.ph_lo = ph; a.ph_hi = ph + 1;
        hipLaunchKernelGGL(fwd, dim3(grid), dim3(NTHREADS), LDS_BYTES, stream, a);
    }
}
```

```cpp
#include <hip/hip_runtime.h>
#include <cstdio>
#include <cstdint>

#define LAS __attribute__((address_space(3)))
typedef unsigned short bf16;
typedef short bf16x8 __attribute__((ext_vector_type(8)));
typedef short bf16x4 __attribute__((ext_vector_type(4)));
typedef float f32x4 __attribute__((ext_vector_type(4)));
typedef unsigned u32x4 __attribute__((ext_vector_type(4)));
typedef unsigned u32x2 __attribute__((ext_vector_type(2)));

constexpr int D = 1024, BATCH = 8, SEQ = 4096, T = BATCH * SEQ;
constexpr int HD = 64, RH = 8, QH = 8, KVH = 2;
constexpr int INW = 2816;
constexpr int C_RQ = 0, C_RK = 512, C_RV = 1024, C_RG = 1536, C_AQ = 2048, C_AK = 2560, C_AV = 2688;
constexpr int CH = 128, NCH = SEQ / CH;
constexpr int SEGC = 8, NSEG = NCH / SEGC;
constexpr int NE = 64, TOPK = 8, EDIM = 256, SDIM = 256, PLE = 256;
constexpr float LN_EPS = 1e-5f, GN_EPS = 1e-6f;
constexpr float ALPHA = 1.189207115002721f;
constexpr float ROUTED_SCALE = 2.5f;
constexpr int NH = 4, TC = T / NH;
constexpr int RMAX = TC * TOPK + NE * 256;
constexpr int MAXTILES = RMAX / 256;
constexpr int NTHREADS = 512;

constexpr size_t MiB = 1u << 20;
constexpr size_t al(size_t x) { return (x + 255) & ~(size_t)255; }
constexpr size_t WS_CTL = 0, CTL_BYTES = 1 * MiB;
constexpr size_t WS_WINT = WS_CTL + CTL_BYTES;
constexpr size_t WS_WOUTT = WS_WINT + al((size_t)INW * D * 2);
constexpr size_t WS_W13T = WS_WOUTT + al((size_t)D * D * 2);
constexpr size_t WS_W2T = WS_W13T + al((size_t)NE * 512 * D * 2);
constexpr size_t WS_WS13T = WS_W2T + al((size_t)NE * D * EDIM * 2);
constexpr size_t WS_WS2T = WS_WS13T + al((size_t)512 * D * 2);
constexpr size_t WS_WGT = WS_WS2T + al((size_t)D * SDIM * 2);
constexpr size_t WS_WPT = WS_WGT + al((size_t)D * D * 2);
constexpr size_t WS_WRT = WS_WPT + al((size_t)D * PLE * 2);
constexpr size_t WS_TAB = WS_WRT + al((size_t)NE * D * 2);
constexpr size_t TAB_BYTES = (size_t)SEQ * (32 + 32 + 8 + 8) * 4;
constexpr size_t WS_SEGT = WS_TAB + al(TAB_BYTES);
constexpr size_t WS_ROUT = WS_SEGT + al((size_t)BATCH * RH * NSEG * 64 * 64 * 4);
constexpr size_t RO_RIDX = 0, RO_RW = RO_RIDX + (size_t)T * 8 * 4, RO_CNT = RO_RW + (size_t)T * 8 * 4, RO_STOK = RO_CNT + 256 * 64 * 4;
constexpr size_t RO_DEST = RO_STOK + (size_t)NH * RMAX * 4, RO_RSC = RO_DEST + (size_t)NH * RMAX * 4, RO_TILE = RO_RSC + (size_t)NH * RMAX * 4;
constexpr size_t RO_END = RO_TILE + (size_t)NH * 512 * 4;
constexpr size_t WS_XB = WS_ROUT + al(RO_END);
constexpr size_t WS_PB = WS_XB + al((size_t)T * D * 2);
constexpr size_t WS_BIG = WS_PB + al((size_t)T * PLE * 2);
constexpr size_t WS_MIXO = WS_BIG + al((size_t)T * INW * 2);
constexpr size_t WS_END1 = WS_MIXO + al((size_t)T * D * 2);
constexpr size_t WS_HS = WS_BIG;
constexpr size_t WS_PP = WS_HS + al((size_t)T * SDIM * 2);
constexpr size_t WS_HSORT = WS_PP + al((size_t)T * D * 2);
constexpr size_t WS_CONTRIB = WS_HSORT + al((size_t)RMAX * EDIM * 2);
constexpr size_t WS_END2 = WS_CONTRIB + al(((size_t)TC * 8 + 1) * D * 2);
constexpr size_t WS_NEED = WS_END1 > WS_END2 ? WS_END1 : WS_END2;
static_assert(WS_NEED <= 512 * MiB, "workspace map exceeds 512 MiB");

__device__ __forceinline__ float bf2f(unsigned v) { return __uint_as_float(v << 16); }
__device__ __forceinline__ unsigned cvt_pk_bf16(float lo, float hi) { unsigned r; asm volatile("v_cvt_pk_bf16_f32 %0, %1, %2" : "=v"(r) : "v"(lo), "v"(hi)); return r; }
__device__ __forceinline__ bf16 f2bf(float f) { return (bf16)(cvt_pk_bf16(f, 0.f) & 0xffffu); }
__device__ __forceinline__ float sigmoidf_(float x) { return 1.0f / (1.0f + __expf(-x)); }
__device__ __forceinline__ float siluf_(float x) { return x / (1.0f + __expf(-x)); }

struct Args {
    const float* in[22];
    float* out;
    unsigned char* ws;
    int ph_lo, ph_hi;
};
enum { I_X = 0, I_P, I_WIN, I_GN, I_ASC, I_SINK, I_WOUT, I_LN1G, I_LN1B, I_WR, I_RB, I_W1, I_W3, I_W2, I_WS1, I_WS3, I_WS2, I_WG, I_BG, I_WP, I_LN2G, I_LN2B };

__device__ __forceinline__ void transpose_tile(const float* __restrict__ src, int ld_src, int sc0, bf16* __restrict__ dst, int ld_dst, int dn0, int k0, LAS float* tile) {
    const int tid = threadIdx.x;
#pragma unroll
    for (int i = 0; i < 2; ++i) {
        const int q = tid + i * NTHREADS, r = q >> 4, c4 = (q & 15) * 4;
        const f32x4 v = *(const f32x4*)(src + (size_t)(k0 + r) * ld_src + sc0 + c4);
        tile[r * 65 + c4 + 0] = v[0]; tile[r * 65 + c4 + 1] = v[1]; tile[r * 65 + c4 + 2] = v[2]; tile[r * 65 + c4 + 3] = v[3];
    }
    __syncthreads();
    {
        const int n = tid >> 3, kc = (tid & 7) * 8;
        u32x4 w;
        w.x = cvt_pk_bf16(tile[(kc + 0) * 65 + n], tile[(kc + 1) * 65 + n]);
        w.y = cvt_pk_bf16(tile[(kc + 2) * 65 + n], tile[(kc + 3) * 65 + n]);
        w.z = cvt_pk_bf16(tile[(kc + 4) * 65 + n], tile[(kc + 5) * 65 + n]);
        w.w = cvt_pk_bf16(tile[(kc + 6) * 65 + n], tile[(kc + 7) * 65 + n]);
        *(u32x4*)(dst + (size_t)(dn0 + n) * ld_dst + k0 + kc) = w;
    }
    __syncthreads();
}
__device__ __forceinline__ void transpose_job(const float* src, int ld_src, int sc0, bf16* dst, int ld_dst, int dn0, int K, int N, int& tctr, int bid, int nb, LAS float* tile) {
    const int nk = K / 64, nn = N / 64;
    for (int t = 0; t < nk * nn; ++t, ++tctr) {
        if ((tctr % nb) != bid) continue;
        const int kt = t % nk, nt = t / nk;
        transpose_tile(src, ld_src, sc0 + nt * 64, dst, ld_dst, dn0 + nt * 64, kt * 64, tile);
    }
}

__device__ void phase_prologue(const Args& a, LAS unsigned char* lds, int bid, int nb) {
    LAS float* tile = (LAS float*)lds;
    unsigned char* ws = a.ws;
    const int tid = threadIdx.x;
    {
        const int ntile = NE * 8 * 16;
        for (int t = bid; t < ntile; t += nb) {
            const int e = t / 128, rem = t % 128, db = rem / 16, kt = rem % 16;
            const int piece = db >> 1, which = piece & 1, pn = piece >> 1, sc0 = pn * 128 + (db & 1) * 64;
            const float* src = (which ? a.in[I_W3] : a.in[I_W1]) + (size_t)e * D * EDIM;
            transpose_tile(src, EDIM, sc0, (bf16*)(ws + WS_W13T) + (size_t)e * 512 * D, D, db * 64, kt * 64, tile);
        }
    }
    {
        const int ntile = NE * 16 * 4;
        for (int t = bid; t < ntile; t += nb) {
            const int e = t / 64, rem = t % 64, nt = rem / 4, kt = rem % 4;
            transpose_tile(a.in[I_W2] + (size_t)e * EDIM * D, D, nt * 64, (bf16*)(ws + WS_W2T) + (size_t)e * D * EDIM, EDIM, nt * 64, kt * 64, tile);
        }
    }
    int tctr = 0;
    transpose_job(a.in[I_WIN], INW, 0, (bf16*)(ws + WS_WINT), D, 0, D, INW, tctr, bid, nb, tile);
    transpose_job(a.in[I_WOUT], D, 0, (bf16*)(ws + WS_WOUTT), D, 0, D, D, tctr, bid, nb, tile);
    for (int pn = 0; pn < 2; ++pn) {
        transpose_job(a.in[I_WS1], SDIM, pn * 128, (bf16*)(ws + WS_WS13T), D, pn * 256, D, 128, tctr, bid, nb, tile);
        transpose_job(a.in[I_WS3], SDIM, pn * 128, (bf16*)(ws + WS_WS13T), D, pn * 256 + 128, D, 128, tctr, bid, nb, tile);
    }
    transpose_job(a.in[I_WS2], D, 0, (bf16*)(ws + WS_WS2T), SDIM, 0, SDIM, D, tctr, bid, nb, tile);
    transpose_job(a.in[I_WG], D, 0, (bf16*)(ws + WS_WGT), D, 0, D, D, tctr, bid, nb, tile);
    transpose_job(a.in[I_WP], D, 0, (bf16*)(ws + WS_WPT), PLE, 0, PLE, D, tctr, bid, nb, tile);
    transpose_job(a.in[I_WR], NE, 0, (bf16*)(ws + WS_WRT), D, 0, D, NE, tctr, bid, nb, tile);
    {
        const size_t n8 = (size_t)T * D / 8;
        const float* x = a.in[I_X]; bf16* xb = (bf16*)(ws + WS_XB);
        for (size_t i = (size_t)bid * NTHREADS + tid; i < n8; i += (size_t)nb * NTHREADS) {
            const f32x4 v0 = *(const f32x4*)(x + i * 8), v1 = *(const f32x4*)(x + i * 8 + 4);
            u32x4 w; w.x = cvt_pk_bf16(v0[0], v0[1]); w.y = cvt_pk_bf16(v0[2], v0[3]); w.z = cvt_pk_bf16(v1[0], v1[1]); w.w = cvt_pk_bf16(v1[2], v1[3]);
            *(u32x4*)(xb + i * 8) = w;
        }
        const size_t m8 = (size_t)T * PLE / 8;
        const float* p = a.in[I_P]; bf16* pb = (bf16*)(ws + WS_PB);
        for (size_t i = (size_t)bid * NTHREADS + tid; i < m8; i += (size_t)nb * NTHREADS) {
            const f32x4 v0 = *(const f32x4*)(p + i * 8), v1 = *(const f32x4*)(p + i * 8 + 4);
            u32x4 w; w.x = cvt_pk_bf16(v0[0], v0[1]); w.y = cvt_pk_bf16(v0[2], v0[3]); w.z = cvt_pk_bf16(v1[0], v1[1]); w.w = cvt_pk_bf16(v1[2], v1[3]);
            *(u32x4*)(pb + i * 8) = w;
        }
    }
    {
        float* tab = (float*)(ws + WS_TAB);
        float* cosr = tab, *sinr = tab + SEQ * 32, *coss = tab + SEQ * 64, *sins = tab + SEQ * 72;
        for (int i = bid * NTHREADS + tid; i < SEQ * 40; i += nb * NTHREADS) {
            const int s = i / 40, j = i % 40;
            if (j < 32) {
                const float inv = (float)pow(10000.0, -(double)j / 32.0);
                const float ang = (float)s * inv;
                cosr[s * 32 + j] = (float)cos((double)ang); sinr[s * 32 + j] = (float)sin((double)ang);
            } else {
                const int jj = j - 32;
                const float inv = (float)pow(500000.0, -(double)jj / 8.0);
                const float ang = (float)s * inv;
                coss[s * 8 + jj] = (float)cos((double)ang); sins[s * 8 + jj] = (float)sin((double)ang);
            }
        }
    }
}

__device__ __forceinline__ int perm32(int rho) { const int n = rho >> 4, i = rho & 15; return 8 * (i >> 2) + 4 * n + (i & 3); }

struct GemmPart { const bf16* A; int lda; const int* rowidx; long arow0; const bf16* Bt; int ldb; int K; };

__device__ __forceinline__ void gemm_part(f32x4 (&acc)[2][2][4][2], const GemmPart& g, int wr, int wc, int fr, int fq) {
    unsigned oa[2][4], ob[2][2];
#pragma unroll
    for (int ai = 0; ai < 2; ++ai)
#pragma unroll
        for (int m = 0; m < 4; ++m) {
            const int r = 128 * ai + 64 * wr + 16 * m + fr;
            const long gr = g.rowidx ? (long)g.rowidx[r] : g.arow0 + r;
            oa[ai][m] = (unsigned)((gr * g.lda + 8 * fq) * 2);
        }
#pragma unroll
    for (int bj = 0; bj < 2; ++bj)
#pragma unroll
        for (int n = 0; n < 2; ++n) {
            const int rb = 128 * bj + 32 * wc + perm32(16 * n + fr);
            ob[bj][n] = (unsigned)((rb * g.ldb + 8 * fq) * 2);
        }
    const char* pA = (const char*)g.A; const char* pB = (const char*)g.Bt;
#pragma unroll 1
    for (int k0 = 0; k0 < g.K; k0 += 32) {
        bf16x8 af[2][4], bfr[2][2];
#pragma unroll
        for (int ai = 0; ai < 2; ++ai)
#pragma unroll
            for (int m = 0; m < 4; ++m) af[ai][m] = *(const bf16x8*)(pA + oa[ai][m]);
#pragma unroll
        for (int bj = 0; bj < 2; ++bj)
#pragma unroll
            for (int n = 0; n < 2; ++n) bfr[bj][n] = *(const bf16x8*)(pB + ob[bj][n]);
#pragma unroll
        for (int ai = 0; ai < 2; ++ai)
#pragma unroll
            for (int bj = 0; bj < 2; ++bj)
#pragma unroll
                for (int m = 0; m < 4; ++m)
#pragma unroll
                    for (int n = 0; n < 2; ++n)
                        acc[ai][bj][m][n] = __builtin_amdgcn_mfma_f32_16x16x32_bf16(bfr[bj][n], af[ai][m], acc[ai][bj][m][n], 0, 0, 0);
        pA += 64; pB += 64;
    }
}
__device__ __forceinline__ void zero_acc(f32x4 (&acc)[2][2][4][2]) {
#pragma unroll
    for (int a = 0; a < 2; ++a)
#pragma unroll
        for (int b = 0; b < 2; ++b)
#pragma unroll
            for (int m = 0; m < 4; ++m)
#pragma unroll
                for (int n = 0; n < 2; ++n) acc[a][b][m][n] = (f32x4){0.f, 0.f, 0.f, 0.f};
}
#define WAVE_IDS() const int tid = threadIdx.x, wid = __builtin_amdgcn_readfirstlane(tid >> 6), lane = tid & 63, wr = wid >> 2, wc = wid & 3, fr = lane & 15, fq = lane >> 4; (void)lane; (void)wr; (void)wc; (void)fr; (void)fq

__device__ __forceinline__ void epi_bf16(const f32x4 (&acc)[2][2][4][2], bf16* O, int ldo, long row0, int col0, int wr, int wc, int fr, int fq) {
#pragma unroll
    for (int ai = 0; ai < 2; ++ai)
#pragma unroll
        for (int m = 0; m < 4; ++m) {
            bf16* rp = O + (size_t)(row0 + 128 * ai + 64 * wr + 16 * m + fr) * ldo + col0 + 32 * wc + 8 * fq;
#pragma unroll
            for (int bj = 0; bj < 2; ++bj) {
                const f32x4 v0 = acc[ai][bj][m][0], v1 = acc[ai][bj][m][1];
                u32x4 w; w.x = cvt_pk_bf16(v0[0], v0[1]); w.y = cvt_pk_bf16(v0[2], v0[3]); w.z = cvt_pk_bf16(v1[0], v1[1]); w.w = cvt_pk_bf16(v1[2], v1[3]);
                *(u32x4*)(rp + 128 * bj) = w;
            }
        }
}
__device__ __forceinline__ void epi_gate(const f32x4 (&acc)[2][2][4][2], bf16* O, int ldo, long row0, int col0, int wr, int wc, int fr, int fq) {
#pragma unroll
    for (int ai = 0; ai < 2; ++ai)
#pragma unroll
        for (int m = 0; m < 4; ++m) {
            bf16* rp = O + (size_t)(row0 + 128 * ai + 64 * wr + 16 * m + fr) * ldo + col0 + 32 * wc + 8 * fq;
            float h[8];
#pragma unroll
            for (int n = 0; n < 2; ++n)
#pragma unroll
                for (int j = 0; j < 4; ++j) h[4 * n + j] = siluf_(acc[ai][0][m][n][j]) * acc[ai][1][m][n][j];
            u32x4 w; w.x = cvt_pk_bf16(h[0], h[1]); w.y = cvt_pk_bf16(h[2], h[3]); w.z = cvt_pk_bf16(h[4], h[5]); w.w = cvt_pk_bf16(h[6], h[7]);
            *(u32x4*)rp = w;
        }
}

__device__ void phase_proj(const Args& a, int bid, int nb) {
    WAVE_IDS();
    const bf16* xb = (const bf16*)(a.ws + WS_XB); const bf16* wt = (const bf16*)(a.ws + WS_WINT); bf16* proj = (bf16*)(a.ws + WS_BIG);
    const int nN = INW / 256, nU = (T / 256) * nN;
    for (int u = bid; u < nU; u += nb) {
        const int pm = u / nN, pn = u % nN;
        f32x4 acc[2][2][4][2]; zero_acc(acc);
        GemmPart g{xb, D, nullptr, (long)pm * 256, wt + (size_t)pn * 256 * D, D, D};
        gemm_part(acc, g, wr, wc, fr, fq);
        epi_bf16(acc, proj, INW, (long)pm * 256, pn * 256, wr, wc, fr, fq);
    }
}

constexpr int QS = 72;
constexpr int TS = 136;
constexpr int TS2 = 264;
constexpr int L_QS = 0;
constexpr int L_KS = L_QS + 128 * QS * 2;
constexpr int L_KTW = L_KS + 256 * QS * 2;
constexpr int L_VT = L_KTW + 64 * TS * 2;
constexpr int L_ST = L_VT + 64 * TS2 * 2;
constexpr int L_MIX_END = L_ST + 64 * QS * 2;
static_assert(L_MIX_END <= 128 * 1024, "mixer LDS");

__device__ __forceinline__ void stage_ret(const Args& a, LAS unsigned char* lds, int b, int h, int n, bool want_q, float l2g) {
    const int tid = threadIdx.x;
    const bf16* proj = (const bf16*)(a.ws + WS_BIG);
    const float* tab = (const float*)(a.ws + WS_TAB);
    const float* cosr = tab, *sinr = tab + SEQ * 32;
    LAS bf16* Qs = (LAS bf16*)(lds + L_QS); LAS bf16* Ks = (LAS bf16*)(lds + L_KS); LAS bf16* Ktw = (LAS bf16*)(lds + L_KTW); LAS bf16* Vt = (LAS bf16*)(lds + L_VT);
    const int row = tid >> 2, i0 = (tid & 3) * 8;
    const int pos = n * CH + row;
    const size_t t = (size_t)b * SEQ + pos;
    const bf16* prow = proj + t * INW;
    f32x4 c0 = *(const f32x4*)(cosr + pos * 32 + i0), c1 = *(const f32x4*)(cosr + pos * 32 + i0 + 4);
    f32x4 s0 = *(const f32x4*)(sinr + pos * 32 + i0), s1 = *(const f32x4*)(sinr + pos * 32 + i0 + 4);
    float cs[8] = {c0[0], c0[1], c0[2], c0[3], c1[0], c1[1], c1[2], c1[3]}, sn[8] = {s0[0], s0[1], s0[2], s0[3], s1[0], s1[1], s1[2], s1[3]};
    if (want_q) {
        const bf16x8 x1 = *(const bf16x8*)(prow + C_RQ + h * 64 + i0), x2 = *(const bf16x8*)(prow + C_RQ + h * 64 + 32 + i0);
        float o1[8], o2[8];
#pragma unroll
        for (int j = 0; j < 8; ++j) { const float a1 = bf2f((unsigned short)x1[j]), a2 = bf2f((unsigned short)x2[j]); o1[j] = a1 * cs[j] - a2 * sn[j]; o2[j] = a2 * cs[j] + a1 * sn[j]; }
        u32x4 w1, w2;
        w1.x = cvt_pk_bf16(o1[0], o1[1]); w1.y = cvt_pk_bf16(o1[2], o1[3]); w1.z = cvt_pk_bf16(o1[4], o1[5]); w1.w = cvt_pk_bf16(o1[6], o1[7]);
        w2.x = cvt_pk_bf16(o2[0], o2[1]); w2.y = cvt_pk_bf16(o2[2], o2[3]); w2.z = cvt_pk_bf16(o2[4], o2[5]); w2.w = cvt_pk_bf16(o2[6], o2[7]);
        *(LAS u32x4*)(Qs + row * QS + i0) = w1; *(LAS u32x4*)(Qs + row * QS + 32 + i0) = w2;
    }
    {
        const bf16x8 x1 = *(const bf16x8*)(prow + C_RK + h * 64 + i0), x2 = *(const bf16x8*)(prow + C_RK + h * 64 + 32 + i0);
        const float kw = exp2f((float)(CH - 1 - row) * l2g);
        float o1[8], o2[8];
#pragma unroll
        for (int j = 0; j < 8; ++j) { const float a1 = bf2f((unsigned short)x1[j]), a2 = bf2f((unsigned short)x2[j]); o1[j] = (a1 * cs[j] - a2 * sn[j]) * 0.125f; o2[j] = (a2 * cs[j] + a1 * sn[j]) * 0.125f; }
        if (want_q) {
            u32x4 w1, w2;
            w1.x = cvt_pk_bf16(o1[0], o1[1]); w1.y = cvt_pk_bf16(o1[2], o1[3]); w1.z = cvt_pk_bf16(o1[4], o1[5]); w1.w = cvt_pk_bf16(o1[6], o1[7]);
            w2.x = cvt_pk_bf16(o2[0], o2[1]); w2.y = cvt_pk_bf16(o2[2], o2[3]); w2.z = cvt_pk_bf16(o2[4], o2[5]); w2.w = cvt_pk_bf16(o2[6], o2[7]);
            *(LAS u32x4*)(Ks + row * QS + i0) = w1; *(LAS u32x4*)(Ks + row * QS + 32 + i0) = w2;
        }
#pragma unroll
        for (int j = 0; j < 8; ++j) { Ktw[(i0 + j) * TS + row] = f2bf(o1[j] * kw); Ktw[(32 + i0 + j) * TS + row] = f2bf(o2[j] * kw); }
    }
    {
        const bf16x8 v1 = *(const bf16x8*)(prow + C_RV + h * 64 + i0), v2 = *(const bf16x8*)(prow + C_RV + h * 64 + 32 + i0);
#pragma unroll
        for (int j = 0; j < 8; ++j) { Vt[(i0 + j) * TS2 + row] = (bf16)v1[j]; Vt[(32 + i0 + j) * TS2 + row] = (bf16)v2[j]; }
    }
}
__device__ __forceinline__ void ret_kv(LAS unsigned char* lds, int wid, int fr, int fq, f32x4 (&kv)[2]) {
    LAS bf16* Ktw = (LAS bf16*)(lds + L_KTW); LAS bf16* Vt = (LAS bf16*)(lds + L_VT);
#pragma unroll
    for (int i = 0; i < 2; ++i) {
        const int tl = 2 * wid + i, dt = tl >> 2, et = tl & 3;
        f32x4 c = {0.f, 0.f, 0.f, 0.f};
#pragma unroll
        for (int ks = 0; ks < 4; ++ks) {
            const bf16x8 kf = *(const LAS bf16x8*)(Ktw + (16 * dt + fr) * TS + 32 * ks + 8 * fq);
            const bf16x8 vf = *(const LAS bf16x8*)(Vt + (16 * et + fr) * TS2 + 32 * ks + 8 * fq);
            c = __builtin_amdgcn_mfma_f32_16x16x32_bf16(kf, vf, c, 0, 0, 0);
        }
        kv[i] = c;
    }
}
__device__ __forceinline__ float head_l2g(int h) { return log2f(1.0f - exp2f(-5.0f - (float)h)); }

__device__ void phase_segtot(const Args& a, LAS unsigned char* lds, int bid, int nb) {
    WAVE_IDS();
    float* segt = (float*)(a.ws + WS_SEGT);
    for (int it = bid; it < BATCH * RH * NSEG; it += nb) {
        const int seg = it % NSEG, h = (it / NSEG) % RH, b = it / (NSEG * RH);
        const float l2g = head_l2g(h), cd = exp2f(128.0f * l2g);
        f32x4 S[2] = {{0.f, 0.f, 0.f, 0.f}, {0.f, 0.f, 0.f, 0.f}};
        for (int c = 0; c < SEGC; ++c) {
            __syncthreads();
            stage_ret(a, lds, b, h, seg * SEGC + c, false, l2g);
            __syncthreads();
            f32x4 kv[2]; ret_kv(lds, wid, fr, fq, kv);
            S[0] = S[0] * cd + kv[0]; S[1] = S[1] * cd + kv[1];
        }
        float* dst = segt + (size_t)((b * RH + h) * NSEG + seg) * 4096;
#pragma unroll
        for (int i = 0; i < 2; ++i) { const int tl = 2 * wid + i, dt = tl >> 2, et = tl & 3;
#pragma unroll
            for (int j = 0; j < 4; ++j) dst[(16 * dt + 4 * fq + j) * 64 + 16 * et + fr] = S[i][j]; }
    }
}

__device__ void phase_retention(const Args& a, LAS unsigned char* lds, int bid, int nb) {
    WAVE_IDS();
    const float* segt = (const float*)(a.ws + WS_SEGT);
    const bf16* proj = (const bf16*)(a.ws + WS_BIG);
    bf16* mixo = (bf16*)(a.ws + WS_MIXO);
    const float* gain = a.in[I_GN];
    LAS bf16* Qs = (LAS bf16*)(lds + L_QS); LAS bf16* Ks = (LAS bf16*)(lds + L_KS); LAS bf16* Vt = (LAS bf16*)(lds + L_VT); LAS bf16* St = (LAS bf16*)(lds + L_ST);
    for (int it = bid; it < BATCH * RH * NSEG; it += nb) {
        const int seg = it % NSEG, h = (it / NSEG) % RH, b = it / (NSEG * RH);
        const float l2g = head_l2g(h), cd = exp2f(128.0f * l2g);
        f32x4 S[2] = {{0.f, 0.f, 0.f, 0.f}, {0.f, 0.f, 0.f, 0.f}};
        for (int sp = 0; sp < seg; ++sp) {
            const float wgt = exp2f(128.0f * l2g * (float)(SEGC * (seg - 1 - sp)));
            const float* src = segt + (size_t)((b * RH + h) * NSEG + sp) * 4096;
#pragma unroll
            for (int i = 0; i < 2; ++i) { const int tl = 2 * wid + i, dt = tl >> 2, et = tl & 3;
#pragma unroll
                for (int j = 0; j < 4; ++j) S[i][j] += wgt * src[(16 * dt + 4 * fq + j) * 64 + 16 * et + fr]; }
        }
        for (int c = 0; c < SEGC; ++c) {
            const int n = seg * SEGC + c;
            __syncthreads();
            stage_ret(a, lds, b, h, n, true, l2g);
#pragma unroll
            for (int i = 0; i < 2; ++i) { const int tl = 2 * wid + i, dt = tl >> 2, et = tl & 3;
                u32x2 w; w.x = cvt_pk_bf16(S[i][0], S[i][1]); w.y = cvt_pk_bf16(S[i][2], S[i][3]);
                *(LAS u32x2*)(St + (16 * et + fr) * QS + 16 * dt + 4 * fq) = w; }
            __syncthreads();
            bf16x8 qf[2];
#pragma unroll
            for (int ks = 0; ks < 2; ++ks) qf[ks] = *(const LAS bf16x8*)(Qs + (16 * wid + fr) * QS + 32 * ks + 8 * fq);
            f32x4 sc[8];
#pragma unroll
            for (int jt = 0; jt < 8; ++jt) {
                sc[jt] = (f32x4){0.f, 0.f, 0.f, 0.f};
                if (jt <= wid) {
#pragma unroll
                    for (int ks = 0; ks < 2; ++ks) {
                        const bf16x8 kf = *(const LAS bf16x8*)(Ks + (16 * jt + fr) * QS + 32 * ks + 8 * fq);
                        sc[jt] = __builtin_amdgcn_mfma_f32_16x16x32_bf16(kf, qf[ks], sc[jt], 0, 0, 0);
                    }
                    const int i = 16 * wid + fr;
#pragma unroll
                    for (int r = 0; r < 4; ++r) { const int j = 16 * jt + 4 * fq + r; const float dcy = exp2f((float)(i - j) * l2g); sc[jt][r] = (i >= j) ? sc[jt][r] * dcy : 0.f; }
                    asm volatile("" : "+v"(sc[jt]) :: "memory");
                }
            }
            f32x4 o[4], oi[4];
#pragma unroll
            for (int et = 0; et < 4; ++et) { o[et] = (f32x4){0.f, 0.f, 0.f, 0.f}; oi[et] = (f32x4){0.f, 0.f, 0.f, 0.f}; }
#pragma unroll
            for (int k2 = 0; k2 < 4; ++k2) {
                if (2 * k2 <= wid) {
                    bf16x8 pf; u32x4 pw;
                    pw.x = cvt_pk_bf16(sc[2 * k2][0], sc[2 * k2][1]); pw.y = cvt_pk_bf16(sc[2 * k2][2], sc[2 * k2][3]);
                    pw.z = cvt_pk_bf16(sc[2 * k2 + 1][0], sc[2 * k2 + 1][1]); pw.w = cvt_pk_bf16(sc[2 * k2 + 1][2], sc[2 * k2 + 1][3]);
                    pf = __builtin_bit_cast(bf16x8, pw);
#pragma unroll
                    for (int et = 0; et < 4; ++et) {
                        const u32x2 va = *(const LAS u32x2*)(Vt + (16 * et + fr) * TS2 + 32 * k2 + 4 * fq);
                        const u32x2 vb = *(const LAS u32x2*)(Vt + (16 * et + fr) * TS2 + 32 * k2 + 16 + 4 * fq);
                        u32x4 vw; vw.x = va.x; vw.y = va.y; vw.z = vb.x; vw.w = vb.y;
                        o[et] = __builtin_amdgcn_mfma_f32_16x16x32_bf16(__builtin_bit_cast(bf16x8, vw), pf, o[et], 0, 0, 0);
                    }
                }
            }
#pragma unroll
            for (int et = 0; et < 4; ++et)
#pragma unroll
                for (int ks = 0; ks < 2; ++ks) {
                    const bf16x8 sf = *(const LAS bf16x8*)(St + (16 * et + fr) * QS + 32 * ks + 8 * fq);
                    oi[et] = __builtin_amdgcn_mfma_f32_16x16x32_bf16(sf, qf[ks], oi[et], 0, 0, 0);
                }
            {
                const int i = 16 * wid + fr;
                const float qw = exp2f((float)(i + 1) * l2g);
                float sum = 0.f;
#pragma unroll
                for (int et = 0; et < 4; ++et)
#pragma unroll
                    for (int r = 0; r < 4; ++r) { o[et][r] += qw * oi[et][r]; sum += o[et][r]; }
                sum += __shfl_xor(sum, 16); sum += __shfl_xor(sum, 32);
                const float mean = sum * (1.0f / 64.0f);
                float q = 0.f;
#pragma unroll
                for (int et = 0; et < 4; ++et)
#pragma unroll
                    for (int r = 0; r < 4; ++r) { const float d = o[et][r] - mean; q += d * d; }
                q += __shfl_xor(q, 16); q += __shfl_xor(q, 32);
                const float rstd = rsqrtf(q * (1.0f / 64.0f) + GN_EPS);
                const size_t t = (size_t)b * SEQ + n * CH + i;
#pragma unroll
                for (int et = 0; et < 4; ++et) {
                    const int e0 = 16 * et + 4 * fq;
                    const u32x2 gw = *(const u32x2*)(proj + t * INW + C_RG + h * 64 + e0);
                    const f32x4 gn = *(const f32x4*)(gain + h * 64 + e0);
                    const float g0 = bf2f(gw.x & 0xffffu), g1 = bf2f(gw.x >> 16), g2 = bf2f(gw.y & 0xffffu), g3 = bf2f(gw.y >> 16);
                    const float y0 = (o[et][0] - mean) * rstd * gn[0] * siluf_(g0), y1 = (o[et][1] - mean) * rstd * gn[1] * siluf_(g1);
                    const float y2 = (o[et][2] - mean) * rstd * gn[2] * siluf_(g2), y3 = (o[et][3] - mean) * rstd * gn[3] * siluf_(g3);
                    u32x2 w; w.x = cvt_pk_bf16(y0, y1); w.y = cvt_pk_bf16(y2, y3);
                    *(u32x2*)(mixo + t * D + h * 64 + e0) = w;
                }
            }
            f32x4 kv[2]; ret_kv(lds, wid, fr, fq, kv);
            S[0] = S[0] * cd + kv[0]; S[1] = S[1] * cd + kv[1];
        }
    }
}

__device__ void phase_swa(const Args& a, LAS unsigned char* lds, int bid, int nb) {
    WAVE_IDS();
    const bf16* proj = (const bf16*)(a.ws + WS_BIG);
    bf16* mixo = (bf16*)(a.ws + WS_MIXO);
    const float* tab = (const float*)(a.ws + WS_TAB);
    const float* coss = tab + SEQ * 64, *sins = tab + SEQ * 72;
    const float* ascale = a.in[I_ASC]; const float* sinks = a.in[I_SINK];
    LAS bf16* Qs = (LAS bf16*)(lds + L_QS); LAS bf16* Ks = (LAS bf16*)(lds + L_KS); LAS bf16* Vt = (LAS bf16*)(lds + L_VT);
    for (int it = bid; it < BATCH * NCH * QH; it += nb) {
        const int qh = it % QH, n = (it / QH) % NCH, b = it / (QH * NCH), kvh = qh >> 2;
        __syncthreads();
        {
            const int row = tid >> 2, cg = tid & 3, pos = n * CH + row;
            const bf16* src = proj + ((size_t)b * SEQ + pos) * INW + C_AQ + qh * 64 + cg * 16;
            bf16x8 x1 = *(const bf16x8*)src, x2 = *(const bf16x8*)(src + 8);
            if (cg == 0) {
                const f32x4 c0 = *(const f32x4*)(coss + pos * 8), c1 = *(const f32x4*)(coss + pos * 8 + 4), s0 = *(const f32x4*)(sins + pos * 8), s1 = *(const f32x4*)(sins + pos * 8 + 4);
                const float cs[8] = {c0[0], c0[1], c0[2], c0[3], c1[0], c1[1], c1[2], c1[3]}, sn[8] = {s0[0], s0[1], s0[2], s0[3], s1[0], s1[1], s1[2], s1[3]};
                float o1[8], o2[8];
#pragma unroll
                for (int j = 0; j < 8; ++j) { const float a1 = bf2f((unsigned short)x1[j]), a2 = bf2f((unsigned short)x2[j]); o1[j] = a1 * cs[j] - a2 * sn[j]; o2[j] = a2 * cs[j] + a1 * sn[j]; }
                u32x4 w1, w2;
                w1.x = cvt_pk_bf16(o1[0], o1[1]); w1.y = cvt_pk_bf16(o1[2], o1[3]); w1.z = cvt_pk_bf16(o1[4], o1[5]); w1.w = cvt_pk_bf16(o1[6], o1[7]);
                w2.x = cvt_pk_bf16(o2[0], o2[1]); w2.y = cvt_pk_bf16(o2[2], o2[3]); w2.z = cvt_pk_bf16(o2[4], o2[5]); w2.w = cvt_pk_bf16(o2[6], o2[7]);
                x1 = __builtin_bit_cast(bf16x8, w1); x2 = __builtin_bit_cast(bf16x8, w2);
            }
            *(LAS bf16x8*)(Qs + row * QS + cg * 16) = x1; *(LAS bf16x8*)(Qs + row * QS + cg * 16 + 8) = x2;
        }
#pragma unroll
        for (int rep = 0; rep < 2; ++rep) {
            const int q = tid + rep * NTHREADS, kj = q >> 2, cg = q & 3, pos = n * CH - CH + kj;
            bf16x8 k1 = {0, 0, 0, 0, 0, 0, 0, 0}, k2 = k1, v1 = k1, v2 = k1;
            if (pos >= 0) {
                const bf16* srow = proj + ((size_t)b * SEQ + pos) * INW;
                k1 = *(const bf16x8*)(srow + C_AK + kvh * 64 + cg * 16); k2 = *(const bf16x8*)(srow + C_AK + kvh * 64 + cg * 16 + 8);
                v1 = *(const bf16x8*)(srow + C_AV + kvh * 64 + cg * 16); v2 = *(const bf16x8*)(srow + C_AV + kvh * 64 + cg * 16 + 8);
                if (cg == 0) {
                    const f32x4 c0 = *(const f32x4*)(coss + pos * 8), c1 = *(const f32x4*)(coss + pos * 8 + 4), s0 = *(const f32x4*)(sins + pos * 8), s1 = *(const f32x4*)(sins + pos * 8 + 4);
                    const float cs[8] = {c0[0], c0[1], c0[2], c0[3], c1[0], c1[1], c1[2], c1[3]}, sn[8] = {s0[0], s0[1], s0[2], s0[3], s1[0], s1[1], s1[2], s1[3]};
                    float o1[8], o2[8];
#pragma unroll
                    for (int j = 0; j < 8; ++j) { const float a1 = bf2f((unsigned short)k1[j]), a2 = bf2f((unsigned short)k2[j]); o1[j] = a1 * cs[j] - a2 * sn[j]; o2[j] = a2 * cs[j] + a1 * sn[j]; }
                    u32x4 w1, w2;
                    w1.x = cvt_pk_bf16(o1[0], o1[1]); w1.y = cvt_pk_bf16(o1[2], o1[3]); w1.z = cvt_pk_bf16(o1[4], o1[5]); w1.w = cvt_pk_bf16(o1[6], o1[7]);
                    w2.x = cvt_pk_bf16(o2[0], o2[1]); w2.y = cvt_pk_bf16(o2[2], o2[3]); w2.z = cvt_pk_bf16(o2[4], o2[5]); w2.w = cvt_pk_bf16(o2[6], o2[7]);
                    k1 = __builtin_bit_cast(bf16x8, w1); k2 = __builtin_bit_cast(bf16x8, w2);
                }
            }
            *(LAS bf16x8*)(Ks + kj * QS + cg * 16) = k1; *(LAS bf16x8*)(Ks + kj * QS + cg * 16 + 8) = k2;
#pragma unroll
            for (int j = 0; j < 8; ++j) { Vt[(cg * 16 + j) * TS2 + kj] = (bf16)v1[j]; Vt[(cg * 16 + 8 + j) * TS2 + kj] = (bf16)v2[j]; }
        }
        __syncthreads();
        const int jt0 = wid & ~1;
        bf16x8 qf[2];
#pragma unroll
        for (int ks = 0; ks < 2; ++ks) qf[ks] = *(const LAS bf16x8*)(Qs + (16 * wid + fr) * QS + 32 * ks + 8 * fq);
        f32x4 sc[10];
        const int i = 16 * wid + fr;
        float mx = sinks[qh];
#pragma unroll
        for (int tt = 0; tt < 10; ++tt) {
            const int jt = jt0 + tt;
            f32x4 c = {0.f, 0.f, 0.f, 0.f};
#pragma unroll
            for (int ks = 0; ks < 2; ++ks) {
                const bf16x8 kf = *(const LAS bf16x8*)(Ks + (16 * jt + fr) * QS + 32 * ks + 8 * fq);
                c = __builtin_amdgcn_mfma_f32_16x16x32_bf16(kf, qf[ks], c, 0, 0, 0);
            }
#pragma unroll
            for (int r = 0; r < 4; ++r) {
                const int kj = 16 * jt + 4 * fq + r;
                const bool valid = (kj > i) && (kj <= i + CH) && (n * CH - CH + kj >= 0);
                c[r] = valid ? c[r] * 0.125f : -1e30f;
                mx = fmaxf(mx, c[r]);
            }
            sc[tt] = c;
        }
        mx = fmaxf(mx, __shfl_xor(mx, 16)); mx = fmaxf(mx, __shfl_xor(mx, 32));
        float den = 0.f;
#pragma unroll
        for (int tt = 0; tt < 10; ++tt)
#pragma unroll
            for (int r = 0; r < 4; ++r) { const float p = (sc[tt][r] > -1e29f) ? __expf(sc[tt][r] - mx) : 0.f; sc[tt][r] = p; den += p; }
        den += __shfl_xor(den, 16); den += __shfl_xor(den, 32);
        den += __expf(sinks[qh] - mx);
        const float inv = 1.0f / den;
        f32x4 o[4];
#pragma unroll
        for (int et = 0; et < 4; ++et) o[et] = (f32x4){0.f, 0.f, 0.f, 0.f};
#pragma unroll
        for (int k2 = 0; k2 < 5; ++k2) {
            u32x4 pw;
            pw.x = cvt_pk_bf16(sc[2 * k2][0] * inv, sc[2 * k2][1] * inv); pw.y = cvt_pk_bf16(sc[2 * k2][2] * inv, sc[2 * k2][3] * inv);
            pw.z = cvt_pk_bf16(sc[2 * k2 + 1][0] * inv, sc[2 * k2 + 1][1] * inv); pw.w = cvt_pk_bf16(sc[2 * k2 + 1][2] * inv, sc[2 * k2 + 1][3] * inv);
            const bf16x8 pf = __builtin_bit_cast(bf16x8, pw);
            const int kb = 16 * (jt0 + 2 * k2);
#pragma unroll
            for (int et = 0; et < 4; ++et) {
                const u32x2 va = *(const LAS u32x2*)(Vt + (16 * et + fr) * TS2 + kb + 4 * fq);
                const u32x2 vb = *(const LAS u32x2*)(Vt + (16 * et + fr) * TS2 + kb + 16 + 4 * fq);
                u32x4 vw; vw.x = va.x; vw.y = va.y; vw.z = vb.x; vw.w = vb.y;
                o[et] = __builtin_amdgcn_mfma_f32_16x16x32_bf16(__builtin_bit_cast(bf16x8, vw), pf, o[et], 0, 0, 0);
            }
        }
        const size_t t = (size_t)b * SEQ + n * CH + i;
#pragma unroll
        for (int et = 0; et < 4; ++et) {
            const int e0 = 16 * et + 4 * fq;
            const f32x4 as = *(const f32x4*)(ascale + qh * 64 + e0);
            u32x2 w; w.x = cvt_pk_bf16(o[et][0] * as[0], o[et][1] * as[1]); w.y = cvt_pk_bf16(o[et][2] * as[2], o[et][3] * as[3]);
            *(u32x2*)(mixo + t * D + 512 + qh * 64 + e0) = w;
        }
    }
}

__device__ void phase_wout(const Args& a, int bid, int nb) {
    WAVE_IDS();
    const bf16* mixo = (const bf16*)(a.ws + WS_MIXO); const bf16* wt = (const bf16*)(a.ws + WS_WOUTT);
    const float* x = a.in[I_X]; float* y = a.out;
    const int nN = D / 256, nU = (T / 256) * nN;
    for (int u = bid; u < nU; u += nb) {
        const int pm = u / nN, pn = u % nN;
        f32x4 acc[2][2][4][2]; zero_acc(acc);
        GemmPart g{mixo, D, nullptr, (long)pm * 256, wt + (size_t)pn * 256 * D, D, D};
        gemm_part(acc, g, wr, wc, fr, fq);
#pragma unroll
        for (int ai = 0; ai < 2; ++ai)
#pragma unroll
            for (int m = 0; m < 4; ++m) {
                const size_t off = (size_t)(pm * 256 + 128 * ai + 64 * wr + 16 * m + fr) * D + pn * 256 + 32 * wc + 8 * fq;
#pragma unroll
                for (int bj = 0; bj < 2; ++bj)
#pragma unroll
                    for (int n = 0; n < 2; ++n) {
                        const f32x4 xv = *(const f32x4*)(x + off + 128 * bj + 4 * n);
                        *(f32x4*)(y + off + 128 * bj + 4 * n) = acc[ai][bj][m][n] + ALPHA * xv;
                    }
            }
    }
}

template <int MODE>
__device__ void phase_ln(const float* src, const float* g, const float* bta, bf16* dstb, float* dstf, int bid, int nb) {
    const int tid = threadIdx.x, wid = tid >> 6, lane = tid & 63;
    f32x4 gv[4], bv[4];
#pragma unroll
    for (int i = 0; i < 4; ++i) { gv[i] = *(const f32x4*)(g + 256 * i + lane * 4); bv[i] = *(const f32x4*)(bta + 256 * i + lane * 4); }
    for (int row = bid * 8 + wid; row < T; row += nb * 8) {
        const float* r = src + (size_t)row * D;
        f32x4 v[4]; float s = 0.f;
#pragma unroll
        for (int i = 0; i < 4; ++i) { v[i] = *(const f32x4*)(r + 256 * i + lane * 4); s += (v[i][0] + v[i][1]) + (v[i][2] + v[i][3]); }
#pragma unroll
        for (int o = 32; o >= 1; o >>= 1) s += __shfl_xor(s, o);
        const float mean = s * (1.0f / D);
        float q = 0.f;
#pragma unroll
        for (int i = 0; i < 4; ++i) { const f32x4 d = v[i] - mean; q += (d[0] * d[0] + d[1] * d[1]) + (d[2] * d[2] + d[3] * d[3]); }
#pragma unroll
        for (int o = 32; o >= 1; o >>= 1) q += __shfl_xor(q, o);
        const float rstd = rsqrtf(q * (1.0f / D) + LN_EPS);
#pragma unroll
        for (int i = 0; i < 4; ++i) {
            const f32x4 y = (v[i] - mean) * rstd * gv[i] + bv[i];
            if (MODE == 0) { u32x2 w; w.x = cvt_pk_bf16(y[0], y[1]); w.y = cvt_pk_bf16(y[2], y[3]); *(u32x2*)(dstb + (size_t)row * D + 256 * i + lane * 4) = w; }
            else *(f32x4*)(dstf + (size_t)row * D + 256 * i + lane * 4) = y;
        }
    }
}

__device__ void phase_router(const Args& a, LAS unsigned char* lds, int bid, int nb) {
    WAVE_IDS();
    const bf16* x1b = (const bf16*)(a.ws + WS_XB); const bf16* wrt = (const bf16*)(a.ws + WS_WRT);
    unsigned char* ro = a.ws + WS_ROUT;
    int* ridx = (int*)(ro + RO_RIDX); float* rw = (float*)(ro + RO_RW); int* cnt = (int*)(ro + RO_CNT);
    const float* rbias = a.in[I_RB];
    LAS float* lg = (LAS float*)lds;
    LAS float* bi = lg + 128 * 65;
    LAS int* hist = (LAS int*)(bi + 128 * 65);
    for (int u = bid; u < T / 128; u += nb) {
        __syncthreads();
        if (tid < 64) hist[tid] = 0;
        {
            f32x4 c[4];
#pragma unroll
            for (int et = 0; et < 4; ++et) c[et] = (f32x4){0.f, 0.f, 0.f, 0.f};
            const bf16* xa = x1b + (size_t)(u * 128 + 16 * wid + fr) * D + 8 * fq;
            for (int k0 = 0; k0 < D; k0 += 32) {
                const bf16x8 xf = *(const bf16x8*)(xa + k0);
#pragma unroll
                for (int et = 0; et < 4; ++et) {
                    const bf16x8 wf = *(const bf16x8*)(wrt + (size_t)(16 * et + fr) * D + k0 + 8 * fq);
                    c[et] = __builtin_amdgcn_mfma_f32_16x16x32_bf16(wf, xf, c[et], 0, 0, 0);
                }
            }
#pragma unroll
            for (int et = 0; et < 4; ++et)
#pragma unroll
                for (int r = 0; r < 4; ++r) {
                    const int e = 16 * et + 4 * fq + r; const float s = sigmoidf_(c[et][r]);
                    lg[(16 * wid + fr) * 65 + e] = s; bi[(16 * wid + fr) * 65 + e] = s + rbias[e];
                }
        }
        __syncthreads();
        if (tid < 128) {
            const LAS float* mb = bi + tid * 65; const LAS float* ms = lg + tid * 65;
            float gs[8];
#pragma unroll
            for (int g = 0; g < 8; ++g) {
                float m1 = -3e38f, m2 = -3e38f;
#pragma unroll
                for (int j = 0; j < 8; ++j) { const float v = mb[g * 8 + j]; if (v > m1) { m2 = m1; m1 = v; } else if (v > m2) m2 = v; }
                gs[g] = m1 + m2;
            }
            unsigned gmask = 0;
#pragma unroll
            for (int rnd = 0; rnd < 4; ++rnd) {
                float best = -3e38f; int bg = 0;
#pragma unroll
                for (int g = 0; g < 8; ++g) { const bool ok = !((gmask >> g) & 1u) && gs[g] > best; best = ok ? gs[g] : best; bg = ok ? g : bg; }
                gmask |= 1u << bg;
            }
            unsigned long long taken = 0ull;
            int sel[8]; float wsel[8]; float wsum = 0.f;
#pragma unroll
            for (int rnd = 0; rnd < 8; ++rnd) {
                float best = -3e38f; int be = 0;
#pragma unroll 1
                for (int e = 0; e < 64; ++e) {
                    const bool ok = ((gmask >> (e >> 3)) & 1u) && !((taken >> e) & 1ull);
                    const float v = mb[e];
                    if (ok && v > best) { best = v; be = e; }
                }
                taken |= 1ull << be;
                sel[rnd] = be; wsel[rnd] = ms[be]; wsum += wsel[rnd];
            }
            const float sc = ROUTED_SCALE / wsum;
            const size_t t = (size_t)u * 128 + tid;
#pragma unroll
            for (int k = 0; k < 8; ++k) { ridx[t * 8 + k] = sel[k]; rw[t * 8 + k] = wsel[k] * sc; __hip_atomic_fetch_add(&hist[sel[k]], 1, __ATOMIC_RELAXED, __HIP_MEMORY_SCOPE_WORKGROUP); }
        }
        __syncthreads();
        if (tid < 64) cnt[u * 64 + tid] = hist[tid];
    }
}

__device__ void phase_sort(const Args& a, LAS unsigned char* lds, int bid, int nb) {
    const int tid = threadIdx.x;
    unsigned char* ro = a.ws + WS_ROUT;
    const int* ridx = (const int*)(ro + RO_RIDX); const float* rw = (const float*)(ro + RO_RW); const int* cnt = (const int*)(ro + RO_CNT);
    int* stok = (int*)(ro + RO_STOK); int* dest = (int*)(ro + RO_DEST); float* rsc = (float*)(ro + RO_RSC); int* tile = (int*)(ro + RO_TILE);
    LAS int* tot = (LAS int*)lds; LAS int* pos0 = tot + 64; LAS int* lcnt = pos0 + 64; LAS int* base = lcnt + 64;
    constexpr int UPC = TC / 128;
    for (int u = bid; u < T / 128; u += nb) {
        const int c = u / UPC, ul = u % UPC;
        __syncthreads();
        if (tid < 64) {
            int tt = 0, pre = 0;
            for (int q = 0; q < UPC; ++q) { const int v = cnt[(c * UPC + q) * 64 + tid]; tt += v; pre += (q < ul) ? v : 0; }
            tot[tid] = tt; pos0[tid] = pre; lcnt[tid] = 0;
        }
        __syncthreads();
        if (tid == 0) { int acc = 0; for (int e = 0; e < 64; ++e) { base[e] = acc; acc += (tot[e] + 255) & ~255; } base[64] = acc; }
        __syncthreads();
        int* stok_c = stok + (size_t)c * RMAX; int* dest_c = dest + (size_t)c * RMAX; float* rsc_c = rsc + (size_t)c * RMAX;
#pragma unroll
        for (int rep = 0; rep < 2; ++rep) {
            const int pr = tid + rep * NTHREADS, tl = pr >> 3, k = pr & 7;
            const size_t t = (size_t)u * 128 + tl;
            const int e = ridx[t * 8 + k];
            const int rank = __hip_atomic_fetch_add(&lcnt[e], 1, __ATOMIC_RELAXED, __HIP_MEMORY_SCOPE_WORKGROUP);
            const int pos = base[e] + pos0[e] + rank;
            stok_c[pos] = (int)t; dest_c[pos] = (int)(t - (size_t)c * TC) * 8 + k; rsc_c[pos] = rw[t * 8 + k];
        }
        if (ul < 64) {
            const int e = ul, lo = base[e] + tot[e], hi = base[e + 1];
            for (int r = lo + tid; r < hi; r += NTHREADS) { stok_c[r] = c * TC; dest_c[r] = TC * 8; rsc_c[r] = 0.f; }
        }
        if (ul == 0) {
            const int ntl = base[64] / 256;
            for (int mt = tid; mt < ntl; mt += NTHREADS) { int e = 0; for (int q = 1; q < 64; ++q) e = (base[q] <= mt * 256) ? q : e; tile[c * 512 + mt] = e; }
            if (tid == 0) tile[c * 512 + 511] = ntl;
        }
    }
}

__device__ void phase_shared_pp(const Args& a, int bid, int nb) {
    WAVE_IDS();
    const bf16* x1b = (const bf16*)(a.ws + WS_XB); const bf16* pb = (const bf16*)(a.ws + WS_PB);
    const bf16* ws13 = (const bf16*)(a.ws + WS_WS13T); const bf16* wpt = (const bf16*)(a.ws + WS_WPT);
    bf16* hs = (bf16*)(a.ws + WS_HS); bf16* pp = (bf16*)(a.ws + WS_PP);
    const int nU1 = (T / 256) * 2, nU2 = (T / 256) * 4;
    for (int u = bid; u < nU1 + nU2; u += nb) {
        f32x4 acc[2][2][4][2]; zero_acc(acc);
        if (u < nU1) {
            const int pm = u / 2, pn = u % 2;
            GemmPart g{x1b, D, nullptr, (long)pm * 256, ws13 + (size_t)pn * 256 * D, D, D};
            gemm_part(acc, g, wr, wc, fr, fq);
            epi_gate(acc, hs, SDIM, (long)pm * 256, pn * 128, wr, wc, fr, fq);
        } else {
            const int v = u - nU1, pm = v / 4, pn = v % 4;
            GemmPart g{pb, PLE, nullptr, (long)pm * 256, wpt + (size_t)pn * 256 * PLE, PLE, PLE};
            gemm_part(acc, g, wr, wc, fr, fq);
            epi_bf16(acc, pp, D, (long)pm * 256, pn * 256, wr, wc, fr, fq);
        }
    }
}

__device__ void phase_moe_up(const Args& a, int c, int bid, int nb) {
    WAVE_IDS();
    unsigned char* ro = a.ws + WS_ROUT;
    const int* stok = (const int*)(ro + RO_STOK) + (size_t)c * RMAX; const int* tile = (const int*)(ro + RO_TILE) + c * 512;
    const bf16* x1b = (const bf16*)(a.ws + WS_XB); const bf16* w13 = (const bf16*)(a.ws + WS_W13T);
    bf16* hsort = (bf16*)(a.ws + WS_HSORT);
    const int ntl = tile[511];
    for (int u = bid; u < ntl * 2; u += nb) {
        const int mt = u >> 1, pn = u & 1, e = tile[mt];
        f32x4 acc[2][2][4][2]; zero_acc(acc);
        GemmPart g{x1b, D, stok + mt * 256, 0, w13 + ((size_t)e * 512 + pn * 256) * D, D, D};
        gemm_part(acc, g, wr, wc, fr, fq);
        epi_gate(acc, hsort, EDIM, (long)mt * 256, pn * 128, wr, wc, fr, fq);
    }
}
__device__ void phase_moe_down(const Args& a, int c, int bid, int nb) {
    WAVE_IDS();
    unsigned char* ro = a.ws + WS_ROUT;
    const int* dest = (const int*)(ro + RO_DEST) + (size_t)c * RMAX; const float* rsc = (const float*)(ro + RO_RSC) + (size_t)c * RMAX; const int* tile = (const int*)(ro + RO_TILE) + c * 512;
    const bf16* hsort = (const bf16*)(a.ws + WS_HSORT); const bf16* w2t = (const bf16*)(a.ws + WS_W2T);
    bf16* contrib = (bf16*)(a.ws + WS_CONTRIB);
    const int ntl = tile[511];
    for (int u = bid; u < ntl * 4; u += nb) {
        const int mt = u >> 2, pn = u & 3, e = tile[mt];
        f32x4 acc[2][2][4][2]; zero_acc(acc);
        GemmPart g{hsort, EDIM, nullptr, (long)mt * 256, w2t + ((size_t)e * D + pn * 256) * EDIM, EDIM, EDIM};
        gemm_part(acc, g, wr, wc, fr, fq);
#pragma unroll
        for (int ai = 0; ai < 2; ++ai)
#pragma unroll
            for (int m = 0; m < 4; ++m) {
                const int r = mt * 256 + 128 * ai + 64 * wr + 16 * m + fr;
                const int dr = dest[r]; const float s = rsc[r];
                bf16* rp = contrib + (size_t)dr * D + pn * 256 + 32 * wc + 8 * fq;
#pragma unroll
                for (int bj = 0; bj < 2; ++bj) {
                    const f32x4 v0 = acc[ai][bj][m][0] * s, v1 = acc[ai][bj][m][1] * s;
                    u32x4 w; w.x = cvt_pk_bf16(v0[0], v0[1]); w.y = cvt_pk_bf16(v0[2], v0[3]); w.z = cvt_pk_bf16(v1[0], v1[1]); w.w = cvt_pk_bf16(v1[2], v1[3]);
                    *(u32x4*)(rp + 128 * bj) = w;
                }
                asm volatile("" ::: "memory");
            }
    }
}
__device__ void phase_final(const Args& a, int c, int bid, int nb) {
    WAVE_IDS();
    const bf16* x1b = (const bf16*)(a.ws + WS_XB); const bf16* wgt = (const bf16*)(a.ws + WS_WGT); const bf16* ws2t = (const bf16*)(a.ws + WS_WS2T);
    const bf16* hs = (const bf16*)(a.ws + WS_HS); const bf16* pp = (const bf16*)(a.ws + WS_PP); const bf16* contrib = (const bf16*)(a.ws + WS_CONTRIB);
    const float* bg = a.in[I_BG]; float* y = a.out;
    const int nU = (TC / 256) * 4;
    for (int u = bid; u < nU; u += nb) {
        const int pml = u >> 2, pn = u & 3; const long row0 = (long)c * TC + pml * 256;
        f32x4 acc[2][2][4][2]; zero_acc(acc);
        GemmPart g0{x1b, D, nullptr, row0, wgt + (size_t)pn * 256 * D, D, D};
        gemm_part(acc, g0, wr, wc, fr, fq);
#pragma unroll
        for (int ai = 0; ai < 2; ++ai)
#pragma unroll
            for (int m = 0; m < 4; ++m) {
                const int rl = pml * 256 + 128 * ai + 64 * wr + 16 * m + fr;
                const size_t t = (size_t)c * TC + rl;
#pragma unroll
                for (int bj = 0; bj < 2; ++bj) {
                    const int col = pn * 256 + 128 * bj + 32 * wc + 8 * fq;
                    float v[8];
                    const f32x4 b0 = *(const f32x4*)(bg + col), b1 = *(const f32x4*)(bg + col + 4);
                    const u32x4 pw = *(const u32x4*)(pp + t * D + col), xw = *(const u32x4*)(x1b + t * D + col);
                    const unsigned pws[4] = {pw.x, pw.y, pw.z, pw.w}, xws[4] = {xw.x, xw.y, xw.z, xw.w};
#pragma unroll
                    for (int j = 0; j < 8; ++j) {
                        const float gacc = acc[ai][bj][m][j >> 2][j & 3] + ((j < 4) ? b0[j & 3] : b1[j & 3]);
                        const float ppv = (j & 1) ? bf2f(pws[j >> 1] >> 16) : bf2f(pws[j >> 1] & 0xffffu);
                        const float xv = (j & 1) ? bf2f(xws[j >> 1] >> 16) : bf2f(xws[j >> 1] & 0xffffu);
                        v[j] = sigmoidf_(gacc) * ppv + ALPHA * xv;
                    }
#pragma unroll
                    for (int k = 0; k < 8; ++k) {
                        if ((k & 3) == 0) asm volatile("" : "+v"(v[0]), "+v"(v[1]), "+v"(v[2]), "+v"(v[3]), "+v"(v[4]), "+v"(v[5]), "+v"(v[6]), "+v"(v[7]) :: "memory");
                        const u32x4 cw = *(const u32x4*)(contrib + ((size_t)rl * 8 + k) * D + col);
                        const unsigned cws[4] = {cw.x, cw.y, cw.z, cw.w};
#pragma unroll
                        for (int j = 0; j < 8; ++j) v[j] += (j & 1) ? bf2f(cws[j >> 1] >> 16) : bf2f(cws[j >> 1] & 0xffffu);
                    }
                    acc[ai][bj][m][0] = (f32x4){v[0], v[1], v[2], v[3]}; acc[ai][bj][m][1] = (f32x4){v[4], v[5], v[6], v[7]};
                    asm volatile("" : "+v"(acc[ai][bj][m][0]), "+v"(acc[ai][bj][m][1]) :: "memory");
                }
            }
        GemmPart g1{hs, SDIM, nullptr, row0, ws2t + (size_t)pn * 256 * SDIM, SDIM, SDIM};
        gemm_part(acc, g1, wr, wc, fr, fq);
#pragma unroll
        for (int ai = 0; ai < 2; ++ai)
#pragma unroll
            for (int m = 0; m < 4; ++m) {
                const size_t off = (size_t)(row0 + 128 * ai + 64 * wr + 16 * m + fr) * D + pn * 256 + 32 * wc + 8 * fq;
#pragma unroll
                for (int bj = 0; bj < 2; ++bj)
#pragma unroll
                    for (int n = 0; n < 2; ++n) *(f32x4*)(y + off + 128 * bj + 4 * n) = acc[ai][bj][m][n];
            }
    }
}


#define XB_TMO      128
#define XB_XCNT(j)  (256  + 64 * (j))
#define XB_XSUB(j)  (1280 + 64 * (j))
#define XB_XGEN(j)  (2304 + 64 * (j))
#define XB_TOP      3328
#define XB_TOPGEN   3392
#define XCD_BAR_WORDS 3456
#define XB_SPIN_CAP (1u << 18)

__device__ __forceinline__ unsigned xb_ld(unsigned* p)              { return __hip_atomic_load(p, __ATOMIC_RELAXED, __HIP_MEMORY_SCOPE_AGENT); }
__device__ __forceinline__ unsigned xb_add(unsigned* p, unsigned v) { return __hip_atomic_fetch_add(p, v, __ATOMIC_RELAXED, __HIP_MEMORY_SCOPE_AGENT); }
__device__ __forceinline__ unsigned xb_xcc_id() { return (unsigned)__builtin_amdgcn_s_getreg((3 << 11) | 20) & 0xFu; }
#define XB_SPIN(cond, bar) do { unsigned _sp = 0; while (cond) { __builtin_amdgcn_s_sleep(1); \
    if ((++_sp & 255u) == 0u) { if (xb_ld(&(bar)[XB_TMO])) break; if (_sp > XB_SPIN_CAP) { atomicAdd(&(bar)[XB_TMO], 1u); break; } } } } while (0)

struct XcdBarrier {
    unsigned* bar; unsigned x;
    volatile LAS unsigned* st;
};
__device__ __forceinline__ XcdBarrier xcd_barrier_post(unsigned* bar, volatile LAS unsigned* st) {
    XcdBarrier b; b.bar = bar; b.x = xb_xcc_id(); b.st = st;
    if (threadIdx.x == 0) (void)xb_add(&bar[XB_XCNT(b.x)], 1u);
    return b;
}
__device__ __forceinline__ void xcd_barrier_complete(unsigned* bar, unsigned x, unsigned& nloc, unsigned& nx) {
    const unsigned G = gridDim.x * gridDim.y * gridDim.z;
    unsigned sum, cnt, mine, sp = 0u;
    for (;;) {
        sum = 0u; cnt = 0u; mine = 0u;
#pragma unroll
        for (unsigned j = 0; j < 16; ++j) { const unsigned c = xb_ld(&bar[XB_XCNT(j)]); sum += c; cnt += (c > 0u) ? 1u : 0u; mine = (j == x) ? c : mine; }
        if (sum == G) break;
        __builtin_amdgcn_s_sleep(1);
        if ((++sp & 255u) == 0u) { if (xb_ld(&bar[XB_TMO])) break; if (sp > XB_SPIN_CAP) { atomicAdd(&bar[XB_TMO], 1u); break; } }
    }
    nloc = mine > 0u ? mine : 1u; nx = cnt > 0u ? cnt : 1u;
}
__device__ __forceinline__ void xcd_barrier(const XcdBarrier& b) {
    asm volatile("s_waitcnt vmcnt(0)" ::: "memory");
    __syncthreads();
    if (threadIdx.x == 0) {
        unsigned* bar = b.bar;
        __builtin_amdgcn_s_waitcnt(0);
        unsigned nloc = b.st[0], nx = b.st[1];
        if (nloc == 0u) { xcd_barrier_complete(bar, b.x, nloc, nx); b.st[0] = nloc; b.st[1] = nx; }
        const unsigned old = xb_add(&bar[XB_XSUB(b.x)], 1u);
        const unsigned gen = old / nloc;
        if (old + 1u == (gen + 1u) * nloc) {
            __builtin_amdgcn_fence(__ATOMIC_RELEASE, "agent");
            asm volatile("s_waitcnt vmcnt(0)" ::: "memory");
            const unsigned og = xb_add(&bar[XB_TOP], 1u);
            const unsigned tg = og / nx;
            if (og + 1u == (tg + 1u) * nx) xb_add(&bar[XB_TOPGEN], 1u);
            else XB_SPIN(xb_ld(&bar[XB_TOPGEN]) == tg, bar);
            __builtin_amdgcn_fence(__ATOMIC_ACQUIRE, "agent");
            xb_add(&bar[XB_XGEN(b.x)], 1u);
            asm volatile("s_waitcnt vmcnt(0)" ::: "memory");
        } else {
            XB_SPIN(xb_ld(&bar[XB_XGEN(b.x)]) == gen, bar);
            __builtin_amdgcn_fence(__ATOMIC_ACQUIRE, "agent");
            asm volatile("s_waitcnt vmcnt(0)" ::: "memory");
        }
    }
    __syncthreads();
}

constexpr int PH_PROLOGUE = 0, PH_PROJ = 1, PH_MIX_A = 2, PH_MIX_B = 3, PH_WOUT = 4, PH_LN1 = 5, PH_ROUTER = 6, PH_SORT = 7, PH_SHARED = 8, PH_MOE0 = 9, PH_LN2 = PH_MOE0 + 3 * NH, PH_END = PH_LN2 + 1;
constexpr int LDS_BYTES = 147456;

constexpr int LDS_BAR_OFF = LDS_BYTES - 16;
#ifndef N_LAUNCHES
#define N_LAUNCHES 1
#endif
__global__ void __launch_bounds__(NTHREADS, 2) fwd(Args a) {
    extern __shared__ __attribute__((aligned(16))) unsigned char lds_raw[];
    LAS unsigned char* lds = (LAS unsigned char*)lds_raw;
    const int bid = blockIdx.x, nb = gridDim.x;
    if (threadIdx.x < 4) ((LAS unsigned*)(lds + LDS_BAR_OFF))[threadIdx.x] = 0u;
    __syncthreads();
    XcdBarrier bar = xcd_barrier_post((unsigned*)(a.ws + WS_CTL), (volatile LAS unsigned*)(lds + LDS_BAR_OFF));
    const int lo = a.ph_lo, hi = a.ph_hi;
#ifndef PHMASK
#define PHMASK 0xffffffffu
#endif
#define IN(k) (((PHMASK >> ((k) < PH_MOE0 ? (k) : ((k) >= PH_LN2 ? 12 : 9 + ((k) - PH_MOE0) % 3))) & 1u) && lo <= (k) && (k) < hi)
#define SEAM(k) do { if (lo <= (k) && (k) + 1 < hi) xcd_barrier(bar); } while (0)
    if (IN(PH_PROLOGUE)) phase_prologue(a, lds, bid, nb);
    SEAM(PH_PROLOGUE);
    if (IN(PH_PROJ)) phase_proj(a, bid, nb);
    SEAM(PH_PROJ);
    if (IN(PH_MIX_A)) { phase_segtot(a, lds, bid, nb); phase_swa(a, lds, bid, nb); }
    SEAM(PH_MIX_A);
    if (IN(PH_MIX_B)) phase_retention(a, lds, bid, nb);
    SEAM(PH_MIX_B);
    if (IN(PH_WOUT)) phase_wout(a, bid, nb);
    SEAM(PH_WOUT);
    if (IN(PH_LN1)) phase_ln<0>(a.out, a.in[I_LN1G], a.in[I_LN1B], (bf16*)(a.ws + WS_XB), nullptr, bid, nb);
    SEAM(PH_LN1);
    if (IN(PH_ROUTER)) phase_router(a, lds, bid, nb);
    SEAM(PH_ROUTER);
    if (IN(PH_SORT)) phase_sort(a, lds, bid, nb);
    SEAM(PH_SORT);
    if (IN(PH_SHARED)) phase_shared_pp(a, bid, nb);
    SEAM(PH_SHARED);
    for (int c = 0; c < NH; ++c) {
        if (IN(PH_MOE0 + 3 * c)) phase_moe_up(a, c, bid, nb);
        SEAM(PH_MOE0 + 3 * c);
        if (IN(PH_MOE0 + 3 * c + 1)) phase_moe_down(a, c, bid, nb);
        SEAM(PH_MOE0 + 3 * c + 1);
        if (IN(PH_MOE0 + 3 * c + 2)) phase_final(a, c, bid, nb);
        SEAM(PH_MOE0 + 3 * c + 2);
    }
    if (IN(PH_LN2)) phase_ln<1>(a.out, a.in[I_LN2G], a.in[I_LN2B], nullptr, a.out, bid, nb);
#undef IN
#undef SEAM
}

extern "C" void kernel_launch(void* const* d_in, const int* in_sizes, int n_in, void* d_out, int out_size, void* d_ws, size_t ws_size, hipStream_t stream) {
    static int grid = 0;
    if (grid == 0) {
        if (n_in != 22 || out_size != T * D || ws_size < WS_NEED) { fprintf(stderr, "kernel_launch: unexpected shapes: n_in %d out %d ws %zu (need %zu)\n", n_in, out_size, ws_size, (size_t)WS_NEED); grid = -1; return; }
        int dev = 0, cus = 0;
        (void)hipGetDevice(&dev); (void)hipDeviceGetAttribute(&cus, hipDeviceAttributeMultiprocessorCount, dev);
        if (hipFuncSetAttribute((const void*)fwd, hipFuncAttributeMaxDynamicSharedMemorySize, LDS_BYTES) != hipSuccess) { fprintf(stderr, "hipFuncSetAttribute failed\n"); grid = -1; return; }
        int per_cu = 0;
        if (hipOccupancyMaxActiveBlocksPerMultiprocessor(&per_cu, (const void*)fwd, NTHREADS, LDS_BYTES) != hipSuccess || per_cu < 1) { fprintf(stderr, "occupancy query: %d blocks per CU\n", per_cu); grid = -1; return; }
        (void)hipGetLastError();
        grid = cus > 0 ? cus : 256;
    }
    if (grid < 0) return;
    (void)hipMemsetAsync((char*)d_ws + WS_CTL, 0, 16384, stream);
    Args a{};
    for (int i = 0; i < 22; ++i) a.in[i] = (const float*)d_in[i];
    a.out = (float*)d_out; a.ws = (unsigned char*)d_ws;
#if N_LAUNCHES == 1
    a.ph_lo = 0; a.ph_hi = PH_END;
    hipLaunchKernelGGL(fwd, dim3(grid), dim3(NTHREADS), LDS_BYTES, stream, a);
#else
    for (int ph = 0; ph < PH_END; ++ph) {
        a.ph_lo = ph; a.ph_hi = ph + 1;
        hipLaunchKernelGGL(fwd, dim3(grid), dim3(NTHREADS), LDS_BYTES, stream, a);
    }
#endif
}
```

```cpp
#include <hip/hip_runtime.h>
#include <cstdio>
#include <cstdint>

#define LAS __attribute__((address_space(3)))
typedef unsigned short bf16;
typedef short bf16x8 __attribute__((ext_vector_type(8)));
typedef short bf16x4 __attribute__((ext_vector_type(4)));
typedef float f32x4 __attribute__((ext_vector_type(4)));
typedef unsigned u32x4 __attribute__((ext_vector_type(4)));
typedef unsigned u32x2 __attribute__((ext_vector_type(2)));

constexpr int D = 1024, BATCH = 8, SEQ = 4096, T = BATCH * SEQ;
constexpr int HD = 64, RH = 8, QH = 8, KVH = 2;
constexpr int INW = 2816;
constexpr int C_RQ = 0, C_RK = 512, C_RV = 1024, C_RG = 1536, C_AQ = 2048, C_AK = 2560, C_AV = 2688;
constexpr int CH = 128, NCH = SEQ / CH;
constexpr int SEGC = 8, NSEG = NCH / SEGC;
constexpr int NE = 64, TOPK = 8, EDIM = 256, SDIM = 256, PLE = 256;
constexpr float LN_EPS = 1e-5f, GN_EPS = 1e-6f;
constexpr float ALPHA = 1.189207115002721f;
constexpr float ROUTED_SCALE = 2.5f;
constexpr int NH = 2, TC = T / NH;
constexpr int RMAX = TC * TOPK + NE * 256;
constexpr int MAXTILES = RMAX / 256;
constexpr int NTHREADS = 512;

constexpr size_t MiB = 1u << 20;
constexpr size_t al(size_t x) { return (x + 255) & ~(size_t)255; }
constexpr size_t WS_CTL = 0, CTL_BYTES = 1 * MiB;
constexpr size_t WS_W13T = WS_CTL + CTL_BYTES;
constexpr size_t WS_W2T = WS_W13T + al((size_t)NE * 512 * D * 2);
constexpr size_t WS_ROUT = WS_W2T + al((size_t)NE * D * EDIM * 2);
constexpr size_t RO_RIDX = 0, RO_RW = RO_RIDX + (size_t)T * 8 * 4, RO_CNT = RO_RW + (size_t)T * 8 * 4, RO_STOK = RO_CNT + 256 * 64 * 4;
constexpr size_t RO_DEST = RO_STOK + (size_t)NH * RMAX * 4, RO_RSC = RO_DEST + (size_t)NH * RMAX * 4, RO_TILE = RO_RSC + (size_t)NH * RMAX * 4;
constexpr int TILE_STRIDE = 1024;
static_assert(MAXTILES < TILE_STRIDE - 1, "tile table");
constexpr size_t RO_END = RO_TILE + (size_t)NH * TILE_STRIDE * 4;
constexpr size_t WS_XB = WS_ROUT + al(RO_END);
constexpr size_t WS_DYN = WS_XB + al((size_t)T * D * 2);
constexpr size_t WS_WINT = WS_DYN;
constexpr size_t WS_WOUTT = WS_WINT + al((size_t)INW * D * 2);
constexpr size_t WS_WS13T = WS_WOUTT + al((size_t)D * D * 2);
constexpr size_t WS_WS2T = WS_WS13T + al((size_t)512 * D * 2);
constexpr size_t WS_WGT = WS_WS2T + al((size_t)D * SDIM * 2);
constexpr size_t WS_WPT = WS_WGT + al((size_t)D * D * 2);
constexpr size_t WS_WRT = WS_WPT + al((size_t)D * PLE * 2);
constexpr size_t WS_TAB = WS_WRT + al((size_t)NE * D * 2);
constexpr size_t TAB_BYTES = (size_t)SEQ * (32 + 32 + 8 + 8) * 4;
constexpr size_t WS_SEGT = WS_TAB + al(TAB_BYTES);
constexpr size_t WS_PB = WS_SEGT + al((size_t)BATCH * RH * NSEG * 64 * 64 * 4);
constexpr size_t WS_BIG = WS_PB + al((size_t)T * PLE * 2);
constexpr size_t WS_MIXO = WS_BIG + al((size_t)T * INW * 2);
constexpr size_t WS_END1 = WS_MIXO + al((size_t)T * D * 2);
constexpr size_t WS_HS = WS_BIG;
constexpr size_t WS_PP = WS_HS + al((size_t)T * SDIM * 2);
static_assert(WS_PP + (size_t)T * D * 2 <= WS_MIXO, "hs/pp overlay proj only");
constexpr size_t WS_HSORT = WS_DYN;
constexpr size_t WS_CONTRIB = WS_HSORT + al((size_t)RMAX * EDIM * 2);
constexpr size_t WS_END2 = WS_CONTRIB + al(((size_t)TC * 8 + 1) * D * 2);
constexpr size_t WS_NEED = WS_END1 > WS_END2 ? WS_END1 : WS_END2;
static_assert(WS_NEED <= 512 * MiB, "workspace map exceeds 512 MiB");

__device__ __forceinline__ int hidden_tid() { int t = threadIdx.x; asm volatile("" : "+v"(t)); return t; }
__device__ __forceinline__ float bf2f(unsigned v) { return __uint_as_float(v << 16); }
__device__ __forceinline__ unsigned cvt_pk_bf16(float lo, float hi) { unsigned r; asm volatile("v_cvt_pk_bf16_f32 %0, %1, %2" : "=v"(r) : "v"(lo), "v"(hi)); return r; }
__device__ __forceinline__ bf16 f2bf(float f) { return (bf16)(cvt_pk_bf16(f, 0.f) & 0xffffu); }
__device__ __forceinline__ float sigmoidf_(float x) { return 1.0f / (1.0f + __expf(-x)); }
__device__ __forceinline__ float siluf_(float x) { return x / (1.0f + __expf(-x)); }

struct Args {
    const float* in[22];
    float* out;
    unsigned char* ws;
    int ph_lo, ph_hi;
};
enum { I_X = 0, I_P, I_WIN, I_GN, I_ASC, I_SINK, I_WOUT, I_LN1G, I_LN1B, I_WR, I_RB, I_W1, I_W3, I_W2, I_WS1, I_WS3, I_WS2, I_WG, I_BG, I_WP, I_LN2G, I_LN2B };

__device__ __forceinline__ void transpose_tile(const float* __restrict__ src, int ld_src, int sc0, bf16* __restrict__ dst, int ld_dst, int dn0, int k0, LAS float* tile) {
    const int tid = hidden_tid();
#pragma unroll
    for (int i = 0; i < 2; ++i) {
        const int q = tid + i * NTHREADS, r = q >> 4, c4 = (q & 15) * 4;
        const f32x4 v = *(const f32x4*)(src + (size_t)(k0 + r) * ld_src + sc0 + c4);
        tile[r * 65 + c4 + 0] = v[0]; tile[r * 65 + c4 + 1] = v[1]; tile[r * 65 + c4 + 2] = v[2]; tile[r * 65 + c4 + 3] = v[3];
    }
    __syncthreads();
    {
        const int n = tid >> 3, kc = (tid & 7) * 8;
        u32x4 w;
        w.x = cvt_pk_bf16(tile[(kc + 0) * 65 + n], tile[(kc + 1) * 65 + n]);
        w.y = cvt_pk_bf16(tile[(kc + 2) * 65 + n], tile[(kc + 3) * 65 + n]);
        w.z = cvt_pk_bf16(tile[(kc + 4) * 65 + n], tile[(kc + 5) * 65 + n]);
        w.w = cvt_pk_bf16(tile[(kc + 6) * 65 + n], tile[(kc + 7) * 65 + n]);
        *(u32x4*)(dst + (size_t)(dn0 + n) * ld_dst + k0 + kc) = w;
    }
    __syncthreads();
}
__device__ __forceinline__ void transpose_job(const float* src, int ld_src, int sc0, bf16* dst, int ld_dst, int dn0, int K, int N, int& tctr, int bid, int nb, LAS float* tile) {
    const int nk = K / 64, nn = N / 64;
    for (int t = 0; t < nk * nn; ++t, ++tctr) {
        if ((tctr % nb) != bid) continue;
        const int kt = t % nk, nt = t / nk;
        transpose_tile(src, ld_src, sc0 + nt * 64, dst, ld_dst, dn0 + nt * 64, kt * 64, tile);
    }
}

__device__ void phase_prologue(const Args& a, LAS unsigned char* lds, int bid, int nb) {
    LAS float* tile = (LAS float*)lds;
    unsigned char* ws = a.ws;
    const int tid = hidden_tid();
    {
        const int ntile = NE * 8 * 16;
        for (int t = bid; t < ntile; t += nb) {
            const int e = t / 128, rem = t % 128, db = rem / 16, kt = rem % 16;
            const int piece = db >> 1, which = piece & 1, pn = piece >> 1, sc0 = pn * 128 + (db & 1) * 64;
            const float* src = (which ? a.in[I_W3] : a.in[I_W1]) + (size_t)e * D * EDIM;
            transpose_tile(src, EDIM, sc0, (bf16*)(ws + WS_W13T) + (size_t)e * 512 * D, D, db * 64, kt * 64, tile);
        }
    }
    {
        const int ntile = NE * 16 * 4;
        for (int t = bid; t < ntile; t += nb) {
            const int e = t / 64, rem = t % 64, nt = rem / 4, kt = rem % 4;
            transpose_tile(a.in[I_W2] + (size_t)e * EDIM * D, D, nt * 64, (bf16*)(ws + WS_W2T) + (size_t)e * D * EDIM, EDIM, nt * 64, kt * 64, tile);
        }
    }
    int tctr = 0;
    transpose_job(a.in[I_WIN], INW, 0, (bf16*)(ws + WS_WINT), D, 0, D, INW, tctr, bid, nb, tile);
    transpose_job(a.in[I_WOUT], D, 0, (bf16*)(ws + WS_WOUTT), D, 0, D, D, tctr, bid, nb, tile);
    for (int pn = 0; pn < 2; ++pn) {
        transpose_job(a.in[I_WS1], SDIM, pn * 128, (bf16*)(ws + WS_WS13T), D, pn * 256, D, 128, tctr, bid, nb, tile);
        transpose_job(a.in[I_WS3], SDIM, pn * 128, (bf16*)(ws + WS_WS13T), D, pn * 256 + 128, D, 128, tctr, bid, nb, tile);
    }
    transpose_job(a.in[I_WS2], D, 0, (bf16*)(ws + WS_WS2T), SDIM, 0, SDIM, D, tctr, bid, nb, tile);
    transpose_job(a.in[I_WG], D, 0, (bf16*)(ws + WS_WGT), D, 0, D, D, tctr, bid, nb, tile);
    transpose_job(a.in[I_WP], D, 0, (bf16*)(ws + WS_WPT), PLE, 0, PLE, D, tctr, bid, nb, tile);
    transpose_job(a.in[I_WR], NE, 0, (bf16*)(ws + WS_WRT), D, 0, D, NE, tctr, bid, nb, tile);
    {
        const size_t n8 = (size_t)T * D / 8;
        const float* x = a.in[I_X]; bf16* xb = (bf16*)(ws + WS_XB);
        for (size_t i = (size_t)bid * NTHREADS + tid; i < n8; i += (size_t)nb * NTHREADS) {
            const f32x4 v0 = *(const f32x4*)(x + i * 8), v1 = *(const f32x4*)(x + i * 8 + 4);
            u32x4 w; w.x = cvt_pk_bf16(v0[0], v0[1]); w.y = cvt_pk_bf16(v0[2], v0[3]); w.z = cvt_pk_bf16(v1[0], v1[1]); w.w = cvt_pk_bf16(v1[2], v1[3]);
            *(u32x4*)(xb + i * 8) = w;
        }
        const size_t m8 = (size_t)T * PLE / 8;
        const float* p = a.in[I_P]; bf16* pb = (bf16*)(ws + WS_PB);
        for (size_t i = (size_t)bid * NTHREADS + tid; i < m8; i += (size_t)nb * NTHREADS) {
            const f32x4 v0 = *(const f32x4*)(p + i * 8), v1 = *(const f32x4*)(p + i * 8 + 4);
            u32x4 w; w.x = cvt_pk_bf16(v0[0], v0[1]); w.y = cvt_pk_bf16(v0[2], v0[3]); w.z = cvt_pk_bf16(v1[0], v1[1]); w.w = cvt_pk_bf16(v1[2], v1[3]);
            *(u32x4*)(pb + i * 8) = w;
        }
    }
    {
        float* tab = (float*)(ws + WS_TAB);
        float* cosr = tab, *sinr = tab + SEQ * 32, *coss = tab + SEQ * 64, *sins = tab + SEQ * 72;
        for (int i = bid * NTHREADS + tid; i < SEQ * 40; i += nb * NTHREADS) {
            const int s = i / 40, j = i % 40;
            if (j < 32) {
                const float inv = (float)pow(10000.0, -(double)j / 32.0);
                const float ang = (float)s * inv;
                cosr[s * 32 + j] = (float)cos((double)ang); sinr[s * 32 + j] = (float)sin((double)ang);
            } else {
                const int jj = j - 32;
                const float inv = (float)pow(500000.0, -(double)jj / 8.0);
                const float ang = (float)s * inv;
                coss[s * 8 + jj] = (float)cos((double)ang); sins[s * 8 + jj] = (float)sin((double)ang);
            }
        }
    }
}

__device__ __forceinline__ int perm32(int rho) { const int n = rho >> 4, i = rho & 15; return 8 * (i >> 2) + 4 * n + (i & 3); }

struct GemmPart { const bf16* A; int lda; const int* rowidx; long arow0; const bf16* Bt; int ldb; int K; };

__device__ __forceinline__ void gemm_part(f32x4 (&acc)[2][2][4][2], const GemmPart& g, int wr, int wc, int fr, int fq) {
    unsigned oa[2][4], ob[2][2];
#pragma unroll
    for (int ai = 0; ai < 2; ++ai)
#pragma unroll
        for (int m = 0; m < 4; ++m) {
            const int r = 128 * ai + 64 * wr + 16 * m + fr;
            const long gr = g.rowidx ? (long)g.rowidx[r] : g.arow0 + r;
            oa[ai][m] = (unsigned)((gr * g.lda + 8 * fq) * 2);
        }
#pragma unroll
    for (int bj = 0; bj < 2; ++bj)
#pragma unroll
        for (int n = 0; n < 2; ++n) {
            const int rb = 128 * bj + 32 * wc + perm32(16 * n + fr);
            ob[bj][n] = (unsigned)((rb * g.ldb + 8 * fq) * 2);
        }
    const char* pA = (const char*)g.A; const char* pB = (const char*)g.Bt;
#pragma unroll 1
    for (int k0 = 0; k0 < g.K; k0 += 32) {
        bf16x8 af[2][4], bfr[2][2];
#pragma unroll
        for (int ai = 0; ai < 2; ++ai)
#pragma unroll
            for (int m = 0; m < 4; ++m) af[ai][m] = *(const bf16x8*)(pA + oa[ai][m]);
#pragma unroll
        for (int bj = 0; bj < 2; ++bj)
#pragma unroll
            for (int n = 0; n < 2; ++n) bfr[bj][n] = *(const bf16x8*)(pB + ob[bj][n]);
#pragma unroll
        for (int ai = 0; ai < 2; ++ai)
#pragma unroll
            for (int bj = 0; bj < 2; ++bj)
#pragma unroll
                for (int m = 0; m < 4; ++m)
#pragma unroll
                    for (int n = 0; n < 2; ++n)
                        acc[ai][bj][m][n] = __builtin_amdgcn_mfma_f32_16x16x32_bf16(bfr[bj][n], af[ai][m], acc[ai][bj][m][n], 0, 0, 0);
        pA += 64; pB += 64;
    }
}
__device__ __forceinline__ void zero_acc(f32x4 (&acc)[2][2][4][2]) {
#pragma unroll
    for (int a = 0; a < 2; ++a)
#pragma unroll
        for (int b = 0; b < 2; ++b)
#pragma unroll
            for (int m = 0; m < 4; ++m)
#pragma unroll
                for (int n = 0; n < 2; ++n) acc[a][b][m][n] = (f32x4){0.f, 0.f, 0.f, 0.f};
}
#define WAVE_IDS() int tid_ = threadIdx.x; asm volatile("" : "+v"(tid_)); const int tid = tid_, wid = __builtin_amdgcn_readfirstlane(tid >> 6), lane = tid & 63, wr = wid >> 2, wc = wid & 3, fr = lane & 15, fq = lane >> 4; (void)lane; (void)wr; (void)wc; (void)fr; (void)fq

__device__ __forceinline__ void epi_bf16(const f32x4 (&acc)[2][2][4][2], bf16* O, int ldo, long row0, int col0, int wr, int wc, int fr, int fq) {
#pragma unroll
    for (int ai = 0; ai < 2; ++ai)
#pragma unroll
        for (int m = 0; m < 4; ++m) {
            bf16* rp = O + (size_t)(row0 + 128 * ai + 64 * wr + 16 * m + fr) * ldo + col0 + 32 * wc + 8 * fq;
#pragma unroll
            for (int bj = 0; bj < 2; ++bj) {
                const f32x4 v0 = acc[ai][bj][m][0], v1 = acc[ai][bj][m][1];
                u32x4 w; w.x = cvt_pk_bf16(v0[0], v0[1]); w.y = cvt_pk_bf16(v0[2], v0[3]); w.z = cvt_pk_bf16(v1[0], v1[1]); w.w = cvt_pk_bf16(v1[2], v1[3]);
                *(u32x4*)(rp + 128 * bj) = w;
            }
        }
}
__device__ __forceinline__ void epi_gate(const f32x4 (&acc)[2][2][4][2], bf16* O, int ldo, long row0, int col0, int wr, int wc, int fr, int fq) {
#pragma unroll
    for (int ai = 0; ai < 2; ++ai)
#pragma unroll
        for (int m = 0; m < 4; ++m) {
            bf16* rp = O + (size_t)(row0 + 128 * ai + 64 * wr + 16 * m + fr) * ldo + col0 + 32 * wc + 8 * fq;
            float h[8];
#pragma unroll
            for (int n = 0; n < 2; ++n)
#pragma unroll
                for (int j = 0; j < 4; ++j) h[4 * n + j] = siluf_(acc[ai][0][m][n][j]) * acc[ai][1][m][n][j];
            u32x4 w; w.x = cvt_pk_bf16(h[0], h[1]); w.y = cvt_pk_bf16(h[2], h[3]); w.z = cvt_pk_bf16(h[4], h[5]); w.w = cvt_pk_bf16(h[6], h[7]);
            *(u32x4*)rp = w;
        }
}

namespace gf {
constexpr int BM = 256, BK = 64, HALF = 128, HTB = HALF * BK * 2, STAGE_BYTES = 8 * HTB;
__device__ __forceinline__ int lds_byte(int r, int c) { const int st = (r >> 4) * 2 + (c >> 5), rr = r & 15, cc = c & 31, ob = rr * 64 + cc * 2; return st * 1024 + (ob ^ (((ob >> 9) & 1) << 5)); }
__device__ __forceinline__ void stage_rc(int b, int& R, int& C) { const int st = b / 1024, sb = b % 1024, swz = sb ^ (((sb >> 9) & 1) << 5); R = (st >> 1) * 16 + swz / 64; C = (st & 1) * 32 + (swz % 64) / 2; }

struct Unit {
    unsigned A;
    unsigned B;
    const int* rowidx;
    int lda, ldb;
    int nt;
    int keep;
    int kind, r0, c0, x0;
};

template <bool GENERAL, class Sched, class Epi>
__device__ __forceinline__ void gemm_fast(LAS unsigned char* lds, const unsigned char* ws, const Sched& S, const Epi& E) {
    const __amdgpu_buffer_rsrc_t rsrc = __builtin_amdgcn_make_buffer_rsrc((void*)ws, 0, 0x7ffffff0, 0x00020000);
    int tid = threadIdx.x; asm volatile("" : "+v"(tid));
    const int wid = __builtin_amdgcn_readfirstlane(tid >> 6), lane = tid & 63, wr = wid >> 2, wc = wid & 3, fr = lane & 15, fq = lane >> 4;
    const unsigned ldsw = (unsigned)wid * 1024u;
    const int aoff = lds_byte(wr * 64 + fr, fq * 8), boff = lds_byte(wc * 32 + fr, fq * 8);
    constexpr unsigned kstep = (unsigned)(BK * 2);
#define GF_SA(b, h) (((b) * 2 + (h)) * HTB)
#define GF_SB(b, h) ((4 + (b) * 2 + (h)) * HTB)
#define GF_STAGE(bufoff, soff, o0, o1) do { \
        __builtin_amdgcn_raw_ptr_buffer_load_lds(rsrc, (LAS void*)(lds + (bufoff) + ldsw), 16, (int)(o0), (int)(soff), 0, 0); \
        __builtin_amdgcn_raw_ptr_buffer_load_lds(rsrc, (LAS void*)(lds + (bufoff) + ldsw + 8192), 16, (int)(o1), (int)(soff), 0, 0); } while (0)
#define GF_LDA(dst, b, h) do { _Pragma("unroll") for (int m = 0; m < 4; ++m) _Pragma("unroll") for (int k = 0; k < 2; ++k) dst[m][k] = *(const LAS bf16x8*)(lds + GF_SA(b, h) + aoff + m * 2048 + k * 1024); } while (0)
#define GF_LDB(dst, b, h) do { _Pragma("unroll") for (int n = 0; n < 2; ++n) _Pragma("unroll") for (int k = 0; k < 2; ++k) dst[n][k] = *(const LAS bf16x8*)(lds + GF_SB(b, h) + boff + n * 2048 + k * 1024); } while (0)
#define GF_MMA(ai, bj, At, Bt) do { __builtin_amdgcn_s_setprio(1); _Pragma("unroll") for (int m = 0; m < 4; ++m) _Pragma("unroll") for (int n = 0; n < 2; ++n) _Pragma("unroll") for (int k = 0; k < 2; ++k) \
        acc[ai][bj][m][n] = __builtin_amdgcn_mfma_f32_16x16x32_bf16(Bt[n][k], At[m][k], acc[ai][bj][m][n], 0, 0, 0); __builtin_amdgcn_s_setprio(0); } while (0)
#define GF_WAIT_V(n) asm volatile("s_waitcnt vmcnt(" #n ")" ::: "memory")
#define GF_WAIT_L(n) asm volatile("s_waitcnt lgkmcnt(" #n ")" ::: "memory")
#define GF_BAR __builtin_amdgcn_s_barrier()
#define GF_SCHED __builtin_amdgcn_sched_barrier(0)
#define GF_SETOFF(u, oA, oB) do { \
        int tz = threadIdx.x; asm volatile("" : "+v"(tz)); \
        int R0, C0, R1, C1; stage_rc(tz * 16, R0, C0); stage_rc(tz * 16 + 8192, R1, C1); \
        const int Rb0 = (R0 & ~31) + perm32(R0 & 31), Rb1 = (R1 & ~31) + perm32(R1 & 31); \
        int g00 = R0, g01 = R1, g10 = HALF + R0, g11 = HALF + R1; \
        if ((u).rowidx) { g00 = (u).rowidx[g00]; g01 = (u).rowidx[g01]; g10 = (u).rowidx[g10]; g11 = (u).rowidx[g11]; } \
        oA[0][0] = (unsigned)g00 * (unsigned)(u).lda + (unsigned)C0 * 2u; oA[0][1] = (unsigned)g01 * (unsigned)(u).lda + (unsigned)C1 * 2u; \
        oA[1][0] = (unsigned)g10 * (unsigned)(u).lda + (unsigned)C0 * 2u; oA[1][1] = (unsigned)g11 * (unsigned)(u).lda + (unsigned)C1 * 2u; \
        oB[0] = (unsigned)Rb0 * (unsigned)(u).ldb + (unsigned)C0 * 2u; oB[1] = (unsigned)Rb1 * (unsigned)(u).ldb + (unsigned)C1 * 2u; } while (0)
    Unit cur, nxt; int ui = 0;
    if (!S.next(0, cur)) return;
    f32x4 acc[2][2][4][2];
#pragma unroll
    for (int a = 0; a < 2; ++a)
#pragma unroll
        for (int b = 0; b < 2; ++b)
#pragma unroll
            for (int m = 0; m < 4; ++m)
#pragma unroll
                for (int n = 0; n < 2; ++n) acc[a][b][m][n] = (f32x4){0.f, 0.f, 0.f, 0.f};
    bf16x8 At[4][2], B0[2][2], B1[2][2];
    unsigned oAc[2][2], oBc[2], oAn[2][2], oBn[2];
    GF_SETOFF(cur, oAc, oBc);
    unsigned cA = cur.A, cB = cur.B, chB = (unsigned)HALF * cur.ldb;
    GF_STAGE(GF_SB(0, 0), cB, oBc[0], oBc[1]); GF_STAGE(GF_SA(0, 0), cA, oAc[0][0], oAc[0][1]); GF_STAGE(GF_SB(0, 1), cB + chB, oBc[0], oBc[1]); GF_STAGE(GF_SA(0, 1), cA, oAc[1][0], oAc[1][1]);
    if (wr == 1) GF_BAR;
    GF_WAIT_V(4); GF_BAR;
    GF_STAGE(GF_SB(1, 0), cB + kstep, oBc[0], oBc[1]); GF_STAGE(GF_SA(1, 0), cA + kstep, oAc[0][0], oAc[0][1]); GF_STAGE(GF_SB(1, 1), cB + chB + kstep, oBc[0], oBc[1]);
    GF_WAIT_V(6); GF_BAR;
    for (;;) {
        const bool has_next = S.next(ui + 1, nxt);
        unsigned nA, nB, nhB;
        if (has_next) { if (GENERAL) GF_SETOFF(nxt, oAn, oBn); nA = nxt.A; nB = nxt.B; nhB = (unsigned)HALF * nxt.ldb; }
        else { if (GENERAL) { oAn[0][0] = oAc[0][0]; oAn[0][1] = oAc[0][1]; oAn[1][0] = oAc[1][0]; oAn[1][1] = oAc[1][1]; oBn[0] = oBc[0]; oBn[1] = oBc[1]; } nA = cA; nB = cB; nhB = chB; }
        const int nt = cur.nt;
        for (int t = 0; t < nt; t += 2) {
            const bool last = (t == nt - 2);
            const unsigned a1 = cA + (unsigned)(t + 1) * kstep;
            const unsigned a2 = last ? nA : cA + (unsigned)(t + 2) * kstep, b2 = last ? nB : cB + (unsigned)(t + 2) * kstep;
            const unsigned a3 = a2 + kstep, b3 = b2 + kstep;
            const unsigned hB2 = last ? nhB : chB;
            const unsigned a2_00 = (GENERAL && last) ? oAn[0][0] : oAc[0][0], a2_01 = (GENERAL && last) ? oAn[0][1] : oAc[0][1], a2_10 = (GENERAL && last) ? oAn[1][0] : oAc[1][0], a2_11 = (GENERAL && last) ? oAn[1][1] : oAc[1][1];
            const unsigned b2_0 = (GENERAL && last) ? oBn[0] : oBc[0], b2_1 = (GENERAL && last) ? oBn[1] : oBc[1];
            GF_LDB(B0, 0, 0); GF_SCHED; GF_LDA(At, 0, 0); GF_STAGE(GF_SA(1, 1), a1, oAc[1][0], oAc[1][1]);
            GF_WAIT_L(8); GF_BAR; GF_WAIT_L(0); GF_MMA(0, 0, At, B0); GF_BAR; GF_SCHED;
            GF_LDB(B1, 0, 1); GF_STAGE(GF_SB(0, 0), b2, b2_0, b2_1);
            GF_BAR; GF_WAIT_L(0); GF_MMA(0, 1, At, B1); GF_BAR;
            GF_LDA(At, 0, 1); GF_STAGE(GF_SA(0, 0), a2, a2_00, a2_01);
            GF_BAR; GF_WAIT_L(0); GF_MMA(1, 0, At, B0); GF_BAR; GF_SCHED;
            GF_STAGE(GF_SB(0, 1), b2 + hB2, b2_0, b2_1);
            GF_WAIT_V(6); GF_BAR; GF_MMA(1, 1, At, B1); GF_BAR;
            GF_LDB(B0, 1, 0); GF_SCHED; GF_LDA(At, 1, 0); GF_STAGE(GF_SA(0, 1), a2, a2_10, a2_11);
            GF_WAIT_L(8); GF_BAR; GF_WAIT_L(0); GF_MMA(0, 0, At, B0); GF_BAR; GF_SCHED;
            GF_LDB(B1, 1, 1); GF_STAGE(GF_SB(1, 0), b3, b2_0, b2_1);
            GF_BAR; GF_WAIT_L(0); GF_MMA(0, 1, At, B1); GF_BAR;
            GF_LDA(At, 1, 1); GF_STAGE(GF_SA(1, 0), a3, a2_00, a2_01);
            GF_BAR; GF_WAIT_L(0); GF_MMA(1, 0, At, B0); GF_BAR; GF_SCHED;
            GF_STAGE(GF_SB(1, 1), b3 + hB2, b2_0, b2_1);
            GF_WAIT_V(6); GF_BAR; GF_MMA(1, 1, At, B1); GF_BAR;
        }
        E(acc, cur, wr, wc, fr, fq);
        if (!has_next) break;
        if (!cur.keep) {
#pragma unroll
            for (int a = 0; a < 2; ++a)
#pragma unroll
                for (int b = 0; b < 2; ++b)
#pragma unroll
                    for (int m = 0; m < 4; ++m)
#pragma unroll
                        for (int n = 0; n < 2; ++n) acc[a][b][m][n] = (f32x4){0.f, 0.f, 0.f, 0.f};
        }
        cur = nxt; cA = nA; cB = nB; chB = nhB; ++ui;
        if (GENERAL) { oAc[0][0] = oAn[0][0]; oAc[0][1] = oAn[0][1]; oAc[1][0] = oAn[1][0]; oAc[1][1] = oAn[1][1]; oBc[0] = oBn[0]; oBc[1] = oBn[1]; }
    }
    GF_WAIT_V(0);
    if (wr == 0) GF_BAR;
    GF_BAR;
#undef GF_SA
#undef GF_SB
#undef GF_STAGE
#undef GF_LDA
#undef GF_LDB
#undef GF_MMA
#undef GF_WAIT_V
#undef GF_WAIT_L
#undef GF_BAR
#undef GF_SCHED
#undef GF_SETOFF
}
}

__device__ __forceinline__ int uload(const int* p) { return __builtin_amdgcn_readfirstlane(__hip_atomic_load(p, __ATOMIC_RELAXED, __HIP_MEMORY_SCOPE_AGENT)); }
__device__ __forceinline__ int vcu_of(int bid, int nb) { return (nb % 8 == 0) ? (bid % 8) * (nb / 8) + bid / 8 : bid; }

struct SchedPlain {
    unsigned A, B; int lda, ldb, nt, nN, nU, G, c; long r0base;
    __device__ __forceinline__ bool next(int i, gf::Unit& u) const {
        const int L = i * G + c; if (L >= nU) return false;
        const int pm = L / nN, pn = L % nN;
        u.A = A + (unsigned)pm * 256u * lda; u.B = B + (unsigned)pn * 256u * ldb; u.rowidx = nullptr; u.lda = lda; u.ldb = ldb; u.nt = nt; u.keep = 0;
        u.kind = 0; u.r0 = (int)(r0base + pm * 256); u.c0 = pn * 256; u.x0 = 0; return true;
    }
};
struct EpiProj { bf16* O; __device__ __forceinline__ void operator()(f32x4 (&acc)[2][2][4][2], const gf::Unit& u, int wr, int wc, int fr, int fq) const { epi_bf16(acc, O, INW, u.r0, u.c0, wr, wc, fr, fq); } };
__device__ void phase_proj(const Args& a, LAS unsigned char* lds, int bid, int nb) {
    SchedPlain S{(unsigned)WS_XB, (unsigned)WS_WINT, D * 2, D * 2, D / 64, INW / 256, (T / 256) * (INW / 256), nb, vcu_of(bid, nb), 0};
    EpiProj E{(bf16*)(a.ws + WS_BIG)};
    gf::gemm_fast<false>(lds, a.ws, S, E);
}

struct EpiWout { const float* x; float* y;
    __device__ __forceinline__ void operator()(f32x4 (&acc)[2][2][4][2], const gf::Unit& u, int wr, int wc, int fr, int fq) const {
#pragma unroll
        for (int ai = 0; ai < 2; ++ai)
#pragma unroll
            for (int m = 0; m < 4; ++m) {
                const size_t off = (size_t)(u.r0 + 128 * ai + 64 * wr + 16 * m + fr) * D + u.c0 + 32 * wc + 8 * fq;
#pragma unroll
                for (int bj = 0; bj < 2; ++bj)
#pragma unroll
                    for (int n = 0; n < 2; ++n) {
                        const f32x4 xv = *(const f32x4*)(x + off + 128 * bj + 4 * n);
                        *(f32x4*)(y + off + 128 * bj + 4 * n) = acc[ai][bj][m][n] + ALPHA * xv;
                    }
                asm volatile("" ::: "memory");
            }
    }
};
__device__ void phase_wout(const Args& a, LAS unsigned char* lds, int bid, int nb) {
    SchedPlain S{(unsigned)WS_MIXO, (unsigned)WS_WOUTT, D * 2, D * 2, D / 64, D / 256, (T / 256) * (D / 256), nb, vcu_of(bid, nb), 0};
    EpiWout E{a.in[I_X], a.out};
    gf::gemm_fast<false>(lds, a.ws, S, E);
}

constexpr int QS = 72;
constexpr int TS = 136;
constexpr int TS2 = 264;
constexpr int L_QS = 0;
constexpr int L_KS = L_QS + 128 * QS * 2;
constexpr int L_KTW = L_KS + 256 * QS * 2;
constexpr int L_VT = L_KTW + 64 * TS * 2;
constexpr int L_ST = L_VT + 64 * TS2 * 2;
constexpr int L_MIX_END = L_ST + 64 * QS * 2;
static_assert(L_MIX_END <= 128 * 1024, "mixer LDS");

__device__ __forceinline__ void stage_ret(const Args& a, LAS unsigned char* lds, int b, int h, int n, bool want_q, float l2g) {
    const int tid = hidden_tid();
    const bf16* proj = (const bf16*)(a.ws + WS_BIG);
    const float* tab = (const float*)(a.ws + WS_TAB);
    const float* cosr = tab, *sinr = tab + SEQ * 32;
    LAS bf16* Qs = (LAS bf16*)(lds + L_QS); LAS bf16* Ks = (LAS bf16*)(lds + L_KS); LAS bf16* Ktw = (LAS bf16*)(lds + L_KTW); LAS bf16* Vt = (LAS bf16*)(lds + L_VT);
    const int row = tid >> 2, i0 = (tid & 3) * 8;
    const int pos = n * CH + row;
    const size_t t = (size_t)b * SEQ + pos;
    const bf16* prow = proj + t * INW;
    f32x4 c0 = *(const f32x4*)(cosr + pos * 32 + i0), c1 = *(const f32x4*)(cosr + pos * 32 + i0 + 4);
    f32x4 s0 = *(const f32x4*)(sinr + pos * 32 + i0), s1 = *(const f32x4*)(sinr + pos * 32 + i0 + 4);
    float cs[8] = {c0[0], c0[1], c0[2], c0[3], c1[0], c1[1], c1[2], c1[3]}, sn[8] = {s0[0], s0[1], s0[2], s0[3], s1[0], s1[1], s1[2], s1[3]};
    if (want_q) {
        const bf16x8 x1 = *(const bf16x8*)(prow + C_RQ + h * 64 + i0), x2 = *(const bf16x8*)(prow + C_RQ + h * 64 + 32 + i0);
        float o1[8], o2[8];
#pragma unroll
        for (int j = 0; j < 8; ++j) { const float a1 = bf2f((unsigned short)x1[j]), a2 = bf2f((unsigned short)x2[j]); o1[j] = a1 * cs[j] - a2 * sn[j]; o2[j] = a2 * cs[j] + a1 * sn[j]; }
        u32x4 w1, w2;
        w1.x = cvt_pk_bf16(o1[0], o1[1]); w1.y = cvt_pk_bf16(o1[2], o1[3]); w1.z = cvt_pk_bf16(o1[4], o1[5]); w1.w = cvt_pk_bf16(o1[6], o1[7]);
        w2.x = cvt_pk_bf16(o2[0], o2[1]); w2.y = cvt_pk_bf16(o2[2], o2[3]); w2.z = cvt_pk_bf16(o2[4], o2[5]); w2.w = cvt_pk_bf16(o2[6], o2[7]);
        *(LAS u32x4*)(Qs + row * QS + i0) = w1; *(LAS u32x4*)(Qs + row * QS + 32 + i0) = w2;
    }
    {
        const bf16x8 x1 = *(const bf16x8*)(prow + C_RK + h * 64 + i0), x2 = *(const bf16x8*)(prow + C_RK + h * 64 + 32 + i0);
        const float kw = exp2f((float)(CH - 1 - row) * l2g);
        float o1[8], o2[8];
#pragma unroll
        for (int j = 0; j < 8; ++j) { const float a1 = bf2f((unsigned short)x1[j]), a2 = bf2f((unsigned short)x2[j]); o1[j] = (a1 * cs[j] - a2 * sn[j]) * 0.125f; o2[j] = (a2 * cs[j] + a1 * sn[j]) * 0.125f; }
        if (want_q) {
            u32x4 w1, w2;
            w1.x = cvt_pk_bf16(o1[0], o1[1]); w1.y = cvt_pk_bf16(o1[2], o1[3]); w1.z = cvt_pk_bf16(o1[4], o1[5]); w1.w = cvt_pk_bf16(o1[6], o1[7]);
            w2.x = cvt_pk_bf16(o2[0], o2[1]); w2.y = cvt_pk_bf16(o2[2], o2[3]); w2.z = cvt_pk_bf16(o2[4], o2[5]); w2.w = cvt_pk_bf16(o2[6], o2[7]);
            *(LAS u32x4*)(Ks + row * QS + i0) = w1; *(LAS u32x4*)(Ks + row * QS + 32 + i0) = w2;
        }
#pragma unroll
        for (int j = 0; j < 8; ++j) { Ktw[(i0 + j) * TS + row] = f2bf(o1[j] * kw); Ktw[(32 + i0 + j) * TS + row] = f2bf(o2[j] * kw); }
    }
    {
        const bf16x8 v1 = *(const bf16x8*)(prow + C_RV + h * 64 + i0), v2 = *(const bf16x8*)(prow + C_RV + h * 64 + 32 + i0);
#pragma unroll
        for (int j = 0; j < 8; ++j) { Vt[(i0 + j) * TS2 + row] = (bf16)v1[j]; Vt[(32 + i0 + j) * TS2 + row] = (bf16)v2[j]; }
    }
}
__device__ __forceinline__ void ret_kv(LAS unsigned char* lds, int wid, int fr, int fq, f32x4 (&kv)[2]) {
    LAS bf16* Ktw = (LAS bf16*)(lds + L_KTW); LAS bf16* Vt = (LAS bf16*)(lds + L_VT);
#pragma unroll
    for (int i = 0; i < 2; ++i) {
        const int tl = 2 * wid + i, dt = tl >> 2, et = tl & 3;
        f32x4 c = {0.f, 0.f, 0.f, 0.f};
#pragma unroll
        for (int ks = 0; ks < 4; ++ks) {
            const bf16x8 kf = *(const LAS bf16x8*)(Ktw + (16 * dt + fr) * TS + 32 * ks + 8 * fq);
            const bf16x8 vf = *(const LAS bf16x8*)(Vt + (16 * et + fr) * TS2 + 32 * ks + 8 * fq);
            c = __builtin_amdgcn_mfma_f32_16x16x32_bf16(kf, vf, c, 0, 0, 0);
        }
        kv[i] = c;
    }
}
__device__ __forceinline__ float head_l2g(int h) { return log2f(1.0f - exp2f(-5.0f - (float)h)); }

__device__ void phase_segtot(const Args& a, LAS unsigned char* lds, int bid, int nb) {
    WAVE_IDS();
    float* segt = (float*)(a.ws + WS_SEGT);
    for (int it = bid; it < BATCH * RH * NSEG; it += nb) {
        const int seg = it % NSEG, h = (it / NSEG) % RH, b = it / (NSEG * RH);
        const float l2g = head_l2g(h), cd = exp2f(128.0f * l2g);
        f32x4 S[2] = {{0.f, 0.f, 0.f, 0.f}, {0.f, 0.f, 0.f, 0.f}};
        for (int c = 0; c < SEGC; ++c) {
            __syncthreads();
            stage_ret(a, lds, b, h, seg * SEGC + c, false, l2g);
            __syncthreads();
            f32x4 kv[2]; ret_kv(lds, wid, fr, fq, kv);
            S[0] = S[0] * cd + kv[0]; S[1] = S[1] * cd + kv[1];
        }
        float* dst = segt + (size_t)((b * RH + h) * NSEG + seg) * 4096;
#pragma unroll
        for (int i = 0; i < 2; ++i) { const int tl = 2 * wid + i, dt = tl >> 2, et = tl & 3;
#pragma unroll
            for (int j = 0; j < 4; ++j) dst[(16 * dt + 4 * fq + j) * 64 + 16 * et + fr] = S[i][j]; }
    }
}

__device__ void phase_retention(const Args& a, LAS unsigned char* lds, int bid, int nb) {
    WAVE_IDS();
    const float* segt = (const float*)(a.ws + WS_SEGT);
    const bf16* proj = (const bf16*)(a.ws + WS_BIG);
    bf16* mixo = (bf16*)(a.ws + WS_MIXO);
    const float* gain = a.in[I_GN];
    LAS bf16* Qs = (LAS bf16*)(lds + L_QS); LAS bf16* Ks = (LAS bf16*)(lds + L_KS); LAS bf16* Vt = (LAS bf16*)(lds + L_VT); LAS bf16* St = (LAS bf16*)(lds + L_ST);
    for (int it = bid; it < BATCH * RH * NSEG; it += nb) {
        const int seg = it % NSEG, h = (it / NSEG) % RH, b = it / (NSEG * RH);
        const float l2g = head_l2g(h), cd = exp2f(128.0f * l2g);
        f32x4 S[2] = {{0.f, 0.f, 0.f, 0.f}, {0.f, 0.f, 0.f, 0.f}};
        for (int sp = 0; sp < seg; ++sp) {
            const float wgt = exp2f(128.0f * l2g * (float)(SEGC * (seg - 1 - sp)));
            const float* src = segt + (size_t)((b * RH + h) * NSEG + sp) * 4096;
#pragma unroll
            for (int i = 0; i < 2; ++i) { const int tl = 2 * wid + i, dt = tl >> 2, et = tl & 3;
#pragma unroll
                for (int j = 0; j < 4; ++j) S[i][j] += wgt * src[(16 * dt + 4 * fq + j) * 64 + 16 * et + fr]; }
        }
        for (int c = 0; c < SEGC; ++c) {
            const int n = seg * SEGC + c;
            __syncthreads();
            stage_ret(a, lds, b, h, n, true, l2g);
#pragma unroll
            for (int i = 0; i < 2; ++i) { const int tl = 2 * wid + i, dt = tl >> 2, et = tl & 3;
                u32x2 w; w.x = cvt_pk_bf16(S[i][0], S[i][1]); w.y = cvt_pk_bf16(S[i][2], S[i][3]);
                *(LAS u32x2*)(St + (16 * et + fr) * QS + 16 * dt + 4 * fq) = w; }
            __syncthreads();
            bf16x8 qf[2];
#pragma unroll
            for (int ks = 0; ks < 2; ++ks) qf[ks] = *(const LAS bf16x8*)(Qs + (16 * wid + fr) * QS + 32 * ks + 8 * fq);
            f32x4 sc[8];
#pragma unroll
            for (int jt = 0; jt < 8; ++jt) {
                sc[jt] = (f32x4){0.f, 0.f, 0.f, 0.f};
                if (jt <= wid) {
#pragma unroll
                    for (int ks = 0; ks < 2; ++ks) {
                        const bf16x8 kf = *(const LAS bf16x8*)(Ks + (16 * jt + fr) * QS + 32 * ks + 8 * fq);
                        sc[jt] = __builtin_amdgcn_mfma_f32_16x16x32_bf16(kf, qf[ks], sc[jt], 0, 0, 0);
                    }
                    const int i = 16 * wid + fr;
#pragma unroll
                    for (int r = 0; r < 4; ++r) { const int j = 16 * jt + 4 * fq + r; const float dcy = exp2f((float)(i - j) * l2g); sc[jt][r] = (i >= j) ? sc[jt][r] * dcy : 0.f; }
                    asm volatile("" : "+v"(sc[jt]) :: "memory");
                }
            }
            f32x4 o[4], oi[4];
#pragma unroll
            for (int et = 0; et < 4; ++et) { o[et] = (f32x4){0.f, 0.f, 0.f, 0.f}; oi[et] = (f32x4){0.f, 0.f, 0.f, 0.f}; }
#pragma unroll
            for (int k2 = 0; k2 < 4; ++k2) {
                if (2 * k2 <= wid) {
                    bf16x8 pf; u32x4 pw;
                    pw.x = cvt_pk_bf16(sc[2 * k2][0], sc[2 * k2][1]); pw.y = cvt_pk_bf16(sc[2 * k2][2], sc[2 * k2][3]);
                    pw.z = cvt_pk_bf16(sc[2 * k2 + 1][0], sc[2 * k2 + 1][1]); pw.w = cvt_pk_bf16(sc[2 * k2 + 1][2], sc[2 * k2 + 1][3]);
                    pf = __builtin_bit_cast(bf16x8, pw);
#pragma unroll
                    for (int et = 0; et < 4; ++et) {
                        const u32x2 va = *(const LAS u32x2*)(Vt + (16 * et + fr) * TS2 + 32 * k2 + 4 * fq);
                        const u32x2 vb = *(const LAS u32x2*)(Vt + (16 * et + fr) * TS2 + 32 * k2 + 16 + 4 * fq);
                        u32x4 vw; vw.x = va.x; vw.y = va.y; vw.z = vb.x; vw.w = vb.y;
                        o[et] = __builtin_amdgcn_mfma_f32_16x16x32_bf16(__builtin_bit_cast(bf16x8, vw), pf, o[et], 0, 0, 0);
                    }
                }
            }
#pragma unroll
            for (int et = 0; et < 4; ++et)
#pragma unroll
                for (int ks = 0; ks < 2; ++ks) {
                    const bf16x8 sf = *(const LAS bf16x8*)(St + (16 * et + fr) * QS + 32 * ks + 8 * fq);
                    oi[et] = __builtin_amdgcn_mfma_f32_16x16x32_bf16(sf, qf[ks], oi[et], 0, 0, 0);
                }
            {
                const int i = 16 * wid + fr;
                const float qw = exp2f((float)(i + 1) * l2g);
                float sum = 0.f;
#pragma unroll
                for (int et = 0; et < 4; ++et)
#pragma unroll
                    for (int r = 0; r < 4; ++r) { o[et][r] += qw * oi[et][r]; sum += o[et][r]; }
                sum += __shfl_xor(sum, 16); sum += __shfl_xor(sum, 32);
                const float mean = sum * (1.0f / 64.0f);
                float q = 0.f;
#pragma unroll
                for (int et = 0; et < 4; ++et)
#pragma unroll
                    for (int r = 0; r < 4; ++r) { const float d = o[et][r] - mean; q += d * d; }
                q += __shfl_xor(q, 16); q += __shfl_xor(q, 32);
                const float rstd = rsqrtf(q * (1.0f / 64.0f) + GN_EPS);
                const size_t t = (size_t)b * SEQ + n * CH + i;
#pragma unroll
                for (int et = 0; et < 4; ++et) {
                    const int e0 = 16 * et + 4 * fq;
                    const u32x2 gw = *(const u32x2*)(proj + t * INW + C_RG + h * 64 + e0);
                    const f32x4 gn = *(const f32x4*)(gain + h * 64 + e0);
                    const float g0 = bf2f(gw.x & 0xffffu), g1 = bf2f(gw.x >> 16), g2 = bf2f(gw.y & 0xffffu), g3 = bf2f(gw.y >> 16);
                    const float y0 = (o[et][0] - mean) * rstd * gn[0] * siluf_(g0), y1 = (o[et][1] - mean) * rstd * gn[1] * siluf_(g1);
                    const float y2 = (o[et][2] - mean) * rstd * gn[2] * siluf_(g2), y3 = (o[et][3] - mean) * rstd * gn[3] * siluf_(g3);
                    u32x2 w; w.x = cvt_pk_bf16(y0, y1); w.y = cvt_pk_bf16(y2, y3);
                    *(u32x2*)(mixo + t * D + h * 64 + e0) = w;
                }
            }
            f32x4 kv[2]; ret_kv(lds, wid, fr, fq, kv);
            S[0] = S[0] * cd + kv[0]; S[1] = S[1] * cd + kv[1];
        }
    }
}

__device__ void phase_swa(const Args& a, LAS unsigned char* lds, int bid, int nb) {
    WAVE_IDS();
    const bf16* proj = (const bf16*)(a.ws + WS_BIG);
    bf16* mixo = (bf16*)(a.ws + WS_MIXO);
    const float* tab = (const float*)(a.ws + WS_TAB);
    const float* coss = tab + SEQ * 64, *sins = tab + SEQ * 72;
    const float* ascale = a.in[I_ASC]; const float* sinks = a.in[I_SINK];
    LAS bf16* Qs = (LAS bf16*)(lds + L_QS); LAS bf16* Ks = (LAS bf16*)(lds + L_KS); LAS bf16* Vt = (LAS bf16*)(lds + L_VT);
    for (int it = bid; it < BATCH * NCH * QH; it += nb) {
        const int qh = it % QH, n = (it / QH) % NCH, b = it / (QH * NCH), kvh = qh >> 2;
        __syncthreads();
        {
            const int row = tid >> 2, cg = tid & 3, pos = n * CH + row;
            const bf16* src = proj + ((size_t)b * SEQ + pos) * INW + C_AQ + qh * 64 + cg * 16;
            bf16x8 x1 = *(const bf16x8*)src, x2 = *(const bf16x8*)(src + 8);
            if (cg == 0) {
                const f32x4 c0 = *(const f32x4*)(coss + pos * 8), c1 = *(const f32x4*)(coss + pos * 8 + 4), s0 = *(const f32x4*)(sins + pos * 8), s1 = *(const f32x4*)(sins + pos * 8 + 4);
                const float cs[8] = {c0[0], c0[1], c0[2], c0[3], c1[0], c1[1], c1[2], c1[3]}, sn[8] = {s0[0], s0[1], s0[2], s0[3], s1[0], s1[1], s1[2], s1[3]};
                float o1[8], o2[8];
#pragma unroll
                for (int j = 0; j < 8; ++j) { const float a1 = bf2f((unsigned short)x1[j]), a2 = bf2f((unsigned short)x2[j]); o1[j] = a1 * cs[j] - a2 * sn[j]; o2[j] = a2 * cs[j] + a1 * sn[j]; }
                u32x4 w1, w2;
                w1.x = cvt_pk_bf16(o1[0], o1[1]); w1.y = cvt_pk_bf16(o1[2], o1[3]); w1.z = cvt_pk_bf16(o1[4], o1[5]); w1.w = cvt_pk_bf16(o1[6], o1[7]);
                w2.x = cvt_pk_bf16(o2[0], o2[1]); w2.y = cvt_pk_bf16(o2[2], o2[3]); w2.z = cvt_pk_bf16(o2[4], o2[5]); w2.w = cvt_pk_bf16(o2[6], o2[7]);
                x1 = __builtin_bit_cast(bf16x8, w1); x2 = __builtin_bit_cast(bf16x8, w2);
            }
            *(LAS bf16x8*)(Qs + row * QS + cg * 16) = x1; *(LAS bf16x8*)(Qs + row * QS + cg * 16 + 8) = x2;
        }
#pragma unroll
        for (int rep = 0; rep < 2; ++rep) {
            const int q = tid + rep * NTHREADS, kj = q >> 2, cg = q & 3, pos = n * CH - CH + kj;
            bf16x8 k1 = {0, 0, 0, 0, 0, 0, 0, 0}, k2 = k1, v1 = k1, v2 = k1;
            if (pos >= 0) {
                const bf16* srow = proj + ((size_t)b * SEQ + pos) * INW;
                k1 = *(const bf16x8*)(srow + C_AK + kvh * 64 + cg * 16); k2 = *(const bf16x8*)(srow + C_AK + kvh * 64 + cg * 16 + 8);
                v1 = *(const bf16x8*)(srow + C_AV + kvh * 64 + cg * 16); v2 = *(const bf16x8*)(srow + C_AV + kvh * 64 + cg * 16 + 8);
                if (cg == 0) {
                    const f32x4 c0 = *(const f32x4*)(coss + pos * 8), c1 = *(const f32x4*)(coss + pos * 8 + 4), s0 = *(const f32x4*)(sins + pos * 8), s1 = *(const f32x4*)(sins + pos * 8 + 4);
                    const float cs[8] = {c0[0], c0[1], c0[2], c0[3], c1[0], c1[1], c1[2], c1[3]}, sn[8] = {s0[0], s0[1], s0[2], s0[3], s1[0], s1[1], s1[2], s1[3]};
                    float o1[8], o2[8];
#pragma unroll
                    for (int j = 0; j < 8; ++j) { const float a1 = bf2f((unsigned short)k1[j]), a2 = bf2f((unsigned short)k2[j]); o1[j] = a1 * cs[j] - a2 * sn[j]; o2[j] = a2 * cs[j] + a1 * sn[j]; }
                    u32x4 w1, w2;
                    w1.x = cvt_pk_bf16(o1[0], o1[1]); w1.y = cvt_pk_bf16(o1[2], o1[3]); w1.z = cvt_pk_bf16(o1[4], o1[5]); w1.w = cvt_pk_bf16(o1[6], o1[7]);
                    w2.x = cvt_pk_bf16(o2[0], o2[1]); w2.y = cvt_pk_bf16(o2[2], o2[3]); w2.z = cvt_pk_bf16(o2[4], o2[5]); w2.w = cvt_pk_bf16(o2[6], o2[7]);
                    k1 = __builtin_bit_cast(bf16x8, w1); k2 = __builtin_bit_cast(bf16x8, w2);
                }
            }
            *(LAS bf16x8*)(Ks + kj * QS + cg * 16) = k1; *(LAS bf16x8*)(Ks + kj * QS + cg * 16 + 8) = k2;
#pragma unroll
            for (int j = 0; j < 8; ++j) { Vt[(cg * 16 + j) * TS2 + kj] = (bf16)v1[j]; Vt[(cg * 16 + 8 + j) * TS2 + kj] = (bf16)v2[j]; }
        }
        __syncthreads();
        const int jt0 = wid & ~1;
        bf16x8 qf[2];
#pragma unroll
        for (int ks = 0; ks < 2; ++ks) qf[ks] = *(const LAS bf16x8*)(Qs + (16 * wid + fr) * QS + 32 * ks + 8 * fq);
        f32x4 sc[10];
        const int i = 16 * wid + fr;
        float mx = sinks[qh];
#pragma unroll
        for (int tt = 0; tt < 10; ++tt) {
            const int jt = jt0 + tt;
            f32x4 c = {0.f, 0.f, 0.f, 0.f};
#pragma unroll
            for (int ks = 0; ks < 2; ++ks) {
                const bf16x8 kf = *(const LAS bf16x8*)(Ks + (16 * jt + fr) * QS + 32 * ks + 8 * fq);
                c = __builtin_amdgcn_mfma_f32_16x16x32_bf16(kf, qf[ks], c, 0, 0, 0);
            }
#pragma unroll
            for (int r = 0; r < 4; ++r) {
                const int kj = 16 * jt + 4 * fq + r;
                const bool valid = (kj > i) && (kj <= i + CH) && (n * CH - CH + kj >= 0);
                c[r] = valid ? c[r] * 0.125f : -1e30f;
                mx = fmaxf(mx, c[r]);
            }
            sc[tt] = c;
        }
        mx = fmaxf(mx, __shfl_xor(mx, 16)); mx = fmaxf(mx, __shfl_xor(mx, 32));
        float den = 0.f;
#pragma unroll
        for (int tt = 0; tt < 10; ++tt)
#pragma unroll
            for (int r = 0; r < 4; ++r) { const float p = (sc[tt][r] > -1e29f) ? __expf(sc[tt][r] - mx) : 0.f; sc[tt][r] = p; den += p; }
        den += __shfl_xor(den, 16); den += __shfl_xor(den, 32);
        den += __expf(sinks[qh] - mx);
        const float inv = 1.0f / den;
        f32x4 o[4];
#pragma unroll
        for (int et = 0; et < 4; ++et) o[et] = (f32x4){0.f, 0.f, 0.f, 0.f};
#pragma unroll
        for (int k2 = 0; k2 < 5; ++k2) {
            u32x4 pw;
            pw.x = cvt_pk_bf16(sc[2 * k2][0] * inv, sc[2 * k2][1] * inv); pw.y = cvt_pk_bf16(sc[2 * k2][2] * inv, sc[2 * k2][3] * inv);
            pw.z = cvt_pk_bf16(sc[2 * k2 + 1][0] * inv, sc[2 * k2 + 1][1] * inv); pw.w = cvt_pk_bf16(sc[2 * k2 + 1][2] * inv, sc[2 * k2 + 1][3] * inv);
            const bf16x8 pf = __builtin_bit_cast(bf16x8, pw);
            const int kb = 16 * (jt0 + 2 * k2);
#pragma unroll
            for (int et = 0; et < 4; ++et) {
                const u32x2 va = *(const LAS u32x2*)(Vt + (16 * et + fr) * TS2 + kb + 4 * fq);
                const u32x2 vb = *(const LAS u32x2*)(Vt + (16 * et + fr) * TS2 + kb + 16 + 4 * fq);
                u32x4 vw; vw.x = va.x; vw.y = va.y; vw.z = vb.x; vw.w = vb.y;
                o[et] = __builtin_amdgcn_mfma_f32_16x16x32_bf16(__builtin_bit_cast(bf16x8, vw), pf, o[et], 0, 0, 0);
            }
        }
        const size_t t = (size_t)b * SEQ + n * CH + i;
#pragma unroll
        for (int et = 0; et < 4; ++et) {
            const int e0 = 16 * et + 4 * fq;
            const f32x4 as = *(const f32x4*)(ascale + qh * 64 + e0);
            u32x2 w; w.x = cvt_pk_bf16(o[et][0] * as[0], o[et][1] * as[1]); w.y = cvt_pk_bf16(o[et][2] * as[2], o[et][3] * as[3]);
            *(u32x2*)(mixo + t * D + 512 + qh * 64 + e0) = w;
        }
    }
}

template <int MODE>
__device__ void phase_ln(const float* src, const float* g, const float* bta, bf16* dstb, float* dstf, int bid, int nb) {
    const int tid = hidden_tid(), wid = tid >> 6, lane = tid & 63;
    f32x4 gv[4], bv[4];
#pragma unroll
    for (int i = 0; i < 4; ++i) { gv[i] = *(const f32x4*)(g + 256 * i + lane * 4); bv[i] = *(const f32x4*)(bta + 256 * i + lane * 4); }
    for (int row = bid * 8 + wid; row < T; row += nb * 8) {
        const float* r = src + (size_t)row * D;
        f32x4 v[4]; float s = 0.f;
#pragma unroll
        for (int i = 0; i < 4; ++i) { v[i] = *(const f32x4*)(r + 256 * i + lane * 4); s += (v[i][0] + v[i][1]) + (v[i][2] + v[i][3]); }
#pragma unroll
        for (int o = 32; o >= 1; o >>= 1) s += __shfl_xor(s, o);
        const float mean = s * (1.0f / D);
        float q = 0.f;
#pragma unroll
        for (int i = 0; i < 4; ++i) { const f32x4 d = v[i] - mean; q += (d[0] * d[0] + d[1] * d[1]) + (d[2] * d[2] + d[3] * d[3]); }
#pragma unroll
        for (int o = 32; o >= 1; o >>= 1) q += __shfl_xor(q, o);
        const float rstd = rsqrtf(q * (1.0f / D) + LN_EPS);
#pragma unroll
        for (int i = 0; i < 4; ++i) {
            const f32x4 y = (v[i] - mean) * rstd * gv[i] + bv[i];
            if (MODE == 0) { u32x2 w; w.x = cvt_pk_bf16(y[0], y[1]); w.y = cvt_pk_bf16(y[2], y[3]); *(u32x2*)(dstb + (size_t)row * D + 256 * i + lane * 4) = w; }
            else *(f32x4*)(dstf + (size_t)row * D + 256 * i + lane * 4) = y;
        }
    }
}

__device__ void phase_router(const Args& a, LAS unsigned char* lds, int bid, int nb) {
    WAVE_IDS();
    const bf16* x1b = (const bf16*)(a.ws + WS_XB); const bf16* wrt = (const bf16*)(a.ws + WS_WRT);
    unsigned char* ro = a.ws + WS_ROUT;
    int* ridx = (int*)(ro + RO_RIDX); float* rw = (float*)(ro + RO_RW); int* cnt = (int*)(ro + RO_CNT);
    const float* rbias = a.in[I_RB];
    LAS float* lg = (LAS float*)lds;
    LAS float* bi = lg + 128 * 65;
    LAS int* hist = (LAS int*)(bi + 128 * 65);
    for (int u = bid; u < T / 128; u += nb) {
        __syncthreads();
        if (tid < 64) hist[tid] = 0;
        {
            f32x4 c[4];
#pragma unroll
            for (int et = 0; et < 4; ++et) c[et] = (f32x4){0.f, 0.f, 0.f, 0.f};
            const bf16* xa = x1b + (size_t)(u * 128 + 16 * wid + fr) * D + 8 * fq;
#pragma unroll 4
            for (int k0 = 0; k0 < D; k0 += 32) {
                const bf16x8 xf = *(const bf16x8*)(xa + k0);
#pragma unroll
                for (int et = 0; et < 4; ++et) {
                    const bf16x8 wf = *(const bf16x8*)(wrt + (size_t)(16 * et + fr) * D + k0 + 8 * fq);
                    c[et] = __builtin_amdgcn_mfma_f32_16x16x32_bf16(wf, xf, c[et], 0, 0, 0);
                }
            }
#pragma unroll
            for (int et = 0; et < 4; ++et)
#pragma unroll
                for (int r = 0; r < 4; ++r) {
                    const int e = 16 * et + 4 * fq + r; const float s = sigmoidf_(c[et][r]);
                    lg[(16 * wid + fr) * 65 + e] = s; bi[(16 * wid + fr) * 65 + e] = s + rbias[e];
                }
        }
        __syncthreads();
        if (tid < 128) {
            const LAS float* mb = bi + tid * 65; const LAS float* ms = lg + tid * 65;
            float gs[8];
#pragma unroll
            for (int g = 0; g < 8; ++g) {
                float m1 = -3e38f, m2 = -3e38f;
#pragma unroll
                for (int j = 0; j < 8; ++j) { const float v = mb[g * 8 + j]; if (v > m1) { m2 = m1; m1 = v; } else if (v > m2) m2 = v; }
                gs[g] = m1 + m2;
            }
            unsigned gmask = 0;
#pragma unroll
            for (int rnd = 0; rnd < 4; ++rnd) {
                float best = -3e38f; int bg = 0;
#pragma unroll
                for (int g = 0; g < 8; ++g) { const bool ok = !((gmask >> g) & 1u) && gs[g] > best; best = ok ? gs[g] : best; bg = ok ? g : bg; }
                gmask |= 1u << bg;
            }
            unsigned long long taken = 0ull;
            int sel[8]; float wsel[8]; float wsum = 0.f;
#pragma unroll
            for (int rnd = 0; rnd < 8; ++rnd) {
                float best = -3e38f; int be = 0;
#pragma unroll 1
                for (int e = 0; e < 64; ++e) {
                    const bool ok = ((gmask >> (e >> 3)) & 1u) && !((taken >> e) & 1ull);
                    const float v = mb[e];
                    if (ok && v > best) { best = v; be = e; }
                }
                taken |= 1ull << be;
                sel[rnd] = be; wsel[rnd] = ms[be]; wsum += wsel[rnd];
            }
            const float sc = ROUTED_SCALE / wsum;
            const size_t t = (size_t)u * 128 + tid;
#pragma unroll
            for (int k = 0; k < 8; ++k) { ridx[t * 8 + k] = sel[k]; rw[t * 8 + k] = wsel[k] * sc; __hip_atomic_fetch_add(&hist[sel[k]], 1, __ATOMIC_RELAXED, __HIP_MEMORY_SCOPE_WORKGROUP); }
        }
        __syncthreads();
        if (tid < 64) cnt[u * 64 + tid] = hist[tid];
    }
}

__device__ void phase_sort(const Args& a, LAS unsigned char* lds, int bid, int nb) {
    const int tid = hidden_tid();
    unsigned char* ro = a.ws + WS_ROUT;
    const int* ridx = (const int*)(ro + RO_RIDX); const float* rw = (const float*)(ro + RO_RW); const int* cnt = (const int*)(ro + RO_CNT);
    int* stok = (int*)(ro + RO_STOK); int* dest = (int*)(ro + RO_DEST); float* rsc = (float*)(ro + RO_RSC); int* tile = (int*)(ro + RO_TILE);
    LAS int* tot = (LAS int*)lds; LAS int* pos0 = tot + 64; LAS int* lcnt = pos0 + 64; LAS int* base = lcnt + 64;
    constexpr int UPC = TC / 128;
    for (int u = bid; u < T / 128; u += nb) {
        const int c = u / UPC, ul = u % UPC;
        __syncthreads();
        if (tid < 64) {
            int tt = 0, pre = 0;
            for (int q = 0; q < UPC; ++q) { const int v = cnt[(c * UPC + q) * 64 + tid]; tt += v; pre += (q < ul) ? v : 0; }
            tot[tid] = tt; pos0[tid] = pre; lcnt[tid] = 0;
        }
        __syncthreads();
        if (tid == 0) { int acc = 0; for (int e = 0; e < 64; ++e) { base[e] = acc; acc += (tot[e] + 255) & ~255; } base[64] = acc; }
        __syncthreads();
        int* stok_c = stok + (size_t)c * RMAX; int* dest_c = dest + (size_t)c * RMAX; float* rsc_c = rsc + (size_t)c * RMAX;
#pragma unroll
        for (int rep = 0; rep < 2; ++rep) {
            const int pr = tid + rep * NTHREADS, tl = pr >> 3, k = pr & 7;
            const size_t t = (size_t)u * 128 + tl;
            const int e = ridx[t * 8 + k];
            const int rank = __hip_atomic_fetch_add(&lcnt[e], 1, __ATOMIC_RELAXED, __HIP_MEMORY_SCOPE_WORKGROUP);
            const int pos = base[e] + pos0[e] + rank;
            stok_c[pos] = (int)t; dest_c[pos] = (int)(t - (size_t)c * TC) * 8 + k; rsc_c[pos] = rw[t * 8 + k];
        }
        if (ul < 64) {
            const int e = ul, lo = base[e] + tot[e], hi = base[e + 1];
            for (int r = lo + tid; r < hi; r += NTHREADS) { stok_c[r] = c * TC; dest_c[r] = TC * 8; rsc_c[r] = 0.f; }
        }
        if (ul == 0) {
            const int ntl = base[64] / 256;
            for (int mt = tid; mt < ntl; mt += NTHREADS) { int e = 0; for (int q = 1; q < 64; ++q) e = (base[q] <= mt * 256) ? q : e; tile[c * TILE_STRIDE + mt] = e; }
            if (tid == 0) tile[c * TILE_STRIDE + TILE_STRIDE - 1] = ntl;
        }
    }
}

struct SchedSharedPP {
    int G, c;
    __device__ __forceinline__ bool next(int i, gf::Unit& u) const {
        constexpr int nU1 = (T / 256) * 2, nU2 = (T / 256) * 4;
        const int L = i * G + c; if (L >= nU1 + nU2) return false;
        u.rowidx = nullptr; u.keep = 0; u.x0 = 0;
        if (L < nU1) { const int pm = L >> 1, pn = L & 1; u.A = (unsigned)WS_XB + (unsigned)pm * 256u * (D * 2); u.B = (unsigned)WS_WS13T + (unsigned)pn * 256u * (D * 2); u.lda = D * 2; u.ldb = D * 2; u.nt = D / 64; u.kind = 0; u.r0 = pm * 256; u.c0 = pn * 128; }
        else { const int v = L - nU1, pm = v >> 2, pn = v & 3; u.A = (unsigned)WS_PB + (unsigned)pm * 256u * (PLE * 2); u.B = (unsigned)WS_WPT + (unsigned)pn * 256u * (PLE * 2); u.lda = PLE * 2; u.ldb = PLE * 2; u.nt = PLE / 64; u.kind = 1; u.r0 = pm * 256; u.c0 = pn * 256; }
        return true;
    }
};
struct EpiSharedPP { bf16* hs; bf16* pp;
    __device__ __forceinline__ void operator()(f32x4 (&acc)[2][2][4][2], const gf::Unit& u, int wr, int wc, int fr, int fq) const {
        if (u.kind == 0) epi_gate(acc, hs, SDIM, u.r0, u.c0, wr, wc, fr, fq); else epi_bf16(acc, pp, D, u.r0, u.c0, wr, wc, fr, fq);
    }
};
__device__ void phase_shared_pp(const Args& a, LAS unsigned char* lds, int bid, int nb) {
    SchedSharedPP S{nb, vcu_of(bid, nb)};
    EpiSharedPP E{(bf16*)(a.ws + WS_HS), (bf16*)(a.ws + WS_PP)};
    gf::gemm_fast<true>(lds, a.ws, S, E);
}

struct SchedBase {
    int G, c;
    __device__ __forceinline__ bool next(int i, gf::Unit& u) const {
        constexpr int nU = (T / 256) * 4;
        const int v = (i >> 1) * G + c, part = i & 1; if (v >= nU) return false;
        const int pm = v >> 2, pn = v & 3;
        u.rowidx = nullptr; u.x0 = 0; u.r0 = pm * 256; u.c0 = pn * 256; u.kind = part; u.keep = 1 - part;
        if (part == 0) { u.A = (unsigned)WS_XB + (unsigned)pm * 256u * (D * 2); u.B = (unsigned)WS_WGT + (unsigned)pn * 256u * (D * 2); u.lda = D * 2; u.ldb = D * 2; u.nt = D / 64; }
        else { u.A = (unsigned)WS_HS + (unsigned)pm * 256u * (SDIM * 2); u.B = (unsigned)WS_WS2T + (unsigned)pn * 256u * (SDIM * 2); u.lda = SDIM * 2; u.ldb = SDIM * 2; u.nt = SDIM / 64; }
        return true;
    }
};
struct EpiBase { const bf16* x1b; const bf16* pp; const float* bg; float* y;
    __device__ __forceinline__ void operator()(f32x4 (&acc)[2][2][4][2], const gf::Unit& u, int wr, int wc, int fr, int fq) const {
        if (u.kind == 0) {
#pragma unroll
            for (int ai = 0; ai < 2; ++ai)
#pragma unroll
                for (int m = 0; m < 4; ++m) {
                    const size_t t = (size_t)(u.r0 + 128 * ai + 64 * wr + 16 * m + fr);
#pragma unroll
                    for (int bj = 0; bj < 2; ++bj) {
                        const int col = u.c0 + 128 * bj + 32 * wc + 8 * fq;
                        const f32x4 b0 = *(const f32x4*)(bg + col), b1 = *(const f32x4*)(bg + col + 4);
                        const u32x4 pw = *(const u32x4*)(pp + t * D + col), xw = *(const u32x4*)(x1b + t * D + col);
                        const unsigned pws[4] = {pw.x, pw.y, pw.z, pw.w}, xws[4] = {xw.x, xw.y, xw.z, xw.w};
                        float v[8];
#pragma unroll
                        for (int j = 0; j < 8; ++j) {
                            const float gacc = acc[ai][bj][m][j >> 2][j & 3] + ((j < 4) ? b0[j & 3] : b1[j & 3]);
                            const float ppv = (j & 1) ? bf2f(pws[j >> 1] >> 16) : bf2f(pws[j >> 1] & 0xffffu);
                            const float xv = (j & 1) ? bf2f(xws[j >> 1] >> 16) : bf2f(xws[j >> 1] & 0xffffu);
                            v[j] = sigmoidf_(gacc) * ppv + ALPHA * xv;
                        }
                        acc[ai][bj][m][0] = (f32x4){v[0], v[1], v[2], v[3]}; acc[ai][bj][m][1] = (f32x4){v[4], v[5], v[6], v[7]};
                    }
                    asm volatile("" : "+v"(acc[ai][0][m][0]), "+v"(acc[ai][0][m][1]), "+v"(acc[ai][1][m][0]), "+v"(acc[ai][1][m][1]) :: "memory");
                }
        } else {
#pragma unroll
            for (int ai = 0; ai < 2; ++ai)
#pragma unroll
                for (int m = 0; m < 4; ++m) {
                    const size_t off = (size_t)(u.r0 + 128 * ai + 64 * wr + 16 * m + fr) * D + u.c0 + 32 * wc + 8 * fq;
#pragma unroll
                    for (int bj = 0; bj < 2; ++bj)
#pragma unroll
                        for (int n = 0; n < 2; ++n) *(f32x4*)(y + off + 128 * bj + 4 * n) = acc[ai][bj][m][n];
                }
        }
    }
};
__device__ void phase_base(const Args& a, LAS unsigned char* lds, int bid, int nb) {
    SchedBase S{nb, vcu_of(bid, nb)};
    EpiBase E{(const bf16*)(a.ws + WS_XB), (const bf16*)(a.ws + WS_PP), a.in[I_BG], a.out};
    gf::gemm_fast<true>(lds, a.ws, S, E);
}

struct SchedMoeUp {
    const int* stok; const int* tile; int nU, G, c;
    __device__ __forceinline__ bool next(int i, gf::Unit& u) const {
        const int L = i * G + c; if (L >= nU) return false;
        const int mt = L >> 1, pn = L & 1, e = uload(tile + mt);
        u.A = (unsigned)WS_XB; u.rowidx = stok + mt * 256; u.B = (unsigned)WS_W13T + ((unsigned)e * 512u + pn * 256u) * (D * 2); u.lda = D * 2; u.ldb = D * 2; u.nt = D / 64; u.keep = 0;
        u.kind = 0; u.r0 = mt * 256; u.c0 = pn * 128; u.x0 = 0; return true;
    }
};
struct EpiMoeUp { bf16* hsort; __device__ __forceinline__ void operator()(f32x4 (&acc)[2][2][4][2], const gf::Unit& u, int wr, int wc, int fr, int fq) const { epi_gate(acc, hsort, EDIM, u.r0, u.c0, wr, wc, fr, fq); } };
__device__ void phase_moe_up(const Args& a, LAS unsigned char* lds, int c, int bid, int nb) {
    unsigned char* ro = a.ws + WS_ROUT;
    const int* tile = (const int*)(ro + RO_TILE) + c * TILE_STRIDE;
    SchedMoeUp S{(const int*)(ro + RO_STOK) + (size_t)c * RMAX, tile, uload(tile + TILE_STRIDE - 1) * 2, nb, vcu_of(bid, nb)};
    EpiMoeUp E{(bf16*)(a.ws + WS_HSORT)};
    gf::gemm_fast<true>(lds, a.ws, S, E);
}
struct SchedMoeDown {
    const int* tile; int nU, G, c;
    __device__ __forceinline__ bool next(int i, gf::Unit& u) const {
        const int L = i * G + c; if (L >= nU) return false;
        const int mt = L >> 2, pn = L & 3, e = uload(tile + mt);
        u.A = (unsigned)WS_HSORT + (unsigned)mt * 256u * (EDIM * 2); u.rowidx = nullptr; u.B = (unsigned)WS_W2T + ((unsigned)e * D + pn * 256u) * (EDIM * 2); u.lda = EDIM * 2; u.ldb = EDIM * 2; u.nt = EDIM / 64; u.keep = 0;
        u.kind = 0; u.r0 = mt * 256; u.c0 = pn * 256; u.x0 = 0; return true;
    }
};
struct EpiMoeDown { const int* dest; const float* rsc; bf16* contrib;
    __device__ __forceinline__ void operator()(f32x4 (&acc)[2][2][4][2], const gf::Unit& u, int wr, int wc, int fr, int fq) const {
#pragma unroll
        for (int ai = 0; ai < 2; ++ai)
#pragma unroll
            for (int m = 0; m < 4; ++m) {
                const int r = u.r0 + 128 * ai + 64 * wr + 16 * m + fr;
                const int dr = dest[r]; const float s = rsc[r];
                bf16* rp = contrib + (size_t)dr * D + u.c0 + 32 * wc + 8 * fq;
#pragma unroll
                for (int bj = 0; bj < 2; ++bj) {
                    const f32x4 v0 = acc[ai][bj][m][0] * s, v1 = acc[ai][bj][m][1] * s;
                    u32x4 w; w.x = cvt_pk_bf16(v0[0], v0[1]); w.y = cvt_pk_bf16(v0[2], v0[3]); w.z = cvt_pk_bf16(v1[0], v1[1]); w.w = cvt_pk_bf16(v1[2], v1[3]);
                    *(u32x4*)(rp + 128 * bj) = w;
                }
                asm volatile("" ::: "memory");
            }
    }
};
__device__ void phase_moe_down(const Args& a, LAS unsigned char* lds, int c, int bid, int nb) {
    unsigned char* ro = a.ws + WS_ROUT;
    const int* tile = (const int*)(ro + RO_TILE) + c * TILE_STRIDE;
    SchedMoeDown S{tile, uload(tile + TILE_STRIDE - 1) * 4, nb, vcu_of(bid, nb)};
    EpiMoeDown E{(const int*)(ro + RO_DEST) + (size_t)c * RMAX, (const float*)(ro + RO_RSC) + (size_t)c * RMAX, (bf16*)(a.ws + WS_CONTRIB)};
    gf::gemm_fast<false>(lds, a.ws, S, E);
}
__device__ void phase_combine(const Args& a, int c, int bid, int nb) {
    const int tid = hidden_tid(), wid = tid >> 6, lane = tid & 63;
    const bf16* contrib = (const bf16*)(a.ws + WS_CONTRIB);
    const float* g = a.in[I_LN2G]; const float* bta = a.in[I_LN2B]; float* y = a.out;
    f32x4 gv[4], bv[4];
#pragma unroll
    for (int j = 0; j < 2; ++j) { gv[2 * j] = *(const f32x4*)(g + 512 * j + 8 * lane); gv[2 * j + 1] = *(const f32x4*)(g + 512 * j + 8 * lane + 4); bv[2 * j] = *(const f32x4*)(bta + 512 * j + 8 * lane); bv[2 * j + 1] = *(const f32x4*)(bta + 512 * j + 8 * lane + 4); }
    for (int rl = bid * 8 + wid; rl < TC; rl += nb * 8) {
        float* row = y + ((size_t)c * TC + rl) * D;
        f32x4 v[4];
#pragma unroll
        for (int j = 0; j < 2; ++j) { v[2 * j] = *(const f32x4*)(row + 512 * j + 8 * lane); v[2 * j + 1] = *(const f32x4*)(row + 512 * j + 8 * lane + 4); }
#pragma unroll
        for (int k = 0; k < 8; ++k) {
            const bf16* cr = contrib + ((size_t)rl * 8 + k) * D;
#pragma unroll
            for (int j = 0; j < 2; ++j) {
                const u32x4 cw = *(const u32x4*)(cr + 512 * j + 8 * lane);
                v[2 * j][0] += bf2f(cw.x & 0xffffu); v[2 * j][1] += bf2f(cw.x >> 16); v[2 * j][2] += bf2f(cw.y & 0xffffu); v[2 * j][3] += bf2f(cw.y >> 16);
                v[2 * j + 1][0] += bf2f(cw.z & 0xffffu); v[2 * j + 1][1] += bf2f(cw.z >> 16); v[2 * j + 1][2] += bf2f(cw.w & 0xffffu); v[2 * j + 1][3] += bf2f(cw.w >> 16);
            }
        }
        float s = 0.f;
#pragma unroll
        for (int i = 0; i < 4; ++i) s += (v[i][0] + v[i][1]) + (v[i][2] + v[i][3]);
#pragma unroll
        for (int o = 32; o >= 1; o >>= 1) s += __shfl_xor(s, o);
        const float mean = s * (1.0f / D);
        float q = 0.f;
#pragma unroll
        for (int i = 0; i < 4; ++i) { const f32x4 d = v[i] - mean; q += (d[0] * d[0] + d[1] * d[1]) + (d[2] * d[2] + d[3] * d[3]); }
#pragma unroll
        for (int o = 32; o >= 1; o >>= 1) q += __shfl_xor(q, o);
        const float rstd = rsqrtf(q * (1.0f / D) + LN_EPS);
#pragma unroll
        for (int j = 0; j < 2; ++j) {
            *(f32x4*)(row + 512 * j + 8 * lane) = (v[2 * j] - mean) * rstd * gv[2 * j] + bv[2 * j];
            *(f32x4*)(row + 512 * j + 8 * lane + 4) = (v[2 * j + 1] - mean) * rstd * gv[2 * j + 1] + bv[2 * j + 1];
        }
    }
}

#define XB_TMO      128
#define XB_XCNT(j)  (256  + 64 * (j))
#define XB_XSUB(j)  (1280 + 64 * (j))
#define XB_XGEN(j)  (2304 + 64 * (j))
#define XB_TOP      3328
#define XB_TOPGEN   3392
#define XCD_BAR_WORDS 3456
#define XB_SPIN_CAP (1u << 18)

__device__ __forceinline__ unsigned xb_ld(unsigned* p)              { return __hip_atomic_load(p, __ATOMIC_RELAXED, __HIP_MEMORY_SCOPE_AGENT); }
__device__ __forceinline__ unsigned xb_add(unsigned* p, unsigned v) { return __hip_atomic_fetch_add(p, v, __ATOMIC_RELAXED, __HIP_MEMORY_SCOPE_AGENT); }
__device__ __forceinline__ unsigned xb_xcc_id() { return (unsigned)__builtin_amdgcn_s_getreg((3 << 11) | 20) & 0xFu; }
#define XB_SPIN(cond, bar) do { unsigned _sp = 0; while (cond) { __builtin_amdgcn_s_sleep(1); \
    if ((++_sp & 255u) == 0u) { if (xb_ld(&(bar)[XB_TMO])) break; if (_sp > XB_SPIN_CAP) { atomicAdd(&(bar)[XB_TMO], 1u); break; } } } } while (0)

struct XcdBarrier {
    unsigned* bar; unsigned x;
    volatile LAS unsigned* st;
};
__device__ __forceinline__ XcdBarrier xcd_barrier_post(unsigned* bar, volatile LAS unsigned* st) {
    XcdBarrier b; b.bar = bar; b.x = xb_xcc_id(); b.st = st;
    if (threadIdx.x == 0) (void)xb_add(&bar[XB_XCNT(b.x)], 1u);
    return b;
}
__device__ __forceinline__ void xcd_barrier_complete(unsigned* bar, unsigned x, unsigned& nloc, unsigned& nx) {
    const unsigned G = gridDim.x * gridDim.y * gridDim.z;
    unsigned sum, cnt, mine, sp = 0u;
    for (;;) {
        sum = 0u; cnt = 0u; mine = 0u;
#pragma unroll
        for (unsigned j = 0; j < 16; ++j) { const unsigned c = xb_ld(&bar[XB_XCNT(j)]); sum += c; cnt += (c > 0u) ? 1u : 0u; mine = (j == x) ? c : mine; }
        if (sum == G) break;
        __builtin_amdgcn_s_sleep(1);
        if ((++sp & 255u) == 0u) { if (xb_ld(&bar[XB_TMO])) break; if (sp > XB_SPIN_CAP) { atomicAdd(&bar[XB_TMO], 1u); break; } }
    }
    nloc = mine > 0u ? mine : 1u; nx = cnt > 0u ? cnt : 1u;
}
__device__ __forceinline__ void xcd_barrier(const XcdBarrier& b) {
    asm volatile("s_waitcnt vmcnt(0)" ::: "memory");
    __syncthreads();
    if (threadIdx.x == 0) {
        unsigned* bar = b.bar;
        __builtin_amdgcn_s_waitcnt(0);
        unsigned nloc = b.st[0], nx = b.st[1];
        if (nloc == 0u) { xcd_barrier_complete(bar, b.x, nloc, nx); b.st[0] = nloc; b.st[1] = nx; }
        const unsigned old = xb_add(&bar[XB_XSUB(b.x)], 1u);
        const unsigned gen = old / nloc;
        if (old + 1u == (gen + 1u) * nloc) {
            __builtin_amdgcn_fence(__ATOMIC_RELEASE, "agent");
            asm volatile("s_waitcnt vmcnt(0)" ::: "memory");
            const unsigned og = xb_add(&bar[XB_TOP], 1u);
            const unsigned tg = og / nx;
            if (og + 1u == (tg + 1u) * nx) xb_add(&bar[XB_TOPGEN], 1u);
            else XB_SPIN(xb_ld(&bar[XB_TOPGEN]) == tg, bar);
            __builtin_amdgcn_fence(__ATOMIC_ACQUIRE, "agent");
            xb_add(&bar[XB_XGEN(b.x)], 1u);
            asm volatile("s_waitcnt vmcnt(0)" ::: "memory");
        } else {
            XB_SPIN(xb_ld(&bar[XB_XGEN(b.x)]) == gen, bar);
            __builtin_amdgcn_fence(__ATOMIC_ACQUIRE, "agent");
            asm volatile("s_waitcnt vmcnt(0)" ::: "memory");
        }
    }
    __syncthreads();
}

constexpr int PH_PROLOGUE = 0, PH_PROJ = 1, PH_MIX_A = 2, PH_MIX_B = 3, PH_WOUT = 4, PH_LN1 = 5, PH_ROUTER = 6, PH_SORT = 7, PH_SHARED = 8, PH_BASE = 9, PH_MOE0 = 10, PH_END = PH_MOE0 + 3 * NH;
constexpr int LDS_BYTES = 147456;

constexpr int LDS_BAR_OFF = LDS_BYTES - 16;
#ifndef N_LAUNCHES
#define N_LAUNCHES 1
#endif
__global__ void __launch_bounds__(NTHREADS, 2) fwd(Args a) {
    extern __shared__ __attribute__((aligned(16))) unsigned char lds_raw[];
    LAS unsigned char* lds = (LAS unsigned char*)lds_raw;
    const int bid = blockIdx.x, nb = gridDim.x;
    if (threadIdx.x < 4) ((LAS unsigned*)(lds + LDS_BAR_OFF))[threadIdx.x] = 0u;
    __syncthreads();
    XcdBarrier bar = xcd_barrier_post((unsigned*)(a.ws + WS_CTL), (volatile LAS unsigned*)(lds + LDS_BAR_OFF));
    const int lo = a.ph_lo, hi = a.ph_hi;
#ifndef PHMASK
#define PHMASK 0xffffffffu
#endif
#define IN(k) (((PHMASK >> ((k) < PH_MOE0 ? (k) : 10 + ((k) - PH_MOE0) % 3)) & 1u) && lo <= (k) && (k) < hi)
#define SEAM(k) do { if (lo <= (k) && (k) + 1 < hi) xcd_barrier(bar); } while (0)
    if (IN(PH_PROLOGUE)) phase_prologue(a, lds, bid, nb);
    SEAM(PH_PROLOGUE);
    if (IN(PH_PROJ)) phase_proj(a, lds, bid, nb);
    SEAM(PH_PROJ);
    if (IN(PH_MIX_A)) { phase_segtot(a, lds, bid, nb); phase_swa(a, lds, bid, nb); }
    SEAM(PH_MIX_A);
    if (IN(PH_MIX_B)) phase_retention(a, lds, bid, nb);
    SEAM(PH_MIX_B);
    if (IN(PH_WOUT)) phase_wout(a, lds, bid, nb);
    SEAM(PH_WOUT);
    if (IN(PH_LN1)) phase_ln<0>(a.out, a.in[I_LN1G], a.in[I_LN1B], (bf16*)(a.ws + WS_XB), nullptr, bid, nb);
    SEAM(PH_LN1);
    if (IN(PH_ROUTER)) phase_router(a, lds, bid, nb);
    SEAM(PH_ROUTER);
    if (IN(PH_SORT)) phase_sort(a, lds, bid, nb);
    SEAM(PH_SORT);
    if (IN(PH_SHARED)) phase_shared_pp(a, lds, bid, nb);
    SEAM(PH_SHARED);
    if (IN(PH_BASE)) phase_base(a, lds, bid, nb);
    SEAM(PH_BASE);
    for (int c = 0; c < NH; ++c) {
        if (IN(PH_MOE0 + 3 * c)) phase_moe_up(a, lds, c, bid, nb);
        SEAM(PH_MOE0 + 3 * c);
        if (IN(PH_MOE0 + 3 * c + 1)) phase_moe_down(a, lds, c, bid, nb);
        SEAM(PH_MOE0 + 3 * c + 1);
        if (IN(PH_MOE0 + 3 * c + 2)) phase_combine(a, c, bid, nb);
        SEAM(PH_MOE0 + 3 * c + 2);
    }
#undef IN
#undef SEAM
}

extern "C" void kernel_launch(void* const* d_in, const int* in_sizes, int n_in, void* d_out, int out_size, void* d_ws, size_t ws_size, hipStream_t stream) {
    static int grid = 0;
    if (grid == 0) {
        if (n_in != 22 || out_size != T * D || ws_size < WS_NEED) { fprintf(stderr, "kernel_launch: unexpected shapes: n_in %d out %d ws %zu (need %zu)\n", n_in, out_size, ws_size, (size_t)WS_NEED); grid = -1; return; }
        int dev = 0, cus = 0;
        (void)hipGetDevice(&dev); (void)hipDeviceGetAttribute(&cus, hipDeviceAttributeMultiprocessorCount, dev);
        if (hipFuncSetAttribute((const void*)fwd, hipFuncAttributeMaxDynamicSharedMemorySize, LDS_BYTES) != hipSuccess) { fprintf(stderr, "hipFuncSetAttribute failed\n"); grid = -1; return; }
        int per_cu = 0;
        if (hipOccupancyMaxActiveBlocksPerMultiprocessor(&per_cu, (const void*)fwd, NTHREADS, LDS_BYTES) != hipSuccess || per_cu < 1) { fprintf(stderr, "occupancy query: %d blocks per CU\n", per_cu); grid = -1; return; }
        (void)hipGetLastError();
        grid = cus > 0 ? cus : 256;
    }
    if (grid < 0) return;
    (void)hipMemsetAsync((char*)d_ws + WS_CTL, 0, 16384, stream);
    Args a{};
    for (int i = 0; i < 22; ++i) a.in[i] = (const float*)d_in[i];
    a.out = (float*)d_out; a.ws = (unsigned char*)d_ws;
#if N_LAUNCHES == 1
    a.ph_lo = 0; a.ph_hi = PH_END;
    hipLaunchKernelGGL(fwd, dim3(grid), dim3(NTHREADS), LDS_BYTES, stream, a);
#else
    for (int ph = 0; ph < PH_END; ++ph) {
        a.ph_lo = ph; a.ph_hi = ph + 1;
        hipLaunchKernelGGL(fwd, dim3(grid), dim3(NTHREADS), LDS_BYTES, stream, a);
    }
#endif
}
```

```cpp
#include <hip/hip_runtime.h>
#include <cstdio>
#include <cstdint>

#define LAS __attribute__((address_space(3)))
typedef unsigned short bf16;
typedef short bf16x8 __attribute__((ext_vector_type(8)));
typedef short bf16x4 __attribute__((ext_vector_type(4)));
typedef float f32x4 __attribute__((ext_vector_type(4)));
typedef unsigned u32x4 __attribute__((ext_vector_type(4)));
typedef unsigned u32x2 __attribute__((ext_vector_type(2)));

constexpr int D = 1024, BATCH = 8, SEQ = 4096, T = BATCH * SEQ;
constexpr int HD = 64, RH = 8, QH = 8, KVH = 2;
constexpr int INW = 2816;
constexpr int C_RQ = 0, C_RK = 512, C_RV = 1024, C_RG = 1536, C_AQ = 2048, C_AK = 2560, C_AV = 2688;
constexpr int CH = 128, NCH = SEQ / CH;
constexpr int SEGC = 8, NSEG = NCH / SEGC;
constexpr int NE = 64, TOPK = 8, EDIM = 256, SDIM = 256, PLE = 256;
constexpr float LN_EPS = 1e-5f, GN_EPS = 1e-6f;
constexpr float ALPHA = 1.189207115002721f;
constexpr float ROUTED_SCALE = 2.5f;
constexpr int NH = 2, TC = T / NH;
constexpr int RMAX = TC * TOPK + NE * 256;
constexpr int MAXTILES = RMAX / 256;
constexpr int NTHREADS = 512;

constexpr size_t MiB = 1u << 20;
constexpr size_t al(size_t x) { return (x + 255) & ~(size_t)255; }
constexpr size_t WS_CTL = 0, CTL_BYTES = 1 * MiB;
constexpr size_t WS_W13T = WS_CTL + CTL_BYTES;
constexpr size_t WS_W2T = WS_W13T + al((size_t)NE * 512 * D * 2);
constexpr size_t WS_ROUT = WS_W2T + al((size_t)NE * D * EDIM * 2);
constexpr size_t RO_RIDX = 0, RO_RW = RO_RIDX + (size_t)T * 8 * 4, RO_CNT = RO_RW + (size_t)T * 8 * 4, RO_STOK = RO_CNT + 256 * 64 * 4;
constexpr size_t RO_DEST = RO_STOK + (size_t)NH * RMAX * 4, RO_RSC = RO_DEST + (size_t)NH * RMAX * 4, RO_TILE = RO_RSC + (size_t)NH * RMAX * 4;
constexpr int TILE_STRIDE = 1024;
static_assert(MAXTILES < TILE_STRIDE - 1, "tile table");
constexpr size_t RO_END = RO_TILE + (size_t)NH * TILE_STRIDE * 4;
constexpr size_t WS_XB = WS_ROUT + al(RO_END);
constexpr size_t WS_DYN = WS_XB + al((size_t)T * D * 2);
constexpr size_t WS_WINT = WS_DYN;
constexpr size_t WS_WOUTT = WS_WINT + al((size_t)INW * D * 2);
constexpr size_t WS_WS13T = WS_WOUTT + al((size_t)D * D * 2);
constexpr size_t WS_WS2T = WS_WS13T + al((size_t)512 * D * 2);
constexpr size_t WS_WGT = WS_WS2T + al((size_t)D * SDIM * 2);
constexpr size_t WS_WPT = WS_WGT + al((size_t)D * D * 2);
constexpr size_t WS_WRT = WS_WPT + al((size_t)D * PLE * 2);
constexpr size_t WS_TAB = WS_WRT + al((size_t)NE * D * 2);
constexpr size_t TAB_BYTES = (size_t)SEQ * (32 + 32 + 8 + 8) * 4;
constexpr size_t WS_SEGT = WS_TAB + al(TAB_BYTES);
constexpr size_t WS_PB = WS_SEGT + al((size_t)BATCH * RH * NSEG * 64 * 64 * 4);
constexpr size_t WS_BIG = WS_PB + al((size_t)T * PLE * 2);
constexpr size_t WS_MIXO = WS_BIG + al((size_t)T * INW * 2);
constexpr size_t WS_PP = WS_MIXO + al((size_t)T * D * 2);
constexpr size_t WS_END1 = WS_PP + al((size_t)T * D * 2);
constexpr size_t WS_HS = WS_BIG;
constexpr size_t WS_HSORT = WS_DYN;
constexpr size_t WS_CONTRIB = WS_HSORT + al((size_t)RMAX * EDIM * 2);
constexpr size_t WS_END2 = WS_CONTRIB + al(((size_t)TC * 8 + 1) * D * 2);
constexpr size_t WS_NEED = WS_END1 > WS_END2 ? WS_END1 : WS_END2;
static_assert(WS_NEED <= 512 * MiB, "workspace map exceeds 512 MiB");

__device__ __forceinline__ int hidden_tid() { int t = threadIdx.x; asm volatile("" : "+v"(t)); return t; }
__device__ __forceinline__ float bf2f(unsigned v) { return __uint_as_float(v << 16); }
__device__ __forceinline__ unsigned cvt_pk_bf16(float lo, float hi) { unsigned r; asm volatile("v_cvt_pk_bf16_f32 %0, %1, %2" : "=v"(r) : "v"(lo), "v"(hi)); return r; }
__device__ __forceinline__ bf16 f2bf(float f) { return (bf16)(cvt_pk_bf16(f, 0.f) & 0xffffu); }
__device__ __forceinline__ float sigmoidf_(float x) { return 1.0f / (1.0f + __expf(-x)); }
__device__ __forceinline__ float siluf_(float x) { return x / (1.0f + __expf(-x)); }

struct Args {
    const float* in[22];
    float* out;
    unsigned char* ws;
    int ph_lo, ph_hi;
};
enum { I_X = 0, I_P, I_WIN, I_GN, I_ASC, I_SINK, I_WOUT, I_LN1G, I_LN1B, I_WR, I_RB, I_W1, I_W3, I_W2, I_WS1, I_WS3, I_WS2, I_WG, I_BG, I_WP, I_LN2G, I_LN2B };

struct TJob { const float* src; bf16* dst; int ld_src, ld_dst, sc0, dn0, k0; };
__device__ __forceinline__ bool get_tjob(const Args& a, int t, TJob& j) {
    unsigned char* ws = a.ws;
    if (t < NE * 32) { const int e = t >> 5, rem = t & 31, db = rem >> 2, kt = rem & 3, piece = db >> 1, which = piece & 1, pn = piece >> 1;
        j.src = (which ? a.in[I_W3] : a.in[I_W1]) + (size_t)e * D * EDIM; j.ld_src = EDIM; j.sc0 = pn * 128 + (db & 1) * 64;
        j.dst = (bf16*)(ws + WS_W13T) + (size_t)e * 512 * D; j.ld_dst = D; j.dn0 = db * 64; j.k0 = kt * 256; return true; }
    t -= NE * 32;
    if (t < NE * 16) { const int e = t >> 4, nt = t & 15;
        j.src = a.in[I_W2] + (size_t)e * EDIM * D; j.ld_src = D; j.sc0 = nt * 64; j.dst = (bf16*)(ws + WS_W2T) + (size_t)e * D * EDIM; j.ld_dst = EDIM; j.dn0 = nt * 64; j.k0 = 0; return true; }
    t -= NE * 16;
    if (t < 44 * 4) { j.src = a.in[I_WIN]; j.ld_src = INW; j.sc0 = (t >> 2) * 64; j.dst = (bf16*)(ws + WS_WINT); j.ld_dst = D; j.dn0 = (t >> 2) * 64; j.k0 = (t & 3) * 256; return true; }
    t -= 44 * 4;
    if (t < 16 * 4) { j.src = a.in[I_WOUT]; j.ld_src = D; j.sc0 = (t >> 2) * 64; j.dst = (bf16*)(ws + WS_WOUTT); j.ld_dst = D; j.dn0 = (t >> 2) * 64; j.k0 = (t & 3) * 256; return true; }
    t -= 16 * 4;
    if (t < 8 * 4) { const int db = t >> 2, piece = db >> 1, which = piece & 1, pn = piece >> 1;
        j.src = which ? a.in[I_WS3] : a.in[I_WS1]; j.ld_src = SDIM; j.sc0 = pn * 128 + (db & 1) * 64; j.dst = (bf16*)(ws + WS_WS13T); j.ld_dst = D; j.dn0 = db * 64; j.k0 = (t & 3) * 256; return true; }
    t -= 8 * 4;
    if (t < 16) { j.src = a.in[I_WS2]; j.ld_src = D; j.sc0 = t * 64; j.dst = (bf16*)(ws + WS_WS2T); j.ld_dst = SDIM; j.dn0 = t * 64; j.k0 = 0; return true; }
    t -= 16;
    if (t < 16 * 4) { j.src = a.in[I_WG]; j.ld_src = D; j.sc0 = (t >> 2) * 64; j.dst = (bf16*)(ws + WS_WGT); j.ld_dst = D; j.dn0 = (t >> 2) * 64; j.k0 = (t & 3) * 256; return true; }
    t -= 16 * 4;
    if (t < 16) { j.src = a.in[I_WP]; j.ld_src = D; j.sc0 = t * 64; j.dst = (bf16*)(ws + WS_WPT); j.ld_dst = PLE; j.dn0 = t * 64; j.k0 = 0; return true; }
    t -= 16;
    if (t < 4) { j.src = a.in[I_WR]; j.ld_src = NE; j.sc0 = 0; j.dst = (bf16*)(ws + WS_WRT); j.ld_dst = D; j.dn0 = 0; j.k0 = t * 256; return true; }
    return false;
}
constexpr int N_TJOBS = NE * 32 + NE * 16 + 44 * 4 + 16 * 4 + 8 * 4 + 16 + 16 * 4 + 16 + 4;

__device__ void phase_prologue(const Args& a, LAS unsigned char* lds, int bid, int nb) {
    LAS float* tile = (LAS float*)lds;
    unsigned char* ws = a.ws;
    const int tid = hidden_tid();
    {
        const int lr = tid >> 4, lc4 = (tid & 15) * 4;
        const int wn = tid & 63, wk = (tid >> 6) * 32;
        TJob j; f32x4 v[8];
        int t = bid;
        bool have = get_tjob(a, t, j);
        if (have) {
#pragma unroll
            for (int i = 0; i < 8; ++i) v[i] = *(const f32x4*)(j.src + (size_t)(j.k0 + lr + 32 * i) * j.ld_src + j.sc0 + lc4);
        }
        while (have) {
#pragma unroll
            for (int i = 0; i < 8; ++i) { LAS float* tp = tile + (lr + 32 * i) * 65 + lc4; tp[0] = v[i][0]; tp[1] = v[i][1]; tp[2] = v[i][2]; tp[3] = v[i][3]; }
            bf16* drow = j.dst + (size_t)(j.dn0 + wn) * j.ld_dst + j.k0 + wk;
            t += nb; TJob jn; const bool hn = get_tjob(a, t, jn);
            if (hn) {
#pragma unroll
                for (int i = 0; i < 8; ++i) v[i] = *(const f32x4*)(jn.src + (size_t)(jn.k0 + lr + 32 * i) * jn.ld_src + jn.sc0 + lc4);
            }
            __syncthreads();
#pragma unroll
            for (int q = 0; q < 4; ++q) {
                u32x4 w;
                w.x = cvt_pk_bf16(tile[(wk + 8 * q + 0) * 65 + wn], tile[(wk + 8 * q + 1) * 65 + wn]);
                w.y = cvt_pk_bf16(tile[(wk + 8 * q + 2) * 65 + wn], tile[(wk + 8 * q + 3) * 65 + wn]);
                w.z = cvt_pk_bf16(tile[(wk + 8 * q + 4) * 65 + wn], tile[(wk + 8 * q + 5) * 65 + wn]);
                w.w = cvt_pk_bf16(tile[(wk + 8 * q + 6) * 65 + wn], tile[(wk + 8 * q + 7) * 65 + wn]);
                *(u32x4*)(drow + 8 * q) = w;
            }
            __syncthreads();
            j = jn; have = hn;
        }
    }
    {
        const size_t n8 = (size_t)T * D / 8;
        const float* x = a.in[I_X]; bf16* xb = (bf16*)(ws + WS_XB);
        for (size_t i = (size_t)bid * NTHREADS + tid; i < n8; i += (size_t)nb * NTHREADS) {
            const f32x4 v0 = *(const f32x4*)(x + i * 8), v1 = *(const f32x4*)(x + i * 8 + 4);
            u32x4 w; w.x = cvt_pk_bf16(v0[0], v0[1]); w.y = cvt_pk_bf16(v0[2], v0[3]); w.z = cvt_pk_bf16(v1[0], v1[1]); w.w = cvt_pk_bf16(v1[2], v1[3]);
            *(u32x4*)(xb + i * 8) = w;
        }
        const size_t m8 = (size_t)T * PLE / 8;
        const float* p = a.in[I_P]; bf16* pb = (bf16*)(ws + WS_PB);
        for (size_t i = (size_t)bid * NTHREADS + tid; i < m8; i += (size_t)nb * NTHREADS) {
            const f32x4 v0 = *(const f32x4*)(p + i * 8), v1 = *(const f32x4*)(p + i * 8 + 4);
            u32x4 w; w.x = cvt_pk_bf16(v0[0], v0[1]); w.y = cvt_pk_bf16(v0[2], v0[3]); w.z = cvt_pk_bf16(v1[0], v1[1]); w.w = cvt_pk_bf16(v1[2], v1[3]);
            *(u32x4*)(pb + i * 8) = w;
        }
    }
    {
        float* tab = (float*)(ws + WS_TAB);
        float* cosr = tab, *sinr = tab + SEQ * 32, *coss = tab + SEQ * 64, *sins = tab + SEQ * 72;
        for (int i = bid * NTHREADS + tid; i < SEQ * 40; i += nb * NTHREADS) {
            const int s = i / 40, j = i % 40;
            if (j < 32) {
                const float inv = (float)pow(10000.0, -(double)j / 32.0);
                const float ang = (float)s * inv;
                cosr[s * 32 + j] = (float)cos((double)ang); sinr[s * 32 + j] = (float)sin((double)ang);
            } else {
                const int jj = j - 32;
                const float inv = (float)pow(500000.0, -(double)jj / 8.0);
                const float ang = (float)s * inv;
                coss[s * 8 + jj] = (float)cos((double)ang); sins[s * 8 + jj] = (float)sin((double)ang);
            }
        }
    }
}

__device__ __forceinline__ int perm32(int rho) { const int n = rho >> 4, i = rho & 15; return 8 * (i >> 2) + 4 * n + (i & 3); }

struct GemmPart { const bf16* A; int lda; const int* rowidx; long arow0; const bf16* Bt; int ldb; int K; };

__device__ __forceinline__ void gemm_part(f32x4 (&acc)[2][2][4][2], const GemmPart& g, int wr, int wc, int fr, int fq) {
    unsigned oa[2][4], ob[2][2];
#pragma unroll
    for (int ai = 0; ai < 2; ++ai)
#pragma unroll
        for (int m = 0; m < 4; ++m) {
            const int r = 128 * ai + 64 * wr + 16 * m + fr;
            const long gr = g.rowidx ? (long)g.rowidx[r] : g.arow0 + r;
            oa[ai][m] = (unsigned)((gr * g.lda + 8 * fq) * 2);
        }
#pragma unroll
    for (int bj = 0; bj < 2; ++bj)
#pragma unroll
        for (int n = 0; n < 2; ++n) {
            const int rb = 128 * bj + 32 * wc + perm32(16 * n + fr);
            ob[bj][n] = (unsigned)((rb * g.ldb + 8 * fq) * 2);
        }
    const char* pA = (const char*)g.A; const char* pB = (const char*)g.Bt;
#pragma unroll 1
    for (int k0 = 0; k0 < g.K; k0 += 32) {
        bf16x8 af[2][4], bfr[2][2];
#pragma unroll
        for (int ai = 0; ai < 2; ++ai)
#pragma unroll
            for (int m = 0; m < 4; ++m) af[ai][m] = *(const bf16x8*)(pA + oa[ai][m]);
#pragma unroll
        for (int bj = 0; bj < 2; ++bj)
#pragma unroll
            for (int n = 0; n < 2; ++n) bfr[bj][n] = *(const bf16x8*)(pB + ob[bj][n]);
#pragma unroll
        for (int ai = 0; ai < 2; ++ai)
#pragma unroll
            for (int bj = 0; bj < 2; ++bj)
#pragma unroll
                for (int m = 0; m < 4; ++m)
#pragma unroll
                    for (int n = 0; n < 2; ++n)
                        acc[ai][bj][m][n] = __builtin_amdgcn_mfma_f32_16x16x32_bf16(bfr[bj][n], af[ai][m], acc[ai][bj][m][n], 0, 0, 0);
        pA += 64; pB += 64;
    }
}
__device__ __forceinline__ void zero_acc(f32x4 (&acc)[2][2][4][2]) {
#pragma unroll
    for (int a = 0; a < 2; ++a)
#pragma unroll
        for (int b = 0; b < 2; ++b)
#pragma unroll
            for (int m = 0; m < 4; ++m)
#pragma unroll
                for (int n = 0; n < 2; ++n) acc[a][b][m][n] = (f32x4){0.f, 0.f, 0.f, 0.f};
}
#define WAVE_IDS() int tid_ = threadIdx.x; asm volatile("" : "+v"(tid_)); const int tid = tid_, wid = __builtin_amdgcn_readfirstlane(tid >> 6), lane = tid & 63, wr = wid >> 2, wc = wid & 3, fr = lane & 15, fq = lane >> 4; (void)lane; (void)wr; (void)wc; (void)fr; (void)fq

__device__ __forceinline__ void epi_bf16(const f32x4 (&acc)[2][2][4][2], bf16* O, int ldo, long row0, int col0, int wr, int wc, int fr, int fq) {
#pragma unroll
    for (int ai = 0; ai < 2; ++ai)
#pragma unroll
        for (int m = 0; m < 4; ++m) {
            bf16* rp = O + (size_t)(row0 + 128 * ai + 64 * wr + 16 * m + fr) * ldo + col0 + 32 * wc + 8 * fq;
#pragma unroll
            for (int bj = 0; bj < 2; ++bj) {
                const f32x4 v0 = acc[ai][bj][m][0], v1 = acc[ai][bj][m][1];
                u32x4 w; w.x = cvt_pk_bf16(v0[0], v0[1]); w.y = cvt_pk_bf16(v0[2], v0[3]); w.z = cvt_pk_bf16(v1[0], v1[1]); w.w = cvt_pk_bf16(v1[2], v1[3]);
                *(u32x4*)(rp + 128 * bj) = w;
            }
        }
}
__device__ __forceinline__ void epi_gate(const f32x4 (&acc)[2][2][4][2], bf16* O, int ldo, long row0, int col0, int wr, int wc, int fr, int fq) {
#pragma unroll
    for (int ai = 0; ai < 2; ++ai)
#pragma unroll
        for (int m = 0; m < 4; ++m) {
            bf16* rp = O + (size_t)(row0 + 128 * ai + 64 * wr + 16 * m + fr) * ldo + col0 + 32 * wc + 8 * fq;
            float h[8];
#pragma unroll
            for (int n = 0; n < 2; ++n)
#pragma unroll
                for (int j = 0; j < 4; ++j) h[4 * n + j] = siluf_(acc[ai][0][m][n][j]) * acc[ai][1][m][n][j];
            u32x4 w; w.x = cvt_pk_bf16(h[0], h[1]); w.y = cvt_pk_bf16(h[2], h[3]); w.z = cvt_pk_bf16(h[4], h[5]); w.w = cvt_pk_bf16(h[6], h[7]);
            *(u32x4*)rp = w;
        }
}

namespace gf {
constexpr int BM = 256, BK = 64, HALF = 128, HTB = HALF * BK * 2, STAGE_BYTES = 8 * HTB;
__device__ __forceinline__ int lds_byte(int r, int c) { const int st = (r >> 4) * 2 + (c >> 5), rr = r & 15, cc = c & 31, ob = rr * 64 + cc * 2; return st * 1024 + (ob ^ (((ob >> 9) & 1) << 5)); }
__device__ __forceinline__ void stage_rc(int b, int& R, int& C) { const int st = b / 1024, sb = b % 1024, swz = sb ^ (((sb >> 9) & 1) << 5); R = (st >> 1) * 16 + swz / 64; C = (st & 1) * 32 + (swz % 64) / 2; }

struct Unit {
    unsigned A;
    unsigned B;
    const int* rowidx;
    int lda, ldb;
    int nt;
    int keep;
    int kind, r0, c0, x0;
};

template <bool GENERAL, class Sched, class Epi>
__device__ __forceinline__ void gemm_fast(LAS unsigned char* lds, const unsigned char* ws, const Sched& S, const Epi& E) {
    const __amdgpu_buffer_rsrc_t rsrc = __builtin_amdgcn_make_buffer_rsrc((void*)ws, 0, 0x7ffffff0, 0x00020000);
    int tid = threadIdx.x; asm volatile("" : "+v"(tid));
    const int wid = __builtin_amdgcn_readfirstlane(tid >> 6), lane = tid & 63, wr = wid >> 2, wc = wid & 3, fr = lane & 15, fq = lane >> 4;
    const unsigned ldsw = (unsigned)wid * 1024u;
    const int aoff = lds_byte(wr * 64 + fr, fq * 8), boff = lds_byte(wc * 32 + fr, fq * 8);
    constexpr unsigned kstep = (unsigned)(BK * 2);
#define GF_SA(b, h) (((b) * 2 + (h)) * HTB)
#define GF_SB(b, h) ((4 + (b) * 2 + (h)) * HTB)
#define GF_STAGE(bufoff, soff, o0, o1) do { \
        __builtin_amdgcn_raw_ptr_buffer_load_lds(rsrc, (LAS void*)(lds + (bufoff) + ldsw), 16, (int)(o0), (int)(soff), 0, 0); \
        __builtin_amdgcn_raw_ptr_buffer_load_lds(rsrc, (LAS void*)(lds + (bufoff) + ldsw + 8192), 16, (int)(o1), (int)(soff), 0, 0); } while (0)
#define GF_LDA(dst, b, h) do { _Pragma("unroll") for (int m = 0; m < 4; ++m) _Pragma("unroll") for (int k = 0; k < 2; ++k) dst[m][k] = *(const LAS bf16x8*)(lds + GF_SA(b, h) + aoff + m * 2048 + k * 1024); } while (0)
#define GF_LDB(dst, b, h) do { _Pragma("unroll") for (int n = 0; n < 2; ++n) _Pragma("unroll") for (int k = 0; k < 2; ++k) dst[n][k] = *(const LAS bf16x8*)(lds + GF_SB(b, h) + boff + n * 2048 + k * 1024); } while (0)
#define GF_MMA(ai, bj, At, Bt) do { __builtin_amdgcn_s_setprio(1); _Pragma("unroll") for (int m = 0; m < 4; ++m) _Pragma("unroll") for (int n = 0; n < 2; ++n) _Pragma("unroll") for (int k = 0; k < 2; ++k) \
        acc[ai][bj][m][n] = __builtin_amdgcn_mfma_f32_16x16x32_bf16(Bt[n][k], At[m][k], acc[ai][bj][m][n], 0, 0, 0); __builtin_amdgcn_s_setprio(0); } while (0)
#define GF_WAIT_V(n) asm volatile("s_waitcnt vmcnt(" #n ")" ::: "memory")
#define GF_WAIT_L(n) asm volatile("s_waitcnt lgkmcnt(" #n ")" ::: "memory")
#define GF_BAR __builtin_amdgcn_s_barrier()
#define GF_SCHED __builtin_amdgcn_sched_barrier(0)
#define GF_SETOFF(u, oA, oB) do { \
        int tz = threadIdx.x; asm volatile("" : "+v"(tz)); \
        int R0, C0, R1, C1; stage_rc(tz * 16, R0, C0); stage_rc(tz * 16 + 8192, R1, C1); \
        const int Rb0 = (R0 & ~31) + perm32(R0 & 31), Rb1 = (R1 & ~31) + perm32(R1 & 31); \
        int g00 = R0, g01 = R1, g10 = HALF + R0, g11 = HALF + R1; \
        if ((u).rowidx) { g00 = (u).rowidx[g00]; g01 = (u).rowidx[g01]; g10 = (u).rowidx[g10]; g11 = (u).rowidx[g11]; } \
        oA[0][0] = (unsigned)g00 * (unsigned)(u).lda + (unsigned)C0 * 2u; oA[0][1] = (unsigned)g01 * (unsigned)(u).lda + (unsigned)C1 * 2u; \
        oA[1][0] = (unsigned)g10 * (unsigned)(u).lda + (unsigned)C0 * 2u; oA[1][1] = (unsigned)g11 * (unsigned)(u).lda + (unsigned)C1 * 2u; \
        oB[0] = (unsigned)Rb0 * (unsigned)(u).ldb + (unsigned)C0 * 2u; oB[1] = (unsigned)Rb1 * (unsigned)(u).ldb + (unsigned)C1 * 2u; } while (0)
    Unit cur, nxt; int ui = 0;
    if (!S.next(0, cur)) return;
    f32x4 acc[2][2][4][2];
#pragma unroll
    for (int a = 0; a < 2; ++a)
#pragma unroll
        for (int b = 0; b < 2; ++b)
#pragma unroll
            for (int m = 0; m < 4; ++m)
#pragma unroll
                for (int n = 0; n < 2; ++n) acc[a][b][m][n] = (f32x4){0.f, 0.f, 0.f, 0.f};
    bf16x8 At[4][2], B0[2][2], B1[2][2];
    unsigned oAc[2][2], oBc[2], oAn[2][2], oBn[2];
    GF_SETOFF(cur, oAc, oBc);
    unsigned cA = cur.A, cB = cur.B, chB = (unsigned)HALF * cur.ldb;
    GF_STAGE(GF_SB(0, 0), cB, oBc[0], oBc[1]); GF_STAGE(GF_SA(0, 0), cA, oAc[0][0], oAc[0][1]); GF_STAGE(GF_SB(0, 1), cB + chB, oBc[0], oBc[1]); GF_STAGE(GF_SA(0, 1), cA, oAc[1][0], oAc[1][1]);
    if (wr == 1) GF_BAR;
    GF_WAIT_V(4); GF_BAR;
    GF_STAGE(GF_SB(1, 0), cB + kstep, oBc[0], oBc[1]); GF_STAGE(GF_SA(1, 0), cA + kstep, oAc[0][0], oAc[0][1]); GF_STAGE(GF_SB(1, 1), cB + chB + kstep, oBc[0], oBc[1]);
    GF_WAIT_V(6); GF_BAR;
    for (;;) {
        const bool has_next = S.next(ui + 1, nxt);
        unsigned nA, nB, nhB;
        if (has_next) { if (GENERAL) GF_SETOFF(nxt, oAn, oBn); nA = nxt.A; nB = nxt.B; nhB = (unsigned)HALF * nxt.ldb; }
        else { if (GENERAL) { oAn[0][0] = oAc[0][0]; oAn[0][1] = oAc[0][1]; oAn[1][0] = oAc[1][0]; oAn[1][1] = oAc[1][1]; oBn[0] = oBc[0]; oBn[1] = oBc[1]; } nA = cA; nB = cB; nhB = chB; }
        const int nt = cur.nt;
        for (int t = 0; t < nt; t += 2) {
            const bool last = (t == nt - 2);
            const unsigned a1 = cA + (unsigned)(t + 1) * kstep;
            const unsigned a2 = last ? nA : cA + (unsigned)(t + 2) * kstep, b2 = last ? nB : cB + (unsigned)(t + 2) * kstep;
            const unsigned a3 = a2 + kstep, b3 = b2 + kstep;
            const unsigned hB2 = last ? nhB : chB;
            const unsigned a2_00 = (GENERAL && last) ? oAn[0][0] : oAc[0][0], a2_01 = (GENERAL && last) ? oAn[0][1] : oAc[0][1], a2_10 = (GENERAL && last) ? oAn[1][0] : oAc[1][0], a2_11 = (GENERAL && last) ? oAn[1][1] : oAc[1][1];
            const unsigned b2_0 = (GENERAL && last) ? oBn[0] : oBc[0], b2_1 = (GENERAL && last) ? oBn[1] : oBc[1];
            GF_LDB(B0, 0, 0); GF_SCHED; GF_LDA(At, 0, 0); GF_STAGE(GF_SA(1, 1), a1, oAc[1][0], oAc[1][1]);
            GF_WAIT_L(8); GF_BAR; GF_WAIT_L(0); GF_MMA(0, 0, At, B0); GF_BAR; GF_SCHED;
            GF_LDB(B1, 0, 1); GF_STAGE(GF_SB(0, 0), b2, b2_0, b2_1);
            GF_BAR; GF_WAIT_L(0); GF_MMA(0, 1, At, B1); GF_BAR;
            GF_LDA(At, 0, 1); GF_STAGE(GF_SA(0, 0), a2, a2_00, a2_01);
            GF_BAR; GF_WAIT_L(0); GF_MMA(1, 0, At, B0); GF_BAR; GF_SCHED;
            GF_STAGE(GF_SB(0, 1), b2 + hB2, b2_0, b2_1);
            GF_WAIT_V(6); GF_BAR; GF_MMA(1, 1, At, B1); GF_BAR;
            GF_LDB(B0, 1, 0); GF_SCHED; GF_LDA(At, 1, 0); GF_STAGE(GF_SA(0, 1), a2, a2_10, a2_11);
            GF_WAIT_L(8); GF_BAR; GF_WAIT_L(0); GF_MMA(0, 0, At, B0); GF_BAR; GF_SCHED;
            GF_LDB(B1, 1, 1); GF_STAGE(GF_SB(1, 0), b3, b2_0, b2_1);
            GF_BAR; GF_WAIT_L(0); GF_MMA(0, 1, At, B1); GF_BAR;
            GF_LDA(At, 1, 1); GF_STAGE(GF_SA(1, 0), a3, a2_00, a2_01);
            GF_BAR; GF_WAIT_L(0); GF_MMA(1, 0, At, B0); GF_BAR; GF_SCHED;
            GF_STAGE(GF_SB(1, 1), b3 + hB2, b2_0, b2_1);
            GF_WAIT_V(6); GF_BAR; GF_MMA(1, 1, At, B1); GF_BAR;
        }
        E(acc, cur, wr, wc, fr, fq);
        if (!has_next) break;
        if (!cur.keep) {
#pragma unroll
            for (int a = 0; a < 2; ++a)
#pragma unroll
                for (int b = 0; b < 2; ++b)
#pragma unroll
                    for (int m = 0; m < 4; ++m)
#pragma unroll
                        for (int n = 0; n < 2; ++n) acc[a][b][m][n] = (f32x4){0.f, 0.f, 0.f, 0.f};
        }
        cur = nxt; cA = nA; cB = nB; chB = nhB; ++ui;
        if (GENERAL) { oAc[0][0] = oAn[0][0]; oAc[0][1] = oAn[0][1]; oAc[1][0] = oAn[1][0]; oAc[1][1] = oAn[1][1]; oBc[0] = oBn[0]; oBc[1] = oBn[1]; }
    }
    GF_WAIT_V(0);
    if (wr == 0) GF_BAR;
    GF_BAR;
#undef GF_SA
#undef GF_SB
#undef GF_STAGE
#undef GF_LDA
#undef GF_LDB
#undef GF_MMA
#undef GF_WAIT_V
#undef GF_WAIT_L
#undef GF_BAR
#undef GF_SCHED
#undef GF_SETOFF
}
}

__device__ __forceinline__ int uload(const int* p) { return __builtin_amdgcn_readfirstlane(__hip_atomic_load(p, __ATOMIC_RELAXED, __HIP_MEMORY_SCOPE_AGENT)); }
__device__ __forceinline__ int vcu_of(int bid, int nb) { return (nb % 8 == 0) ? (bid % 8) * (nb / 8) + bid / 8 : bid; }

struct SchedPlain {
    unsigned A, B; int lda, ldb, nt, nN, nU, G, c; long r0base;
    __device__ __forceinline__ bool next(int i, gf::Unit& u) const {
        const int L = i * G + c; if (L >= nU) return false;
        const int pm = L / nN, pn = L % nN;
        u.A = A + (unsigned)pm * 256u * lda; u.B = B + (unsigned)pn * 256u * ldb; u.rowidx = nullptr; u.lda = lda; u.ldb = ldb; u.nt = nt; u.keep = 0;
        u.kind = 0; u.r0 = (int)(r0base + pm * 256); u.c0 = pn * 256; u.x0 = 0; return true;
    }
};
struct EpiProj { bf16* O; __device__ __forceinline__ void operator()(f32x4 (&acc)[2][2][4][2], const gf::Unit& u, int wr, int wc, int fr, int fq) const { epi_bf16(acc, O, INW, u.r0, u.c0, wr, wc, fr, fq); } };
struct SchedProjPP {
    int G, c;
    __device__ __forceinline__ bool next(int i, gf::Unit& u) const {
        constexpr int nN = INW / 256, nProj = (T / 256) * nN, nPP = (T / 256) * 4;
        const int R = nProj / G, rem = nProj % G;
        u.rowidx = nullptr; u.keep = 0; u.x0 = 0;
        const int L = i * G + c;
        if (i < R || (i == R && c < rem)) { const int pm = L / nN, pn = L % nN;
            u.A = (unsigned)WS_XB + (unsigned)pm * 256u * (D * 2); u.B = (unsigned)WS_WINT + (unsigned)pn * 256u * (D * 2); u.lda = D * 2; u.ldb = D * 2; u.nt = D / 64; u.kind = 0; u.r0 = pm * 256; u.c0 = pn * 256; return true; }
        const int nw = G - rem, per = (nPP + nw - 1) / nw, j = i - R;
        if (c < rem || j >= per) return false;
        const int idx = (c - rem) * per + j; if (idx >= nPP) return false;
        const int pm = idx >> 2, pn = idx & 3;
        u.A = (unsigned)WS_PB + (unsigned)pm * 256u * (PLE * 2); u.B = (unsigned)WS_WPT + (unsigned)pn * 256u * (PLE * 2); u.lda = PLE * 2; u.ldb = PLE * 2; u.nt = PLE / 64; u.kind = 1; u.r0 = pm * 256; u.c0 = pn * 256; return true;
    }
};
struct EpiProjPP { bf16* proj; bf16* pp;
    __device__ __forceinline__ void operator()(f32x4 (&acc)[2][2][4][2], const gf::Unit& u, int wr, int wc, int fr, int fq) const {
        if (u.kind == 0) epi_bf16(acc, proj, INW, u.r0, u.c0, wr, wc, fr, fq); else epi_bf16(acc, pp, D, u.r0, u.c0, wr, wc, fr, fq);
    }
};
__device__ void phase_proj(const Args& a, LAS unsigned char* lds, int bid, int nb) {
    SchedProjPP S{nb, vcu_of(bid, nb)};
    EpiProjPP E{(bf16*)(a.ws + WS_BIG), (bf16*)(a.ws + WS_PP)};
    gf::gemm_fast<true>(lds, a.ws, S, E);
}

struct EpiWout { const float* x; float* y;
    __device__ __forceinline__ void operator()(f32x4 (&acc)[2][2][4][2], const gf::Unit& u, int wr, int wc, int fr, int fq) const {
#pragma unroll
        for (int ai = 0; ai < 2; ++ai)
#pragma unroll
            for (int m = 0; m < 4; ++m) {
                const size_t off = (size_t)(u.r0 + 128 * ai + 64 * wr + 16 * m + fr) * D + u.c0 + 32 * wc + 8 * fq;
#pragma unroll
                for (int bj = 0; bj < 2; ++bj)
#pragma unroll
                    for (int n = 0; n < 2; ++n) {
                        const f32x4 xv = *(const f32x4*)(x + off + 128 * bj + 4 * n);
                        *(f32x4*)(y + off + 128 * bj + 4 * n) = acc[ai][bj][m][n] + ALPHA * xv;
                    }
                asm volatile("" ::: "memory");
            }
    }
};
__device__ void phase_wout(const Args& a, LAS unsigned char* lds, int bid, int nb) {
    SchedPlain S{(unsigned)WS_MIXO, (unsigned)WS_WOUTT, D * 2, D * 2, D / 64, D / 256, (T / 256) * (D / 256), nb, vcu_of(bid, nb), 0};
    EpiWout E{a.in[I_X], a.out};
    gf::gemm_fast<false>(lds, a.ws, S, E);
}

constexpr int QS = 72;
constexpr int TS = 136;
constexpr int TS2 = 264;
constexpr int L_QS = 0;
constexpr int L_KS = L_QS + 128 * QS * 2;
constexpr int L_KTW = L_KS + 256 * QS * 2;
constexpr int L_VT = L_KTW + 64 * TS * 2;
constexpr int L_ST = L_VT + 64 * TS2 * 2;
constexpr int L_MIX_END = L_ST + 64 * QS * 2;
static_assert(L_MIX_END <= 128 * 1024, "mixer LDS");

__device__ __forceinline__ void stage_ret(const Args& a, LAS unsigned char* lds, int b, int h, int n, bool want_q, float l2g) {
    const int tid = hidden_tid();
    const bf16* proj = (const bf16*)(a.ws + WS_BIG);
    const float* tab = (const float*)(a.ws + WS_TAB);
    const float* cosr = tab, *sinr = tab + SEQ * 32;
    LAS bf16* Qs = (LAS bf16*)(lds + L_QS); LAS bf16* Ks = (LAS bf16*)(lds + L_KS); LAS bf16* Ktw = (LAS bf16*)(lds + L_KTW); LAS bf16* Vt = (LAS bf16*)(lds + L_VT);
    const int row = tid >> 2, i0 = (tid & 3) * 8;
    const int pos = n * CH + row;
    const size_t t = (size_t)b * SEQ + pos;
    const bf16* prow = proj + t * INW;
    f32x4 c0 = *(const f32x4*)(cosr + pos * 32 + i0), c1 = *(const f32x4*)(cosr + pos * 32 + i0 + 4);
    f32x4 s0 = *(const f32x4*)(sinr + pos * 32 + i0), s1 = *(const f32x4*)(sinr + pos * 32 + i0 + 4);
    float cs[8] = {c0[0], c0[1], c0[2], c0[3], c1[0], c1[1], c1[2], c1[3]}, sn[8] = {s0[0], s0[1], s0[2], s0[3], s1[0], s1[1], s1[2], s1[3]};
    if (want_q) {
        const bf16x8 x1 = *(const bf16x8*)(prow + C_RQ + h * 64 + i0), x2 = *(const bf16x8*)(prow + C_RQ + h * 64 + 32 + i0);
        float o1[8], o2[8];
#pragma unroll
        for (int j = 0; j < 8; ++j) { const float a1 = bf2f((unsigned short)x1[j]), a2 = bf2f((unsigned short)x2[j]); o1[j] = a1 * cs[j] - a2 * sn[j]; o2[j] = a2 * cs[j] + a1 * sn[j]; }
        u32x4 w1, w2;
        w1.x = cvt_pk_bf16(o1[0], o1[1]); w1.y = cvt_pk_bf16(o1[2], o1[3]); w1.z = cvt_pk_bf16(o1[4], o1[5]); w1.w = cvt_pk_bf16(o1[6], o1[7]);
        w2.x = cvt_pk_bf16(o2[0], o2[1]); w2.y = cvt_pk_bf16(o2[2], o2[3]); w2.z = cvt_pk_bf16(o2[4], o2[5]); w2.w = cvt_pk_bf16(o2[6], o2[7]);
        *(LAS u32x4*)(Qs + row * QS + i0) = w1; *(LAS u32x4*)(Qs + row * QS + 32 + i0) = w2;
    }
    {
        const bf16x8 x1 = *(const bf16x8*)(prow + C_RK + h * 64 + i0), x2 = *(const bf16x8*)(prow + C_RK + h * 64 + 32 + i0);
        const float kw = exp2f((float)(CH - 1 - row) * l2g);
        float o1[8], o2[8];
#pragma unroll
        for (int j = 0; j < 8; ++j) { const float a1 = bf2f((unsigned short)x1[j]), a2 = bf2f((unsigned short)x2[j]); o1[j] = (a1 * cs[j] - a2 * sn[j]) * 0.125f; o2[j] = (a2 * cs[j] + a1 * sn[j]) * 0.125f; }
        if (want_q) {
            u32x4 w1, w2;
            w1.x = cvt_pk_bf16(o1[0], o1[1]); w1.y = cvt_pk_bf16(o1[2], o1[3]); w1.z = cvt_pk_bf16(o1[4], o1[5]); w1.w = cvt_pk_bf16(o1[6], o1[7]);
            w2.x = cvt_pk_bf16(o2[0], o2[1]); w2.y = cvt_pk_bf16(o2[2], o2[3]); w2.z = cvt_pk_bf16(o2[4], o2[5]); w2.w = cvt_pk_bf16(o2[6], o2[7]);
            *(LAS u32x4*)(Ks + row * QS + i0) = w1; *(LAS u32x4*)(Ks + row * QS + 32 + i0) = w2;
        }
#pragma unroll
        for (int j = 0; j < 8; ++j) { Ktw[(i0 + j) * TS + row] = f2bf(o1[j] * kw); Ktw[(32 + i0 + j) * TS + row] = f2bf(o2[j] * kw); }
    }
    {
        const bf16x8 v1 = *(const bf16x8*)(prow + C_RV + h * 64 + i0), v2 = *(const bf16x8*)(prow + C_RV + h * 64 + 32 + i0);
#pragma unroll
        for (int j = 0; j < 8; ++j) { Vt[(i0 + j) * TS2 + row] = (bf16)v1[j]; Vt[(32 + i0 + j) * TS2 + row] = (bf16)v2[j]; }
    }
}
__device__ __forceinline__ void ret_kv(LAS unsigned char* lds, int wid, int fr, int fq, f32x4 (&kv)[2]) {
    LAS bf16* Ktw = (LAS bf16*)(lds + L_KTW); LAS bf16* Vt = (LAS bf16*)(lds + L_VT);
#pragma unroll
    for (int i = 0; i < 2; ++i) {
        const int tl = 2 * wid + i, dt = tl >> 2, et = tl & 3;
        f32x4 c = {0.f, 0.f, 0.f, 0.f};
#pragma unroll
        for (int ks = 0; ks < 4; ++ks) {
            const bf16x8 kf = *(const LAS bf16x8*)(Ktw + (16 * dt + fr) * TS + 32 * ks + 8 * fq);
            const bf16x8 vf = *(const LAS bf16x8*)(Vt + (16 * et + fr) * TS2 + 32 * ks + 8 * fq);
            c = __builtin_amdgcn_mfma_f32_16x16x32_bf16(kf, vf, c, 0, 0, 0);
        }
        kv[i] = c;
    }
}
__device__ __forceinline__ float head_l2g(int h) { return log2f(1.0f - exp2f(-5.0f - (float)h)); }

__device__ void phase_segtot(const Args& a, LAS unsigned char* lds, int bid, int nb) {
    WAVE_IDS();
    float* segt = (float*)(a.ws + WS_SEGT);
    for (int it = bid; it < BATCH * RH * NSEG; it += nb) {
        const int seg = it % NSEG, h = (it / NSEG) % RH, b = it / (NSEG * RH);
        const float l2g = head_l2g(h), cd = exp2f(128.0f * l2g);
        f32x4 S[2] = {{0.f, 0.f, 0.f, 0.f}, {0.f, 0.f, 0.f, 0.f}};
        for (int c = 0; c < SEGC; ++c) {
            __syncthreads();
            stage_ret(a, lds, b, h, seg * SEGC + c, false, l2g);
            __syncthreads();
            f32x4 kv[2]; ret_kv(lds, wid, fr, fq, kv);
            S[0] = S[0] * cd + kv[0]; S[1] = S[1] * cd + kv[1];
        }
        float* dst = segt + (size_t)((b * RH + h) * NSEG + seg) * 4096;
#pragma unroll
        for (int i = 0; i < 2; ++i) { const int tl = 2 * wid + i, dt = tl >> 2, et = tl & 3;
#pragma unroll
            for (int j = 0; j < 4; ++j) dst[(16 * dt + 4 * fq + j) * 64 + 16 * et + fr] = S[i][j]; }
    }
}

__device__ void phase_retention(const Args& a, LAS unsigned char* lds, int bid, int nb) {
    WAVE_IDS();
    const float* segt = (const float*)(a.ws + WS_SEGT);
    const bf16* proj = (const bf16*)(a.ws + WS_BIG);
    bf16* mixo = (bf16*)(a.ws + WS_MIXO);
    const float* gain = a.in[I_GN];
    LAS bf16* Qs = (LAS bf16*)(lds + L_QS); LAS bf16* Ks = (LAS bf16*)(lds + L_KS); LAS bf16* Vt = (LAS bf16*)(lds + L_VT); LAS bf16* St = (LAS bf16*)(lds + L_ST);
    for (int it = bid; it < BATCH * RH * NSEG; it += nb) {
        const int seg = it % NSEG, h = (it / NSEG) % RH, b = it / (NSEG * RH);
        const float l2g = head_l2g(h), cd = exp2f(128.0f * l2g);
        f32x4 S[2] = {{0.f, 0.f, 0.f, 0.f}, {0.f, 0.f, 0.f, 0.f}};
        for (int sp = 0; sp < seg; ++sp) {
            const float wgt = exp2f(128.0f * l2g * (float)(SEGC * (seg - 1 - sp)));
            const float* src = segt + (size_t)((b * RH + h) * NSEG + sp) * 4096;
#pragma unroll
            for (int i = 0; i < 2; ++i) { const int tl = 2 * wid + i, dt = tl >> 2, et = tl & 3;
#pragma unroll
                for (int j = 0; j < 4; ++j) S[i][j] += wgt * src[(16 * dt + 4 * fq + j) * 64 + 16 * et + fr]; }
        }
        for (int c = 0; c < SEGC; ++c) {
            const int n = seg * SEGC + c;
            __syncthreads();
            stage_ret(a, lds, b, h, n, true, l2g);
#pragma unroll
            for (int i = 0; i < 2; ++i) { const int tl = 2 * wid + i, dt = tl >> 2, et = tl & 3;
                u32x2 w; w.x = cvt_pk_bf16(S[i][0], S[i][1]); w.y = cvt_pk_bf16(S[i][2], S[i][3]);
                *(LAS u32x2*)(St + (16 * et + fr) * QS + 16 * dt + 4 * fq) = w; }
            __syncthreads();
            bf16x8 qf[2];
#pragma unroll
            for (int ks = 0; ks < 2; ++ks) qf[ks] = *(const LAS bf16x8*)(Qs + (16 * wid + fr) * QS + 32 * ks + 8 * fq);
            f32x4 sc[8];
#pragma unroll
            for (int jt = 0; jt < 8; ++jt) {
                sc[jt] = (f32x4){0.f, 0.f, 0.f, 0.f};
                if (jt <= wid) {
#pragma unroll
                    for (int ks = 0; ks < 2; ++ks) {
                        const bf16x8 kf = *(const LAS bf16x8*)(Ks + (16 * jt + fr) * QS + 32 * ks + 8 * fq);
                        sc[jt] = __builtin_amdgcn_mfma_f32_16x16x32_bf16(kf, qf[ks], sc[jt], 0, 0, 0);
                    }
                    const int i = 16 * wid + fr;
#pragma unroll
                    for (int r = 0; r < 4; ++r) { const int j = 16 * jt + 4 * fq + r; const float dcy = exp2f((float)(i - j) * l2g); sc[jt][r] = (i >= j) ? sc[jt][r] * dcy : 0.f; }
                    asm volatile("" : "+v"(sc[jt]) :: "memory");
                }
            }
            f32x4 o[4], oi[4];
#pragma unroll
            for (int et = 0; et < 4; ++et) { o[et] = (f32x4){0.f, 0.f, 0.f, 0.f}; oi[et] = (f32x4){0.f, 0.f, 0.f, 0.f}; }
#pragma unroll
            for (int k2 = 0; k2 < 4; ++k2) {
                if (2 * k2 <= wid) {
                    bf16x8 pf; u32x4 pw;
                    pw.x = cvt_pk_bf16(sc[2 * k2][0], sc[2 * k2][1]); pw.y = cvt_pk_bf16(sc[2 * k2][2], sc[2 * k2][3]);
                    pw.z = cvt_pk_bf16(sc[2 * k2 + 1][0], sc[2 * k2 + 1][1]); pw.w = cvt_pk_bf16(sc[2 * k2 + 1][2], sc[2 * k2 + 1][3]);
                    pf = __builtin_bit_cast(bf16x8, pw);
#pragma unroll
                    for (int et = 0; et < 4; ++et) {
                        const u32x2 va = *(const LAS u32x2*)(Vt + (16 * et + fr) * TS2 + 32 * k2 + 4 * fq);
                        const u32x2 vb = *(const LAS u32x2*)(Vt + (16 * et + fr) * TS2 + 32 * k2 + 16 + 4 * fq);
                        u32x4 vw; vw.x = va.x; vw.y = va.y; vw.z = vb.x; vw.w = vb.y;
                        o[et] = __builtin_amdgcn_mfma_f32_16x16x32_bf16(__builtin_bit_cast(bf16x8, vw), pf, o[et], 0, 0, 0);
                    }
                }
            }
#pragma unroll
            for (int et = 0; et < 4; ++et)
#pragma unroll
                for (int ks = 0; ks < 2; ++ks) {
                    const bf16x8 sf = *(const LAS bf16x8*)(St + (16 * et + fr) * QS + 32 * ks + 8 * fq);
                    oi[et] = __builtin_amdgcn_mfma_f32_16x16x32_bf16(sf, qf[ks], oi[et], 0, 0, 0);
                }
            {
                const int i = 16 * wid + fr;
                const float qw = exp2f((float)(i + 1) * l2g);
                float sum = 0.f;
#pragma unroll
                for (int et = 0; et < 4; ++et)
#pragma unroll
                    for (int r = 0; r < 4; ++r) { o[et][r] += qw * oi[et][r]; sum += o[et][r]; }
                sum += __shfl_xor(sum, 16); sum += __shfl_xor(sum, 32);
                const float mean = sum * (1.0f / 64.0f);
                float q = 0.f;
#pragma unroll
                for (int et = 0; et < 4; ++et)
#pragma unroll
                    for (int r = 0; r < 4; ++r) { const float d = o[et][r] - mean; q += d * d; }
                q += __shfl_xor(q, 16); q += __shfl_xor(q, 32);
                const float rstd = rsqrtf(q * (1.0f / 64.0f) + GN_EPS);
                const size_t t = (size_t)b * SEQ + n * CH + i;
#pragma unroll
                for (int et = 0; et < 4; ++et) {
                    const int e0 = 16 * et + 4 * fq;
                    const u32x2 gw = *(const u32x2*)(proj + t * INW + C_RG + h * 64 + e0);
                    const f32x4 gn = *(const f32x4*)(gain + h * 64 + e0);
                    const float g0 = bf2f(gw.x & 0xffffu), g1 = bf2f(gw.x >> 16), g2 = bf2f(gw.y & 0xffffu), g3 = bf2f(gw.y >> 16);
                    const float y0 = (o[et][0] - mean) * rstd * gn[0] * siluf_(g0), y1 = (o[et][1] - mean) * rstd * gn[1] * siluf_(g1);
                    const float y2 = (o[et][2] - mean) * rstd * gn[2] * siluf_(g2), y3 = (o[et][3] - mean) * rstd * gn[3] * siluf_(g3);
                    u32x2 w; w.x = cvt_pk_bf16(y0, y1); w.y = cvt_pk_bf16(y2, y3);
                    *(u32x2*)(mixo + t * D + h * 64 + e0) = w;
                }
            }
            f32x4 kv[2]; ret_kv(lds, wid, fr, fq, kv);
            S[0] = S[0] * cd + kv[0]; S[1] = S[1] * cd + kv[1];
        }
    }
}

__device__ void phase_swa(const Args& a, LAS unsigned char* lds, int bid, int nb) {
    WAVE_IDS();
    const bf16* proj = (const bf16*)(a.ws + WS_BIG);
    bf16* mixo = (bf16*)(a.ws + WS_MIXO);
    const float* tab = (const float*)(a.ws + WS_TAB);
    const float* coss = tab + SEQ * 64, *sins = tab + SEQ * 72;
    const float* ascale = a.in[I_ASC]; const float* sinks = a.in[I_SINK];
    LAS bf16* Qs = (LAS bf16*)(lds + L_QS); LAS bf16* Ks = (LAS bf16*)(lds + L_KS); LAS bf16* Vt = (LAS bf16*)(lds + L_VT);
    for (int it = bid; it < BATCH * NCH * QH; it += nb) {
        const int qh = it % QH, n = (it / QH) % NCH, b = it / (QH * NCH), kvh = qh >> 2;
        __syncthreads();
        {
            const int row = tid >> 2, cg = tid & 3, pos = n * CH + row;
            const bf16* src = proj + ((size_t)b * SEQ + pos) * INW + C_AQ + qh * 64 + cg * 16;
            bf16x8 x1 = *(const bf16x8*)src, x2 = *(const bf16x8*)(src + 8);
            if (cg == 0) {
                const f32x4 c0 = *(const f32x4*)(coss + pos * 8), c1 = *(const f32x4*)(coss + pos * 8 + 4), s0 = *(const f32x4*)(sins + pos * 8), s1 = *(const f32x4*)(sins + pos * 8 + 4);
                const float cs[8] = {c0[0], c0[1], c0[2], c0[3], c1[0], c1[1], c1[2], c1[3]}, sn[8] = {s0[0], s0[1], s0[2], s0[3], s1[0], s1[1], s1[2], s1[3]};
                float o1[8], o2[8];
#pragma unroll
                for (int j = 0; j < 8; ++j) { const float a1 = bf2f((unsigned short)x1[j]), a2 = bf2f((unsigned short)x2[j]); o1[j] = a1 * cs[j] - a2 * sn[j]; o2[j] = a2 * cs[j] + a1 * sn[j]; }
                u32x4 w1, w2;
                w1.x = cvt_pk_bf16(o1[0], o1[1]); w1.y = cvt_pk_bf16(o1[2], o1[3]); w1.z = cvt_pk_bf16(o1[4], o1[5]); w1.w = cvt_pk_bf16(o1[6], o1[7]);
                w2.x = cvt_pk_bf16(o2[0], o2[1]); w2.y = cvt_pk_bf16(o2[2], o2[3]); w2.z = cvt_pk_bf16(o2[4], o2[5]); w2.w = cvt_pk_bf16(o2[6], o2[7]);
                x1 = __builtin_bit_cast(bf16x8, w1); x2 = __builtin_bit_cast(bf16x8, w2);
            }
            *(LAS bf16x8*)(Qs + row * QS + cg * 16) = x1; *(LAS bf16x8*)(Qs + row * QS + cg * 16 + 8) = x2;
        }
#pragma unroll
        for (int rep = 0; rep < 2; ++rep) {
            const int q = tid + rep * NTHREADS, kj = q >> 2, cg = q & 3, pos = n * CH - CH + kj;
            bf16x8 k1 = {0, 0, 0, 0, 0, 0, 0, 0}, k2 = k1, v1 = k1, v2 = k1;
            if (pos >= 0) {
                const bf16* srow = proj + ((size_t)b * SEQ + pos) * INW;
                k1 = *(const bf16x8*)(srow + C_AK + kvh * 64 + cg * 16); k2 = *(const bf16x8*)(srow + C_AK + kvh * 64 + cg * 16 + 8);
                v1 = *(const bf16x8*)(srow + C_AV + kvh * 64 + cg * 16); v2 = *(const bf16x8*)(srow + C_AV + kvh * 64 + cg * 16 + 8);
                if (cg == 0) {
                    const f32x4 c0 = *(const f32x4*)(coss + pos * 8), c1 = *(const f32x4*)(coss + pos * 8 + 4), s0 = *(const f32x4*)(sins + pos * 8), s1 = *(const f32x4*)(sins + pos * 8 + 4);
                    const float cs[8] = {c0[0], c0[1], c0[2], c0[3], c1[0], c1[1], c1[2], c1[3]}, sn[8] = {s0[0], s0[1], s0[2], s0[3], s1[0], s1[1], s1[2], s1[3]};
                    float o1[8], o2[8];
#pragma unroll
                    for (int j = 0; j < 8; ++j) { const float a1 = bf2f((unsigned short)k1[j]), a2 = bf2f((unsigned short)k2[j]); o1[j] = a1 * cs[j] - a2 * sn[j]; o2[j] = a2 * cs[j] + a1 * sn[j]; }
                    u32x4 w1, w2;
                    w1.x = cvt_pk_bf16(o1[0], o1[1]); w1.y = cvt_pk_bf16(o1[2], o1[3]); w1.z = cvt_pk_bf16(o1[4], o1[5]); w1.w = cvt_pk_bf16(o1[6], o1[7]);
                    w2.x = cvt_pk_bf16(o2[0], o2[1]); w2.y = cvt_pk_bf16(o2[2], o2[3]); w2.z = cvt_pk_bf16(o2[4], o2[5]); w2.w = cvt_pk_bf16(o2[6], o2[7]);
                    k1 = __builtin_bit_cast(bf16x8, w1); k2 = __builtin_bit_cast(bf16x8, w2);
                }
            }
            *(LAS bf16x8*)(Ks + kj * QS + cg * 16) = k1; *(LAS bf16x8*)(Ks + kj * QS + cg * 16 + 8) = k2;
#pragma unroll
            for (int j = 0; j < 8; ++j) { Vt[(cg * 16 + j) * TS2 + kj] = (bf16)v1[j]; Vt[(cg * 16 + 8 + j) * TS2 + kj] = (bf16)v2[j]; }
        }
        __syncthreads();
        const int jt0 = wid & ~1;
        bf16x8 qf[2];
#pragma unroll
        for (int ks = 0; ks < 2; ++ks) qf[ks] = *(const LAS bf16x8*)(Qs + (16 * wid + fr) * QS + 32 * ks + 8 * fq);
        f32x4 sc[10];
        const int i = 16 * wid + fr;
        float mx = sinks[qh];
#pragma unroll
        for (int tt = 0; tt < 10; ++tt) {
            const int jt = jt0 + tt;
            f32x4 c = {0.f, 0.f, 0.f, 0.f};
#pragma unroll
            for (int ks = 0; ks < 2; ++ks) {
                const bf16x8 kf = *(const LAS bf16x8*)(Ks + (16 * jt + fr) * QS + 32 * ks + 8 * fq);
                c = __builtin_amdgcn_mfma_f32_16x16x32_bf16(kf, qf[ks], c, 0, 0, 0);
            }
#pragma unroll
            for (int r = 0; r < 4; ++r) {
                const int kj = 16 * jt + 4 * fq + r;
                const bool valid = (kj > i) && (kj <= i + CH) && (n * CH - CH + kj >= 0);
                c[r] = valid ? c[r] * 0.125f : -1e30f;
                mx = fmaxf(mx, c[r]);
            }
            sc[tt] = c;
        }
        mx = fmaxf(mx, __shfl_xor(mx, 16)); mx = fmaxf(mx, __shfl_xor(mx, 32));
        float den = 0.f;
#pragma unroll
        for (int tt = 0; tt < 10; ++tt)
#pragma unroll
            for (int r = 0; r < 4; ++r) { const float p = (sc[tt][r] > -1e29f) ? __expf(sc[tt][r] - mx) : 0.f; sc[tt][r] = p; den += p; }
        den += __shfl_xor(den, 16); den += __shfl_xor(den, 32);
        den += __expf(sinks[qh] - mx);
        const float inv = 1.0f / den;
        f32x4 o[4];
#pragma unroll
        for (int et = 0; et < 4; ++et) o[et] = (f32x4){0.f, 0.f, 0.f, 0.f};
#pragma unroll
        for (int k2 = 0; k2 < 5; ++k2) {
            u32x4 pw;
            pw.x = cvt_pk_bf16(sc[2 * k2][0] * inv, sc[2 * k2][1] * inv); pw.y = cvt_pk_bf16(sc[2 * k2][2] * inv, sc[2 * k2][3] * inv);
            pw.z = cvt_pk_bf16(sc[2 * k2 + 1][0] * inv, sc[2 * k2 + 1][1] * inv); pw.w = cvt_pk_bf16(sc[2 * k2 + 1][2] * inv, sc[2 * k2 + 1][3] * inv);
            const bf16x8 pf = __builtin_bit_cast(bf16x8, pw);
            const int kb = 16 * (jt0 + 2 * k2);
#pragma unroll
            for (int et = 0; et < 4; ++et) {
                const u32x2 va = *(const LAS u32x2*)(Vt + (16 * et + fr) * TS2 + kb + 4 * fq);
                const u32x2 vb = *(const LAS u32x2*)(Vt + (16 * et + fr) * TS2 + kb + 16 + 4 * fq);
                u32x4 vw; vw.x = va.x; vw.y = va.y; vw.z = vb.x; vw.w = vb.y;
                o[et] = __builtin_amdgcn_mfma_f32_16x16x32_bf16(__builtin_bit_cast(bf16x8, vw), pf, o[et], 0, 0, 0);
            }
        }
        const size_t t = (size_t)b * SEQ + n * CH + i;
#pragma unroll
        for (int et = 0; et < 4; ++et) {
            const int e0 = 16 * et + 4 * fq;
            const f32x4 as = *(const f32x4*)(ascale + qh * 64 + e0);
            u32x2 w; w.x = cvt_pk_bf16(o[et][0] * as[0], o[et][1] * as[1]); w.y = cvt_pk_bf16(o[et][2] * as[2], o[et][3] * as[3]);
            *(u32x2*)(mixo + t * D + 512 + qh * 64 + e0) = w;
        }
    }
}

template <int MODE>
__device__ void phase_ln(const float* src, const float* g, const float* bta, bf16* dstb, float* dstf, int bid, int nb) {
    const int tid = hidden_tid(), wid = tid >> 6, lane = tid & 63;
    f32x4 gv[4], bv[4];
#pragma unroll
    for (int i = 0; i < 4; ++i) { gv[i] = *(const f32x4*)(g + 256 * i + lane * 4); bv[i] = *(const f32x4*)(bta + 256 * i + lane * 4); }
    for (int row = bid * 8 + wid; row < T; row += nb * 8) {
        const float* r = src + (size_t)row * D;
        f32x4 v[4]; float s = 0.f;
#pragma unroll
        for (int i = 0; i < 4; ++i) { v[i] = *(const f32x4*)(r + 256 * i + lane * 4); s += (v[i][0] + v[i][1]) + (v[i][2] + v[i][3]); }
#pragma unroll
        for (int o = 32; o >= 1; o >>= 1) s += __shfl_xor(s, o);
        const float mean = s * (1.0f / D);
        float q = 0.f;
#pragma unroll
        for (int i = 0; i < 4; ++i) { const f32x4 d = v[i] - mean; q += (d[0] * d[0] + d[1] * d[1]) + (d[2] * d[2] + d[3] * d[3]); }
#pragma unroll
        for (int o = 32; o >= 1; o >>= 1) q += __shfl_xor(q, o);
        const float rstd = rsqrtf(q * (1.0f / D) + LN_EPS);
#pragma unroll
        for (int i = 0; i < 4; ++i) {
            const f32x4 y = (v[i] - mean) * rstd * gv[i] + bv[i];
            if (MODE == 0) { u32x2 w; w.x = cvt_pk_bf16(y[0], y[1]); w.y = cvt_pk_bf16(y[2], y[3]); *(u32x2*)(dstb + (size_t)row * D + 256 * i + lane * 4) = w; }
            else *(f32x4*)(dstf + (size_t)row * D + 256 * i + lane * 4) = y;
        }
    }
}

__device__ void phase_router(const Args& a, LAS unsigned char* lds, int bid, int nb) {
    WAVE_IDS();
    const bf16* x1b = (const bf16*)(a.ws + WS_XB); const bf16* wrt = (const bf16*)(a.ws + WS_WRT);
    unsigned char* ro = a.ws + WS_ROUT;
    int* ridx = (int*)(ro + RO_RIDX); float* rw = (float*)(ro + RO_RW); int* cnt = (int*)(ro + RO_CNT);
    const float* rbias = a.in[I_RB];
    LAS float* lg = (LAS float*)lds;
    LAS float* bi = lg + 128 * 65;
    LAS int* hist = (LAS int*)(bi + 128 * 65);
    for (int u = bid; u < T / 128; u += nb) {
        __syncthreads();
        if (tid < 64) hist[tid] = 0;
        {
            f32x4 c[4];
#pragma unroll
            for (int et = 0; et < 4; ++et) c[et] = (f32x4){0.f, 0.f, 0.f, 0.f};
            const bf16* xa = x1b + (size_t)(u * 128 + 16 * wid + fr) * D + 8 * fq;
#pragma unroll 4
            for (int k0 = 0; k0 < D; k0 += 32) {
                const bf16x8 xf = *(const bf16x8*)(xa + k0);
#pragma unroll
                for (int et = 0; et < 4; ++et) {
                    const bf16x8 wf = *(const bf16x8*)(wrt + (size_t)(16 * et + fr) * D + k0 + 8 * fq);
                    c[et] = __builtin_amdgcn_mfma_f32_16x16x32_bf16(wf, xf, c[et], 0, 0, 0);
                }
            }
#pragma unroll
            for (int et = 0; et < 4; ++et)
#pragma unroll
                for (int r = 0; r < 4; ++r) {
                    const int e = 16 * et + 4 * fq + r; const float s = sigmoidf_(c[et][r]);
                    lg[(16 * wid + fr) * 65 + e] = s; bi[(16 * wid + fr) * 65 + e] = s + rbias[e];
                }
        }
        __syncthreads();
        if (tid < 128) {
            const LAS float* mb = bi + tid * 65; const LAS float* ms = lg + tid * 65;
            float gs[8];
#pragma unroll
            for (int g = 0; g < 8; ++g) {
                float m1 = -3e38f, m2 = -3e38f;
#pragma unroll
                for (int j = 0; j < 8; ++j) { const float v = mb[g * 8 + j]; if (v > m1) { m2 = m1; m1 = v; } else if (v > m2) m2 = v; }
                gs[g] = m1 + m2;
            }
            unsigned gmask = 0;
#pragma unroll
            for (int rnd = 0; rnd < 4; ++rnd) {
                float best = -3e38f; int bg = 0;
#pragma unroll
                for (int g = 0; g < 8; ++g) { const bool ok = !((gmask >> g) & 1u) && gs[g] > best; best = ok ? gs[g] : best; bg = ok ? g : bg; }
                gmask |= 1u << bg;
            }
            unsigned long long taken = 0ull;
            int sel[8]; float wsel[8]; float wsum = 0.f;
#pragma unroll
            for (int rnd = 0; rnd < 8; ++rnd) {
                float best = -3e38f; int be = 0;
#pragma unroll 1
                for (int e = 0; e < 64; ++e) {
                    const bool ok = ((gmask >> (e >> 3)) & 1u) && !((taken >> e) & 1ull);
                    const float v = mb[e];
                    if (ok && v > best) { best = v; be = e; }
                }
                taken |= 1ull << be;
                sel[rnd] = be; wsel[rnd] = ms[be]; wsum += wsel[rnd];
            }
            const float sc = ROUTED_SCALE / wsum;
            const size_t t = (size_t)u * 128 + tid;
#pragma unroll
            for (int k = 0; k < 8; ++k) { ridx[t * 8 + k] = sel[k]; rw[t * 8 + k] = wsel[k] * sc; __hip_atomic_fetch_add(&hist[sel[k]], 1, __ATOMIC_RELAXED, __HIP_MEMORY_SCOPE_WORKGROUP); }
        }
        __syncthreads();
        if (tid < 64) cnt[u * 64 + tid] = hist[tid];
    }
}

__device__ void phase_sort(const Args& a, LAS unsigned char* lds, int bid, int nb) {
    const int tid = hidden_tid();
    unsigned char* ro = a.ws + WS_ROUT;
    const int* ridx = (const int*)(ro + RO_RIDX); const float* rw = (const float*)(ro + RO_RW); const int* cnt = (const int*)(ro + RO_CNT);
    int* stok = (int*)(ro + RO_STOK); int* dest = (int*)(ro + RO_DEST); float* rsc = (float*)(ro + RO_RSC); int* tile = (int*)(ro + RO_TILE);
    LAS int* tot = (LAS int*)lds; LAS int* pos0 = tot + 64; LAS int* lcnt = pos0 + 64; LAS int* base = lcnt + 64;
    constexpr int UPC = TC / 128;
    for (int u = bid; u < T / 128; u += nb) {
        const int c = u / UPC, ul = u % UPC;
        __syncthreads();
        if (tid < 64) {
            int tt = 0, pre = 0;
            for (int q = 0; q < UPC; ++q) { const int v = cnt[(c * UPC + q) * 64 + tid]; tt += v; pre += (q < ul) ? v : 0; }
            tot[tid] = tt; pos0[tid] = pre; lcnt[tid] = 0;
        }
        __syncthreads();
        if (tid == 0) { int acc = 0; for (int e = 0; e < 64; ++e) { base[e] = acc; acc += (tot[e] + 255) & ~255; } base[64] = acc; }
        __syncthreads();
        int* stok_c = stok + (size_t)c * RMAX; int* dest_c = dest + (size_t)c * RMAX; float* rsc_c = rsc + (size_t)c * RMAX;
#pragma unroll
        for (int rep = 0; rep < 2; ++rep) {
            const int pr = tid + rep * NTHREADS, tl = pr >> 3, k = pr & 7;
            const size_t t = (size_t)u * 128 + tl;
            const int e = ridx[t * 8 + k];
            const int rank = __hip_atomic_fetch_add(&lcnt[e], 1, __ATOMIC_RELAXED, __HIP_MEMORY_SCOPE_WORKGROUP);
            const int pos = base[e] + pos0[e] + rank;
            stok_c[pos] = (int)t; dest_c[pos] = (int)(t - (size_t)c * TC) * 8 + k; rsc_c[pos] = rw[t * 8 + k];
        }
        if (ul < 64) {
            const int e = ul, lo = base[e] + tot[e], hi = base[e + 1];
            for (int r = lo + tid; r < hi; r += NTHREADS) { stok_c[r] = c * TC; dest_c[r] = TC * 8; rsc_c[r] = 0.f; }
        }
        if (ul == 0) {
            const int ntl = base[64] / 256;
            for (int mt = tid; mt < ntl; mt += NTHREADS) { int e = 0; for (int q = 1; q < 64; ++q) e = (base[q] <= mt * 256) ? q : e; tile[c * TILE_STRIDE + mt] = e; }
            if (tid == 0) tile[c * TILE_STRIDE + TILE_STRIDE - 1] = ntl;
        }
    }
}

struct SchedShared {
    int G, c;
    __device__ __forceinline__ bool next(int i, gf::Unit& u) const {
        constexpr int nU1 = (T / 256) * 2;
        const int L = i * G + c; if (L >= nU1) return false;
        u.rowidx = nullptr; u.keep = 0; u.x0 = 0;
        const int pm = L >> 1, pn = L & 1; u.A = (unsigned)WS_XB + (unsigned)pm * 256u * (D * 2); u.B = (unsigned)WS_WS13T + (unsigned)pn * 256u * (D * 2); u.lda = D * 2; u.ldb = D * 2; u.nt = D / 64; u.kind = 0; u.r0 = pm * 256; u.c0 = pn * 128;
        return true;
    }
};
struct EpiShared { bf16* hs;
    __device__ __forceinline__ void operator()(f32x4 (&acc)[2][2][4][2], const gf::Unit& u, int wr, int wc, int fr, int fq) const { epi_gate(acc, hs, SDIM, u.r0, u.c0, wr, wc, fr, fq); }
};
__device__ void phase_shared(const Args& a, LAS unsigned char* lds, int bid, int nb) {
    SchedShared S{nb, vcu_of(bid, nb)};
    EpiShared E{(bf16*)(a.ws + WS_HS)};
    gf::gemm_fast<false>(lds, a.ws, S, E);
}

struct SchedBase {
    int G, c;
    __device__ __forceinline__ bool next(int i, gf::Unit& u) const {
        constexpr int nU = (T / 256) * 4;
        const int v = (i >> 1) * G + c, part = i & 1; if (v >= nU) return false;
        const int pm = v >> 2, pn = v & 3;
        u.rowidx = nullptr; u.x0 = 0; u.r0 = pm * 256; u.c0 = pn * 256; u.kind = part; u.keep = 1 - part;
        if (part == 0) { u.A = (unsigned)WS_XB + (unsigned)pm * 256u * (D * 2); u.B = (unsigned)WS_WGT + (unsigned)pn * 256u * (D * 2); u.lda = D * 2; u.ldb = D * 2; u.nt = D / 64; }
        else { u.A = (unsigned)WS_HS + (unsigned)pm * 256u * (SDIM * 2); u.B = (unsigned)WS_WS2T + (unsigned)pn * 256u * (SDIM * 2); u.lda = SDIM * 2; u.ldb = SDIM * 2; u.nt = SDIM / 64; }
        return true;
    }
};
struct EpiBase { const bf16* x1b; const bf16* pp; const float* bg; float* y;
    __device__ __forceinline__ void operator()(f32x4 (&acc)[2][2][4][2], const gf::Unit& u, int wr, int wc, int fr, int fq) const {
        if (u.kind == 0) {
#pragma unroll
            for (int ai = 0; ai < 2; ++ai)
#pragma unroll
                for (int m = 0; m < 4; ++m) {
                    const size_t t = (size_t)(u.r0 + 128 * ai + 64 * wr + 16 * m + fr);
#pragma unroll
                    for (int bj = 0; bj < 2; ++bj) {
                        const int col = u.c0 + 128 * bj + 32 * wc + 8 * fq;
                        const f32x4 b0 = *(const f32x4*)(bg + col), b1 = *(const f32x4*)(bg + col + 4);
                        const u32x4 pw = *(const u32x4*)(pp + t * D + col), xw = *(const u32x4*)(x1b + t * D + col);
                        const unsigned pws[4] = {pw.x, pw.y, pw.z, pw.w}, xws[4] = {xw.x, xw.y, xw.z, xw.w};
                        float v[8];
#pragma unroll
                        for (int j = 0; j < 8; ++j) {
                            const float gacc = acc[ai][bj][m][j >> 2][j & 3] + ((j < 4) ? b0[j & 3] : b1[j & 3]);
                            const float ppv = (j & 1) ? bf2f(pws[j >> 1] >> 16) : bf2f(pws[j >> 1] & 0xffffu);
                            const float xv = (j & 1) ? bf2f(xws[j >> 1] >> 16) : bf2f(xws[j >> 1] & 0xffffu);
                            v[j] = sigmoidf_(gacc) * ppv + ALPHA * xv;
                        }
                        acc[ai][bj][m][0] = (f32x4){v[0], v[1], v[2], v[3]}; acc[ai][bj][m][1] = (f32x4){v[4], v[5], v[6], v[7]};
                    }
                    asm volatile("" : "+v"(acc[ai][0][m][0]), "+v"(acc[ai][0][m][1]), "+v"(acc[ai][1][m][0]), "+v"(acc[ai][1][m][1]) :: "memory");
                }
        } else {
#pragma unroll
            for (int ai = 0; ai < 2; ++ai)
#pragma unroll
                for (int m = 0; m < 4; ++m) {
                    const size_t off = (size_t)(u.r0 + 128 * ai + 64 * wr + 16 * m + fr) * D + u.c0 + 32 * wc + 8 * fq;
#pragma unroll
                    for (int bj = 0; bj < 2; ++bj)
#pragma unroll
                        for (int n = 0; n < 2; ++n) *(f32x4*)(y + off + 128 * bj + 4 * n) = acc[ai][bj][m][n];
                }
        }
    }
};
__device__ void phase_base(const Args& a, LAS unsigned char* lds, int bid, int nb) {
    SchedBase S{nb, vcu_of(bid, nb)};
    EpiBase E{(const bf16*)(a.ws + WS_XB), (const bf16*)(a.ws + WS_PP), a.in[I_BG], a.out};
    gf::gemm_fast<true>(lds, a.ws, S, E);
}

struct SchedMoeUp {
    const int* stok; const int* tile; int nU, G, c;
    __device__ __forceinline__ bool next(int i, gf::Unit& u) const {
        const int L = i * G + c; if (L >= nU) return false;
        const int mt = L >> 1, pn = L & 1, e = uload(tile + mt);
        u.A = (unsigned)WS_XB; u.rowidx = stok + mt * 256; u.B = (unsigned)WS_W13T + ((unsigned)e * 512u + pn * 256u) * (D * 2); u.lda = D * 2; u.ldb = D * 2; u.nt = D / 64; u.keep = 0;
        u.kind = 0; u.r0 = mt * 256; u.c0 = pn * 128; u.x0 = 0; return true;
    }
};
struct EpiMoeUp { bf16* hsort; __device__ __forceinline__ void operator()(f32x4 (&acc)[2][2][4][2], const gf::Unit& u, int wr, int wc, int fr, int fq) const { epi_gate(acc, hsort, EDIM, u.r0, u.c0, wr, wc, fr, fq); } };
__device__ void phase_moe_up(const Args& a, LAS unsigned char* lds, int c, int bid, int nb) {
    unsigned char* ro = a.ws + WS_ROUT;
    const int* tile = (const int*)(ro + RO_TILE) + c * TILE_STRIDE;
    SchedMoeUp S{(const int*)(ro + RO_STOK) + (size_t)c * RMAX, tile, uload(tile + TILE_STRIDE - 1) * 2, nb, vcu_of(bid, nb)};
    EpiMoeUp E{(bf16*)(a.ws + WS_HSORT)};
    gf::gemm_fast<true>(lds, a.ws, S, E);
}
struct SchedMoeDown {
    const int* tile; int nU, G, c;
    __device__ __forceinline__ bool next(int i, gf::Unit& u) const {
        const int L = i * G + c; if (L >= nU) return false;
        const int mt = L >> 2, pn = L & 3, e = uload(tile + mt);
        u.A = (unsigned)WS_HSORT + (unsigned)mt * 256u * (EDIM * 2); u.rowidx = nullptr; u.B = (unsigned)WS_W2T + ((unsigned)e * D + pn * 256u) * (EDIM * 2); u.lda = EDIM * 2; u.ldb = EDIM * 2; u.nt = EDIM / 64; u.keep = 0;
        u.kind = 0; u.r0 = mt * 256; u.c0 = pn * 256; u.x0 = 0; return true;
    }
};
struct EpiMoeDown { const int* dest; const float* rsc; bf16* contrib;
    __device__ __forceinline__ void operator()(f32x4 (&acc)[2][2][4][2], const gf::Unit& u, int wr, int wc, int fr, int fq) const {
#pragma unroll
        for (int ai = 0; ai < 2; ++ai)
#pragma unroll
            for (int m = 0; m < 4; ++m) {
                const int r = u.r0 + 128 * ai + 64 * wr + 16 * m + fr;
                const int dr = dest[r]; const float s = rsc[r];
                bf16* rp = contrib + (size_t)dr * D + u.c0 + 32 * wc + 8 * fq;
#pragma unroll
                for (int bj = 0; bj < 2; ++bj) {
                    const f32x4 v0 = acc[ai][bj][m][0] * s, v1 = acc[ai][bj][m][1] * s;
                    u32x4 w; w.x = cvt_pk_bf16(v0[0], v0[1]); w.y = cvt_pk_bf16(v0[2], v0[3]); w.z = cvt_pk_bf16(v1[0], v1[1]); w.w = cvt_pk_bf16(v1[2], v1[3]);
                    *(u32x4*)(rp + 128 * bj) = w;
                }
                asm volatile("" ::: "memory");
            }
    }
};
__device__ void phase_moe_down(const Args& a, LAS unsigned char* lds, int c, int bid, int nb) {
    unsigned char* ro = a.ws + WS_ROUT;
    const int* tile = (const int*)(ro + RO_TILE) + c * TILE_STRIDE;
    SchedMoeDown S{tile, uload(tile + TILE_STRIDE - 1) * 4, nb, vcu_of(bid, nb)};
    EpiMoeDown E{(const int*)(ro + RO_DEST) + (size_t)c * RMAX, (const float*)(ro + RO_RSC) + (size_t)c * RMAX, (bf16*)(a.ws + WS_CONTRIB)};
    gf::gemm_fast<false>(lds, a.ws, S, E);
}
__device__ void phase_combine(const Args& a, int c, int bid, int nb) {
    const int tid = hidden_tid(), wid = tid >> 6, lane = tid & 63;
    const bf16* contrib = (const bf16*)(a.ws + WS_CONTRIB);
    const float* g = a.in[I_LN2G]; const float* bta = a.in[I_LN2B]; float* y = a.out;
    f32x4 gv[4], bv[4];
#pragma unroll
    for (int j = 0; j < 2; ++j) { gv[2 * j] = *(const f32x4*)(g + 512 * j + 8 * lane); gv[2 * j + 1] = *(const f32x4*)(g + 512 * j + 8 * lane + 4); bv[2 * j] = *(const f32x4*)(bta + 512 * j + 8 * lane); bv[2 * j + 1] = *(const f32x4*)(bta + 512 * j + 8 * lane + 4); }
    for (int rl = bid * 8 + wid; rl < TC; rl += nb * 8) {
        float* row = y + ((size_t)c * TC + rl) * D;
        f32x4 v[4];
#pragma unroll
        for (int j = 0; j < 2; ++j) { v[2 * j] = *(const f32x4*)(row + 512 * j + 8 * lane); v[2 * j + 1] = *(const f32x4*)(row + 512 * j + 8 * lane + 4); }
#pragma unroll
        for (int k = 0; k < 8; ++k) {
            const bf16* cr = contrib + ((size_t)rl * 8 + k) * D;
#pragma unroll
            for (int j = 0; j < 2; ++j) {
                const u32x4 cw = *(const u32x4*)(cr + 512 * j + 8 * lane);
                v[2 * j][0] += bf2f(cw.x & 0xffffu); v[2 * j][1] += bf2f(cw.x >> 16); v[2 * j][2] += bf2f(cw.y & 0xffffu); v[2 * j][3] += bf2f(cw.y >> 16);
                v[2 * j + 1][0] += bf2f(cw.z & 0xffffu); v[2 * j + 1][1] += bf2f(cw.z >> 16); v[2 * j + 1][2] += bf2f(cw.w & 0xffffu); v[2 * j + 1][3] += bf2f(cw.w >> 16);
            }
        }
        float s = 0.f;
#pragma unroll
        for (int i = 0; i < 4; ++i) s += (v[i][0] + v[i][1]) + (v[i][2] + v[i][3]);
#pragma unroll
        for (int o = 32; o >= 1; o >>= 1) s += __shfl_xor(s, o);
        const float mean = s * (1.0f / D);
        float q = 0.f;
#pragma unroll
        for (int i = 0; i < 4; ++i) { const f32x4 d = v[i] - mean; q += (d[0] * d[0] + d[1] * d[1]) + (d[2] * d[2] + d[3] * d[3]); }
#pragma unroll
        for (int o = 32; o >= 1; o >>= 1) q += __shfl_xor(q, o);
        const float rstd = rsqrtf(q * (1.0f / D) + LN_EPS);
#pragma unroll
        for (int j = 0; j < 2; ++j) {
            *(f32x4*)(row + 512 * j + 8 * lane) = (v[2 * j] - mean) * rstd * gv[2 * j] + bv[2 * j];
            *(f32x4*)(row + 512 * j + 8 * lane + 4) = (v[2 * j + 1] - mean) * rstd * gv[2 * j + 1] + bv[2 * j + 1];
        }
    }
}

#define XB_TMO      128
#define XB_XCNT(j)  (256  + 64 * (j))
#define XB_XSUB(j)  (1280 + 64 * (j))
#define XB_XGEN(j)  (2304 + 64 * (j))
#define XB_TOP      3328
#define XB_TOPGEN   3392
#define XCD_BAR_WORDS 3456
#define XB_SPIN_CAP (1u << 18)

__device__ __forceinline__ unsigned xb_ld(unsigned* p)              { return __hip_atomic_load(p, __ATOMIC_RELAXED, __HIP_MEMORY_SCOPE_AGENT); }
__device__ __forceinline__ unsigned xb_add(unsigned* p, unsigned v) { return __hip_atomic_fetch_add(p, v, __ATOMIC_RELAXED, __HIP_MEMORY_SCOPE_AGENT); }
__device__ __forceinline__ unsigned xb_xcc_id() { return (unsigned)__builtin_amdgcn_s_getreg((3 << 11) | 20) & 0xFu; }
#define XB_SPIN(cond, bar) do { unsigned _sp = 0; while (cond) { __builtin_amdgcn_s_sleep(1); \
    if ((++_sp & 255u) == 0u) { if (xb_ld(&(bar)[XB_TMO])) break; if (_sp > XB_SPIN_CAP) { atomicAdd(&(bar)[XB_TMO], 1u); break; } } } } while (0)

struct XcdBarrier {
    unsigned* bar; unsigned x;
    volatile LAS unsigned* st;
};
__device__ __forceinline__ XcdBarrier xcd_barrier_post(unsigned* bar, volatile LAS unsigned* st) {
    XcdBarrier b; b.bar = bar; b.x = xb_xcc_id(); b.st = st;
    if (threadIdx.x == 0) (void)xb_add(&bar[XB_XCNT(b.x)], 1u);
    return b;
}
__device__ __forceinline__ void xcd_barrier_complete(unsigned* bar, unsigned x, unsigned& nloc, unsigned& nx) {
    const unsigned G = gridDim.x * gridDim.y * gridDim.z;
    unsigned sum, cnt, mine, sp = 0u;
    for (;;) {
        sum = 0u; cnt = 0u; mine = 0u;
#pragma unroll
        for (unsigned j = 0; j < 16; ++j) { const unsigned c = xb_ld(&bar[XB_XCNT(j)]); sum += c; cnt += (c > 0u) ? 1u : 0u; mine = (j == x) ? c : mine; }
        if (sum == G) break;
        __builtin_amdgcn_s_sleep(1);
        if ((++sp & 255u) == 0u) { if (xb_ld(&bar[XB_TMO])) break; if (sp > XB_SPIN_CAP) { atomicAdd(&bar[XB_TMO], 1u); break; } }
    }
    nloc = mine > 0u ? mine : 1u; nx = cnt > 0u ? cnt : 1u;
}
__device__ __forceinline__ void xcd_barrier(const XcdBarrier& b) {
    asm volatile("s_waitcnt vmcnt(0)" ::: "memory");
    __syncthreads();
    if (threadIdx.x == 0) {
        unsigned* bar = b.bar;
        __builtin_amdgcn_s_waitcnt(0);
        unsigned nloc = b.st[0], nx = b.st[1];
        if (nloc == 0u) { xcd_barrier_complete(bar, b.x, nloc, nx); b.st[0] = nloc; b.st[1] = nx; }
        const unsigned old = xb_add(&bar[XB_XSUB(b.x)], 1u);
        const unsigned gen = old / nloc;
        if (old + 1u == (gen + 1u) * nloc) {
            __builtin_amdgcn_fence(__ATOMIC_RELEASE, "agent");
            asm volatile("s_waitcnt vmcnt(0)" ::: "memory");
            const unsigned og = xb_add(&bar[XB_TOP], 1u);
            const unsigned tg = og / nx;
            if (og + 1u == (tg + 1u) * nx) xb_add(&bar[XB_TOPGEN], 1u);
            else XB_SPIN(xb_ld(&bar[XB_TOPGEN]) == tg, bar);
            __builtin_amdgcn_fence(__ATOMIC_ACQUIRE, "agent");
            xb_add(&bar[XB_XGEN(b.x)], 1u);
            asm volatile("s_waitcnt vmcnt(0)" ::: "memory");
        } else {
            XB_SPIN(xb_ld(&bar[XB_XGEN(b.x)]) == gen, bar);
            __builtin_amdgcn_fence(__ATOMIC_ACQUIRE, "agent");
            asm volatile("s_waitcnt vmcnt(0)" ::: "memory");
        }
    }
    __syncthreads();
}

constexpr int PH_PROLOGUE = 0, PH_PROJ = 1, PH_MIX_A = 2, PH_MIX_B = 3, PH_WOUT = 4, PH_LN1 = 5, PH_ROUTER = 6, PH_SORT = 7, PH_MOE0 = 8, PH_END = PH_MOE0 + 3 * NH;
constexpr int LDS_BYTES = 147456;

constexpr int LDS_BAR_OFF = LDS_BYTES - 16;
#ifndef N_LAUNCHES
#define N_LAUNCHES 1
#endif
__global__ void __launch_bounds__(NTHREADS, 2) fwd(Args a) {
    extern __shared__ __attribute__((aligned(16))) unsigned char lds_raw[];
    LAS unsigned char* lds = (LAS unsigned char*)lds_raw;
    const int bid = blockIdx.x, nb = gridDim.x;
    if (threadIdx.x < 4) ((LAS unsigned*)(lds + LDS_BAR_OFF))[threadIdx.x] = 0u;
    __syncthreads();
    XcdBarrier bar = xcd_barrier_post((unsigned*)(a.ws + WS_CTL), (volatile LAS unsigned*)(lds + LDS_BAR_OFF));
    const int lo = a.ph_lo, hi = a.ph_hi;
#ifndef PHMASK
#define PHMASK 0xffffffffu
#endif
#define IN(k) (((PHMASK >> ((k) < PH_MOE0 ? (k) : 8 + ((k) - PH_MOE0) % 3)) & 1u) && lo <= (k) && (k) < hi)
#define SEAM(k) do { if (lo <= (k) && (k) + 1 < hi) xcd_barrier(bar); } while (0)
    if (IN(PH_PROLOGUE)) phase_prologue(a, lds, bid, nb);
    SEAM(PH_PROLOGUE);
    if (IN(PH_PROJ)) phase_proj(a, lds, bid, nb);
    SEAM(PH_PROJ);
    if (IN(PH_MIX_A)) { phase_segtot(a, lds, bid, nb); phase_swa(a, lds, bid, nb); }
    SEAM(PH_MIX_A);
    if (IN(PH_MIX_B)) phase_retention(a, lds, bid, nb);
    SEAM(PH_MIX_B);
    if (IN(PH_WOUT)) phase_wout(a, lds, bid, nb);
    SEAM(PH_WOUT);
    if (IN(PH_LN1)) phase_ln<0>(a.out, a.in[I_LN1G], a.in[I_LN1B], (bf16*)(a.ws + WS_XB), nullptr, bid, nb);
    SEAM(PH_LN1);
    if (IN(PH_ROUTER)) { phase_router(a, lds, bid, nb); __syncthreads(); phase_shared(a, lds, bid, nb); }
    SEAM(PH_ROUTER);
    if (IN(PH_SORT)) { phase_sort(a, lds, bid, nb); __syncthreads(); phase_base(a, lds, bid, nb); }
    SEAM(PH_SORT);
    for (int c = 0; c < NH; ++c) {
        if (IN(PH_MOE0 + 3 * c)) phase_moe_up(a, lds, c, bid, nb);
        SEAM(PH_MOE0 + 3 * c);
        if (IN(PH_MOE0 + 3 * c + 1)) phase_moe_down(a, lds, c, bid, nb);
        SEAM(PH_MOE0 + 3 * c + 1);
        if (IN(PH_MOE0 + 3 * c + 2)) phase_combine(a, c, bid, nb);
        SEAM(PH_MOE0 + 3 * c + 2);
    }
#undef IN
#undef SEAM
}

extern "C" void kernel_launch(void* const* d_in, const int* in_sizes, int n_in, void* d_out, int out_size, void* d_ws, size_t ws_size, hipStream_t stream) {
    static int grid = 0;
    if (grid == 0) {
        if (n_in != 22 || out_size != T * D || ws_size < WS_NEED) { fprintf(stderr, "kernel_launch: unexpected shapes: n_in %d out %d ws %zu (need %zu)\n", n_in, out_size, ws_size, (size_t)WS_NEED); grid = -1; return; }
        int dev = 0, cus = 0;
        (void)hipGetDevice(&dev); (void)hipDeviceGetAttribute(&cus, hipDeviceAttributeMultiprocessorCount, dev);
        if (hipFuncSetAttribute((const void*)fwd, hipFuncAttributeMaxDynamicSharedMemorySize, LDS_BYTES) != hipSuccess) { fprintf(stderr, "hipFuncSetAttribute failed\n"); grid = -1; return; }
        int per_cu = 0;
        if (hipOccupancyMaxActiveBlocksPerMultiprocessor(&per_cu, (const void*)fwd, NTHREADS, LDS_BYTES) != hipSuccess || per_cu < 1) { fprintf(stderr, "occupancy query: %d blocks per CU\n", per_cu); grid = -1; return; }
        (void)hipGetLastError();
        grid = cus > 0 ? cus : 256;
    }
    if (grid < 0) return;
    (void)hipMemsetAsync((char*)d_ws + WS_CTL, 0, 16384, stream);
    Args a{};
    for (int i = 0; i < 22; ++i) a.in[i] = (const float*)d_in[i];
    a.out = (float*)d_out; a.ws = (unsigned char*)d_ws;
#if N_LAUNCHES == 1
    a.ph_lo = 0; a.ph_hi = PH_END;
    hipLaunchKernelGGL(fwd, dim3(grid), dim3(NTHREADS), LDS_BYTES, stream, a);
#else
    for (int ph = 0; ph < PH_END; ++ph) {
        a.ph_lo = ph; a.ph_hi = ph + 1;
        hipLaunchKernelGGL(fwd, dim3(grid), dim3(NTHREADS), LDS_BYTES, stream, a);
    }
#endif
}
```

```cpp
#include <hip/hip_runtime.h>
#include <cstdio>
#include <cstdint>

#define LAS __attribute__((address_space(3)))
typedef unsigned short bf16;
typedef short bf16x8 __attribute__((ext_vector_type(8)));
typedef short bf16x4 __attribute__((ext_vector_type(4)));
typedef float f32x4 __attribute__((ext_vector_type(4)));
typedef unsigned u32x4 __attribute__((ext_vector_type(4)));
typedef unsigned u32x2 __attribute__((ext_vector_type(2)));

constexpr int D = 1024, BATCH = 8, SEQ = 4096, T = BATCH * SEQ;
constexpr int HD = 64, RH = 8, QH = 8, KVH = 2;
constexpr int INW = 2816;
constexpr int C_RQ = 0, C_RK = 512, C_RV = 1024, C_RG = 1536, C_AQ = 2048, C_AK = 2560, C_AV = 2688;
constexpr int CH = 128, NCH = SEQ / CH;
constexpr int SEGC = 8, NSEG = NCH / SEGC;
constexpr int NE = 64, TOPK = 8, EDIM = 256, SDIM = 256, PLE = 256;
constexpr float LN_EPS = 1e-5f, GN_EPS = 1e-6f;
constexpr float ALPHA = 1.189207115002721f;
constexpr float ROUTED_SCALE = 2.5f;
constexpr int NH = 2, TC = T / NH;
constexpr int RMAX = TC * TOPK + NE * 256;
constexpr int MAXTILES = RMAX / 256;
constexpr int NTHREADS = 512;

constexpr size_t MiB = 1u << 20;
constexpr size_t al(size_t x) { return (x + 255) & ~(size_t)255; }
constexpr size_t WS_CTL = 0, CTL_BYTES = 1 * MiB;
constexpr size_t WS_W13T = WS_CTL + CTL_BYTES;
constexpr size_t WS_W2T = WS_W13T + al((size_t)NE * 512 * D * 2);
constexpr size_t WS_ROUT = WS_W2T + al((size_t)NE * D * EDIM * 2);
constexpr size_t RO_RIDX = 0, RO_RW = RO_RIDX + (size_t)T * 8 * 4, RO_CNT = RO_RW + (size_t)T * 8 * 4, RO_STOK = RO_CNT + 256 * 64 * 4;
constexpr size_t RO_DEST = RO_STOK + (size_t)NH * RMAX * 4, RO_RSC = RO_DEST + (size_t)NH * RMAX * 4, RO_TILE = RO_RSC + (size_t)NH * RMAX * 4;
constexpr int TILE_STRIDE = 1024;
static_assert(MAXTILES < TILE_STRIDE - 1, "tile table");
constexpr size_t RO_END = RO_TILE + (size_t)NH * TILE_STRIDE * 4;
constexpr size_t WS_XB = WS_ROUT + al(RO_END);
constexpr size_t WS_DYN = WS_XB + al((size_t)T * D * 2);
constexpr size_t WS_WINT = WS_DYN;
constexpr size_t WS_WOUTT = WS_WINT + al((size_t)INW * D * 2);
constexpr size_t WS_WS13T = WS_WOUTT + al((size_t)D * D * 2);
constexpr size_t WS_WS2T = WS_WS13T + al((size_t)512 * D * 2);
constexpr size_t WS_WGT = WS_WS2T + al((size_t)D * SDIM * 2);
constexpr size_t WS_WPT = WS_WGT + al((size_t)D * D * 2);
constexpr size_t WS_WRT = WS_WPT + al((size_t)D * PLE * 2);
constexpr size_t WS_TAB = WS_WRT + al((size_t)NE * D * 2);
constexpr size_t TAB_BYTES = (size_t)SEQ * (32 + 32 + 8 + 8) * 4;
constexpr size_t WS_SEGT = WS_TAB + al(TAB_BYTES);
constexpr size_t WS_PB = WS_SEGT + al((size_t)BATCH * RH * NSEG * 64 * 64 * 4);
constexpr size_t WS_BIG = WS_PB + al((size_t)T * PLE * 2);
constexpr size_t WS_MIXO = WS_BIG + al((size_t)T * INW * 2);
constexpr size_t WS_PP = WS_MIXO + al((size_t)T * D * 2);
constexpr size_t WS_END1 = WS_PP + al((size_t)T * D * 2);
constexpr size_t WS_HS = WS_BIG;
constexpr size_t WS_HSORT = WS_DYN;
constexpr size_t WS_CONTRIB = WS_HSORT + al((size_t)RMAX * EDIM * 2);
constexpr size_t WS_END2 = WS_CONTRIB + al(((size_t)TC * 8 + 1) * D * 2);
constexpr size_t WS_NEED = WS_END1 > WS_END2 ? WS_END1 : WS_END2;
static_assert(WS_NEED <= 512 * MiB, "workspace map exceeds 512 MiB");

__device__ __forceinline__ int hidden_tid() { int t = threadIdx.x; asm volatile("" : "+v"(t)); return t; }
__device__ __forceinline__ float bf2f(unsigned v) { return __uint_as_float(v << 16); }
__device__ __forceinline__ unsigned cvt_pk_bf16(float lo, float hi) { unsigned r; asm volatile("v_cvt_pk_bf16_f32 %0, %1, %2" : "=v"(r) : "v"(lo), "v"(hi)); return r; }
__device__ __forceinline__ bf16 f2bf(float f) { return (bf16)(cvt_pk_bf16(f, 0.f) & 0xffffu); }
__device__ __forceinline__ float sigmoidf_(float x) { return 1.0f / (1.0f + __expf(-x)); }
__device__ __forceinline__ float siluf_(float x) { return x / (1.0f + __expf(-x)); }

struct Args {
    const float* in[22];
    float* out;
    unsigned char* ws;
    int ph_lo, ph_hi;
};
enum { I_X = 0, I_P, I_WIN, I_GN, I_ASC, I_SINK, I_WOUT, I_LN1G, I_LN1B, I_WR, I_RB, I_W1, I_W3, I_W2, I_WS1, I_WS3, I_WS2, I_WG, I_BG, I_WP, I_LN2G, I_LN2B };

struct TJob { const float* src; bf16* dst; int ld_src, ld_dst, sc0, dn0, k0; };
__device__ __forceinline__ bool get_tjob(const Args& a, int t, TJob& j) {
    unsigned char* ws = a.ws;
    if (t < NE * 32) { const int e = t >> 5, rem = t & 31, db = rem >> 2, kt = rem & 3, piece = db >> 1, which = piece & 1, pn = piece >> 1;
        j.src = (which ? a.in[I_W3] : a.in[I_W1]) + (size_t)e * D * EDIM; j.ld_src = EDIM; j.sc0 = pn * 128 + (db & 1) * 64;
        j.dst = (bf16*)(ws + WS_W13T) + (size_t)e * 512 * D; j.ld_dst = D; j.dn0 = db * 64; j.k0 = kt * 256; return true; }
    t -= NE * 32;
    if (t < NE * 16) { const int e = t >> 4, nt = t & 15;
        j.src = a.in[I_W2] + (size_t)e * EDIM * D; j.ld_src = D; j.sc0 = nt * 64; j.dst = (bf16*)(ws + WS_W2T) + (size_t)e * D * EDIM; j.ld_dst = EDIM; j.dn0 = nt * 64; j.k0 = 0; return true; }
    t -= NE * 16;
    if (t < 44 * 4) { j.src = a.in[I_WIN]; j.ld_src = INW; j.sc0 = (t >> 2) * 64; j.dst = (bf16*)(ws + WS_WINT); j.ld_dst = D; j.dn0 = (t >> 2) * 64; j.k0 = (t & 3) * 256; return true; }
    t -= 44 * 4;
    if (t < 16 * 4) { j.src = a.in[I_WOUT]; j.ld_src = D; j.sc0 = (t >> 2) * 64; j.dst = (bf16*)(ws + WS_WOUTT); j.ld_dst = D; j.dn0 = (t >> 2) * 64; j.k0 = (t & 3) * 256; return true; }
    t -= 16 * 4;
    if (t < 8 * 4) { const int db = t >> 2, piece = db >> 1, which = piece & 1, pn = piece >> 1;
        j.src = which ? a.in[I_WS3] : a.in[I_WS1]; j.ld_src = SDIM; j.sc0 = pn * 128 + (db & 1) * 64; j.dst = (bf16*)(ws + WS_WS13T); j.ld_dst = D; j.dn0 = db * 64; j.k0 = (t & 3) * 256; return true; }
    t -= 8 * 4;
    if (t < 16) { j.src = a.in[I_WS2]; j.ld_src = D; j.sc0 = t * 64; j.dst = (bf16*)(ws + WS_WS2T); j.ld_dst = SDIM; j.dn0 = t * 64; j.k0 = 0; return true; }
    t -= 16;
    if (t < 16 * 4) { j.src = a.in[I_WG]; j.ld_src = D; j.sc0 = (t >> 2) * 64; j.dst = (bf16*)(ws + WS_WGT); j.ld_dst = D; j.dn0 = (t >> 2) * 64; j.k0 = (t & 3) * 256; return true; }
    t -= 16 * 4;
    if (t < 16) { j.src = a.in[I_WP]; j.ld_src = D; j.sc0 = t * 64; j.dst = (bf16*)(ws + WS_WPT); j.ld_dst = PLE; j.dn0 = t * 64; j.k0 = 0; return true; }
    t -= 16;
    if (t < 4) { j.src = a.in[I_WR]; j.ld_src = NE; j.sc0 = 0; j.dst = (bf16*)(ws + WS_WRT); j.ld_dst = D; j.dn0 = 0; j.k0 = t * 256; return true; }
    return false;
}
constexpr int N_TJOBS = NE * 32 + NE * 16 + 44 * 4 + 16 * 4 + 8 * 4 + 16 + 16 * 4 + 16 + 4;

__device__ void phase_prologue(const Args& a, LAS unsigned char* lds, int bid, int nb) {
    LAS float* tile = (LAS float*)lds;
    unsigned char* ws = a.ws;
    const int tid = hidden_tid();
    {
        const int lr = tid >> 4, lc4 = (tid & 15) * 4;
        const int wn = tid & 63, wk = (tid >> 6) * 32;
        TJob j; f32x4 v[8];
        int t = bid;
        bool have = get_tjob(a, t, j);
        if (have) {
#pragma unroll
            for (int i = 0; i < 8; ++i) v[i] = *(const f32x4*)(j.src + (size_t)(j.k0 + lr + 32 * i) * j.ld_src + j.sc0 + lc4);
        }
        while (have) {
#pragma unroll
            for (int i = 0; i < 8; ++i) { LAS float* tp = tile + (lr + 32 * i) * 65 + lc4; tp[0] = v[i][0]; tp[1] = v[i][1]; tp[2] = v[i][2]; tp[3] = v[i][3]; }
            bf16* drow = j.dst + (size_t)(j.dn0 + wn) * j.ld_dst + j.k0 + wk;
            t += nb; TJob jn; const bool hn = get_tjob(a, t, jn);
            if (hn) {
#pragma unroll
                for (int i = 0; i < 8; ++i) v[i] = *(const f32x4*)(jn.src + (size_t)(jn.k0 + lr + 32 * i) * jn.ld_src + jn.sc0 + lc4);
            }
            __syncthreads();
#pragma unroll
            for (int q = 0; q < 4; ++q) {
                u32x4 w;
                w.x = cvt_pk_bf16(tile[(wk + 8 * q + 0) * 65 + wn], tile[(wk + 8 * q + 1) * 65 + wn]);
                w.y = cvt_pk_bf16(tile[(wk + 8 * q + 2) * 65 + wn], tile[(wk + 8 * q + 3) * 65 + wn]);
                w.z = cvt_pk_bf16(tile[(wk + 8 * q + 4) * 65 + wn], tile[(wk + 8 * q + 5) * 65 + wn]);
                w.w = cvt_pk_bf16(tile[(wk + 8 * q + 6) * 65 + wn], tile[(wk + 8 * q + 7) * 65 + wn]);
                *(u32x4*)(drow + 8 * q) = w;
            }
            __syncthreads();
            j = jn; have = hn;
        }
    }
    {
        const size_t n8 = (size_t)T * D / 8;
        const float* x = a.in[I_X]; bf16* xb = (bf16*)(ws + WS_XB);
        for (size_t i = (size_t)bid * NTHREADS + tid; i < n8; i += (size_t)nb * NTHREADS) {
            const f32x4 v0 = *(const f32x4*)(x + i * 8), v1 = *(const f32x4*)(x + i * 8 + 4);
            u32x4 w; w.x = cvt_pk_bf16(v0[0], v0[1]); w.y = cvt_pk_bf16(v0[2], v0[3]); w.z = cvt_pk_bf16(v1[0], v1[1]); w.w = cvt_pk_bf16(v1[2], v1[3]);
            *(u32x4*)(xb + i * 8) = w;
        }
        const size_t m8 = (size_t)T * PLE / 8;
        const float* p = a.in[I_P]; bf16* pb = (bf16*)(ws + WS_PB);
        for (size_t i = (size_t)bid * NTHREADS + tid; i < m8; i += (size_t)nb * NTHREADS) {
            const f32x4 v0 = *(const f32x4*)(p + i * 8), v1 = *(const f32x4*)(p + i * 8 + 4);
            u32x4 w; w.x = cvt_pk_bf16(v0[0], v0[1]); w.y = cvt_pk_bf16(v0[2], v0[3]); w.z = cvt_pk_bf16(v1[0], v1[1]); w.w = cvt_pk_bf16(v1[2], v1[3]);
            *(u32x4*)(pb + i * 8) = w;
        }
    }
    {
        float* tab = (float*)(ws + WS_TAB);
        float* cosr = tab, *sinr = tab + SEQ * 32, *coss = tab + SEQ * 64, *sins = tab + SEQ * 72;
        for (int i = bid * NTHREADS + tid; i < SEQ * 40; i += nb * NTHREADS) {
            const int s = i / 40, j = i % 40;
            if (j < 32) {
                const float inv = (float)pow(10000.0, -(double)j / 32.0);
                const float ang = (float)s * inv;
                cosr[s * 32 + j] = (float)cos((double)ang); sinr[s * 32 + j] = (float)sin((double)ang);
            } else {
                const int jj = j - 32;
                const float inv = (float)pow(500000.0, -(double)jj / 8.0);
                const float ang = (float)s * inv;
                coss[s * 8 + jj] = (float)cos((double)ang); sins[s * 8 + jj] = (float)sin((double)ang);
            }
        }
    }
}

__device__ __forceinline__ int perm32(int rho) { const int n = rho >> 4, i = rho & 15; return 8 * (i >> 2) + 4 * n + (i & 3); }

struct GemmPart { const bf16* A; int lda; const int* rowidx; long arow0; const bf16* Bt; int ldb; int K; };

__device__ __forceinline__ void gemm_part(f32x4 (&acc)[2][2][4][2], const GemmPart& g, int wr, int wc, int fr, int fq) {
    unsigned oa[2][4], ob[2][2];
#pragma unroll
    for (int ai = 0; ai < 2; ++ai)
#pragma unroll
        for (int m = 0; m < 4; ++m) {
            const int r = 128 * ai + 64 * wr + 16 * m + fr;
            const long gr = g.rowidx ? (long)g.rowidx[r] : g.arow0 + r;
            oa[ai][m] = (unsigned)((gr * g.lda + 8 * fq) * 2);
        }
#pragma unroll
    for (int bj = 0; bj < 2; ++bj)
#pragma unroll
        for (int n = 0; n < 2; ++n) {
            const int rb = 128 * bj + 32 * wc + perm32(16 * n + fr);
            ob[bj][n] = (unsigned)((rb * g.ldb + 8 * fq) * 2);
        }
    const char* pA = (const char*)g.A; const char* pB = (const char*)g.Bt;
#pragma unroll 1
    for (int k0 = 0; k0 < g.K; k0 += 32) {
        bf16x8 af[2][4], bfr[2][2];
#pragma unroll
        for (int ai = 0; ai < 2; ++ai)
#pragma unroll
            for (int m = 0; m < 4; ++m) af[ai][m] = *(const bf16x8*)(pA + oa[ai][m]);
#pragma unroll
        for (int bj = 0; bj < 2; ++bj)
#pragma unroll
            for (int n = 0; n < 2; ++n) bfr[bj][n] = *(const bf16x8*)(pB + ob[bj][n]);
#pragma unroll
        for (int ai = 0; ai < 2; ++ai)
#pragma unroll
            for (int bj = 0; bj < 2; ++bj)
#pragma unroll
                for (int m = 0; m < 4; ++m)
#pragma unroll
                    for (int n = 0; n < 2; ++n)
                        acc[ai][bj][m][n] = __builtin_amdgcn_mfma_f32_16x16x32_bf16(bfr[bj][n], af[ai][m], acc[ai][bj][m][n], 0, 0, 0);
        pA += 64; pB += 64;
    }
}
__device__ __forceinline__ void zero_acc(f32x4 (&acc)[2][2][4][2]) {
#pragma unroll
    for (int a = 0; a < 2; ++a)
#pragma unroll
        for (int b = 0; b < 2; ++b)
#pragma unroll
            for (int m = 0; m < 4; ++m)
#pragma unroll
                for (int n = 0; n < 2; ++n) acc[a][b][m][n] = (f32x4){0.f, 0.f, 0.f, 0.f};
}
#define WAVE_IDS() int tid_ = threadIdx.x; asm volatile("" : "+v"(tid_)); const int tid = tid_, wid = __builtin_amdgcn_readfirstlane(tid >> 6), lane = tid & 63, wr = wid >> 2, wc = wid & 3, fr = lane & 15, fq = lane >> 4; (void)lane; (void)wr; (void)wc; (void)fr; (void)fq

__device__ __forceinline__ void epi_bf16(const f32x4 (&acc)[2][2][4][2], bf16* O, int ldo, long row0, int col0, int wr, int wc, int fr, int fq) {
#pragma unroll
    for (int ai = 0; ai < 2; ++ai)
#pragma unroll
        for (int m = 0; m < 4; ++m) {
            bf16* rp = O + (size_t)(row0 + 128 * ai + 64 * wr + 16 * m + fr) * ldo + col0 + 32 * wc + 8 * fq;
#pragma unroll
            for (int bj = 0; bj < 2; ++bj) {
                const f32x4 v0 = acc[ai][bj][m][0], v1 = acc[ai][bj][m][1];
                u32x4 w; w.x = cvt_pk_bf16(v0[0], v0[1]); w.y = cvt_pk_bf16(v0[2], v0[3]); w.z = cvt_pk_bf16(v1[0], v1[1]); w.w = cvt_pk_bf16(v1[2], v1[3]);
                *(u32x4*)(rp + 128 * bj) = w;
            }
        }
}
__device__ __forceinline__ void epi_gate(const f32x4 (&acc)[2][2][4][2], bf16* O, int ldo, long row0, int col0, int wr, int wc, int fr, int fq) {
#pragma unroll
    for (int ai = 0; ai < 2; ++ai)
#pragma unroll
        for (int m = 0; m < 4; ++m) {
            bf16* rp = O + (size_t)(row0 + 128 * ai + 64 * wr + 16 * m + fr) * ldo + col0 + 32 * wc + 8 * fq;
            float h[8];
#pragma unroll
            for (int n = 0; n < 2; ++n)
#pragma unroll
                for (int j = 0; j < 4; ++j) h[4 * n + j] = siluf_(acc[ai][0][m][n][j]) * acc[ai][1][m][n][j];
            u32x4 w; w.x = cvt_pk_bf16(h[0], h[1]); w.y = cvt_pk_bf16(h[2], h[3]); w.z = cvt_pk_bf16(h[4], h[5]); w.w = cvt_pk_bf16(h[6], h[7]);
            *(u32x4*)rp = w;
        }
}

namespace gf {
constexpr int BM = 256, BK = 64, HALF = 128, HTB = HALF * BK * 2, STAGE_BYTES = 8 * HTB;
__device__ __forceinline__ int lds_byte(int r, int c) { const int st = (r >> 4) * 2 + (c >> 5), rr = r & 15, cc = c & 31, ob = rr * 64 + cc * 2; return st * 1024 + (ob ^ (((ob >> 9) & 1) << 5)); }
__device__ __forceinline__ void stage_rc(int b, int& R, int& C) { const int st = b / 1024, sb = b % 1024, swz = sb ^ (((sb >> 9) & 1) << 5); R = (st >> 1) * 16 + swz / 64; C = (st & 1) * 32 + (swz % 64) / 2; }

struct Unit {
    unsigned A;
    unsigned B;
    const int* rowidx;
    int lda, ldb;
    int nt;
    int keep;
    int kind, r0, c0, x0;
};

template <bool GENERAL, class Sched, class Epi>
__device__ __forceinline__ void gemm_fast(LAS unsigned char* lds, const unsigned char* ws, const Sched& S, const Epi& E) {
    const __amdgpu_buffer_rsrc_t rsrc = __builtin_amdgcn_make_buffer_rsrc((void*)ws, 0, 0x7ffffff0, 0x00020000);
    int tid = threadIdx.x; asm volatile("" : "+v"(tid));
    const int wid = __builtin_amdgcn_readfirstlane(tid >> 6), lane = tid & 63, wr = wid >> 2, wc = wid & 3, fr = lane & 15, fq = lane >> 4;
    const unsigned ldsw = (unsigned)wid * 1024u;
    const int aoff = lds_byte(wr * 64 + fr, fq * 8), boff = lds_byte(wc * 32 + fr, fq * 8);
    constexpr unsigned kstep = (unsigned)(BK * 2);
#define GF_SA(b, h) (((b) * 2 + (h)) * HTB)
#define GF_SB(b, h) ((4 + (b) * 2 + (h)) * HTB)
#define GF_STAGE(bufoff, soff, o0, o1) do { \
        __builtin_amdgcn_raw_ptr_buffer_load_lds(rsrc, (LAS void*)(lds + (bufoff) + ldsw), 16, (int)(o0), (int)(soff), 0, 0); \
        __builtin_amdgcn_raw_ptr_buffer_load_lds(rsrc, (LAS void*)(lds + (bufoff) + ldsw + 8192), 16, (int)(o1), (int)(soff), 0, 0); } while (0)
#define GF_LDA(dst, b, h) do { _Pragma("unroll") for (int m = 0; m < 4; ++m) _Pragma("unroll") for (int k = 0; k < 2; ++k) dst[m][k] = *(const LAS bf16x8*)(lds + GF_SA(b, h) + aoff + m * 2048 + k * 1024); } while (0)
#define GF_LDB(dst, b, h) do { _Pragma("unroll") for (int n = 0; n < 2; ++n) _Pragma("unroll") for (int k = 0; k < 2; ++k) dst[n][k] = *(const LAS bf16x8*)(lds + GF_SB(b, h) + boff + n * 2048 + k * 1024); } while (0)
#define GF_MMA(ai, bj, At, Bt) do { __builtin_amdgcn_s_setprio(1); _Pragma("unroll") for (int m = 0; m < 4; ++m) _Pragma("unroll") for (int n = 0; n < 2; ++n) _Pragma("unroll") for (int k = 0; k < 2; ++k) \
        acc[ai][bj][m][n] = __builtin_amdgcn_mfma_f32_16x16x32_bf16(Bt[n][k], At[m][k], acc[ai][bj][m][n], 0, 0, 0); __builtin_amdgcn_s_setprio(0); } while (0)
#define GF_WAIT_V(n) asm volatile("s_waitcnt vmcnt(" #n ")" ::: "memory")
#define GF_WAIT_L(n) asm volatile("s_waitcnt lgkmcnt(" #n ")" ::: "memory")
#define GF_BAR __builtin_amdgcn_s_barrier()
#define GF_SCHED __builtin_amdgcn_sched_barrier(0)
#define GF_SETOFF(u, oA, oB) do { \
        int tz = threadIdx.x; asm volatile("" : "+v"(tz)); \
        int R0, C0, R1, C1; stage_rc(tz * 16, R0, C0); stage_rc(tz * 16 + 8192, R1, C1); \
        const int Rb0 = (R0 & ~31) + perm32(R0 & 31), Rb1 = (R1 & ~31) + perm32(R1 & 31); \
        int g00 = R0, g01 = R1, g10 = HALF + R0, g11 = HALF + R1; \
        if ((u).rowidx) { g00 = (u).rowidx[g00]; g01 = (u).rowidx[g01]; g10 = (u).rowidx[g10]; g11 = (u).rowidx[g11]; } \
        oA[0][0] = (unsigned)g00 * (unsigned)(u).lda + (unsigned)C0 * 2u; oA[0][1] = (unsigned)g01 * (unsigned)(u).lda + (unsigned)C1 * 2u; \
        oA[1][0] = (unsigned)g10 * (unsigned)(u).lda + (unsigned)C0 * 2u; oA[1][1] = (unsigned)g11 * (unsigned)(u).lda + (unsigned)C1 * 2u; \
        oB[0] = (unsigned)Rb0 * (unsigned)(u).ldb + (unsigned)C0 * 2u; oB[1] = (unsigned)Rb1 * (unsigned)(u).ldb + (unsigned)C1 * 2u; } while (0)
    Unit cur, nxt; int ui = 0;
    if (!S.next(0, cur)) return;
    f32x4 acc[2][2][4][2];
#pragma unroll
    for (int a = 0; a < 2; ++a)
#pragma unroll
        for (int b = 0; b < 2; ++b)
#pragma unroll
            for (int m = 0; m < 4; ++m)
#pragma unroll
                for (int n = 0; n < 2; ++n) acc[a][b][m][n] = (f32x4){0.f, 0.f, 0.f, 0.f};
    bf16x8 At[4][2], B0[2][2], B1[2][2];
    unsigned oAc[2][2], oBc[2], oAn[2][2], oBn[2];
    GF_SETOFF(cur, oAc, oBc);
    unsigned cA = cur.A, cB = cur.B, chB = (unsigned)HALF * cur.ldb;
    GF_STAGE(GF_SB(0, 0), cB, oBc[0], oBc[1]); GF_STAGE(GF_SA(0, 0), cA, oAc[0][0], oAc[0][1]); GF_STAGE(GF_SB(0, 1), cB + chB, oBc[0], oBc[1]); GF_STAGE(GF_SA(0, 1), cA, oAc[1][0], oAc[1][1]);
    if (wr == 1) GF_BAR;
    GF_WAIT_V(4); GF_BAR;
    GF_STAGE(GF_SB(1, 0), cB + kstep, oBc[0], oBc[1]); GF_STAGE(GF_SA(1, 0), cA + kstep, oAc[0][0], oAc[0][1]); GF_STAGE(GF_SB(1, 1), cB + chB + kstep, oBc[0], oBc[1]);
    GF_WAIT_V(6); GF_BAR;
    for (;;) {
        const bool has_next = S.next(ui + 1, nxt);
        unsigned nA, nB, nhB;
        if (has_next) { if (GENERAL) GF_SETOFF(nxt, oAn, oBn); nA = nxt.A; nB = nxt.B; nhB = (unsigned)HALF * nxt.ldb; }
        else { if (GENERAL) { oAn[0][0] = oAc[0][0]; oAn[0][1] = oAc[0][1]; oAn[1][0] = oAc[1][0]; oAn[1][1] = oAc[1][1]; oBn[0] = oBc[0]; oBn[1] = oBc[1]; } nA = cA; nB = cB; nhB = chB; }
        const int nt = cur.nt;
        for (int t = 0; t < nt; t += 2) {
            const bool last = (t == nt - 2);
            const unsigned a1 = cA + (unsigned)(t + 1) * kstep;
            const unsigned a2 = last ? nA : cA + (unsigned)(t + 2) * kstep, b2 = last ? nB : cB + (unsigned)(t + 2) * kstep;
            const unsigned a3 = a2 + kstep, b3 = b2 + kstep;
            const unsigned hB2 = last ? nhB : chB;
            const unsigned a2_00 = (GENERAL && last) ? oAn[0][0] : oAc[0][0], a2_01 = (GENERAL && last) ? oAn[0][1] : oAc[0][1], a2_10 = (GENERAL && last) ? oAn[1][0] : oAc[1][0], a2_11 = (GENERAL && last) ? oAn[1][1] : oAc[1][1];
            const unsigned b2_0 = (GENERAL && last) ? oBn[0] : oBc[0], b2_1 = (GENERAL && last) ? oBn[1] : oBc[1];
            GF_LDB(B0, 0, 0); GF_SCHED; GF_LDA(At, 0, 0); GF_STAGE(GF_SA(1, 1), a1, oAc[1][0], oAc[1][1]);
            GF_WAIT_L(8); GF_BAR; GF_WAIT_L(0); GF_MMA(0, 0, At, B0); GF_BAR; GF_SCHED;
            GF_LDB(B1, 0, 1); GF_STAGE(GF_SB(0, 0), b2, b2_0, b2_1);
            GF_BAR; GF_WAIT_L(0); GF_MMA(0, 1, At, B1); GF_BAR;
            GF_LDA(At, 0, 1); GF_STAGE(GF_SA(0, 0), a2, a2_00, a2_01);
            GF_BAR; GF_WAIT_L(0); GF_MMA(1, 0, At, B0); GF_BAR; GF_SCHED;
            GF_STAGE(GF_SB(0, 1), b2 + hB2, b2_0, b2_1);
            GF_WAIT_V(6); GF_BAR; GF_MMA(1, 1, At, B1); GF_BAR;
            GF_LDB(B0, 1, 0); GF_SCHED; GF_LDA(At, 1, 0); GF_STAGE(GF_SA(0, 1), a2, a2_10, a2_11);
            GF_WAIT_L(8); GF_BAR; GF_WAIT_L(0); GF_MMA(0, 0, At, B0); GF_BAR; GF_SCHED;
            GF_LDB(B1, 1, 1); GF_STAGE(GF_SB(1, 0), b3, b2_0, b2_1);
            GF_BAR; GF_WAIT_L(0); GF_MMA(0, 1, At, B1); GF_BAR;
            GF_LDA(At, 1, 1); GF_STAGE(GF_SA(1, 0), a3, a2_00, a2_01);
            GF_BAR; GF_WAIT_L(0); GF_MMA(1, 0, At, B0); GF_BAR; GF_SCHED;
            GF_STAGE(GF_SB(1, 1), b3 + hB2, b2_0, b2_1);
            GF_WAIT_V(6); GF_BAR; GF_MMA(1, 1, At, B1); GF_BAR;
        }
        E(acc, cur, wr, wc, fr, fq);
        if (!has_next) break;
        if (!cur.keep) {
#pragma unroll
            for (int a = 0; a < 2; ++a)
#pragma unroll
                for (int b = 0; b < 2; ++b)
#pragma unroll
                    for (int m = 0; m < 4; ++m)
#pragma unroll
                        for (int n = 0; n < 2; ++n) acc[a][b][m][n] = (f32x4){0.f, 0.f, 0.f, 0.f};
        }
        cur = nxt; cA = nA; cB = nB; chB = nhB; ++ui;
        if (GENERAL) { oAc[0][0] = oAn[0][0]; oAc[0][1] = oAn[0][1]; oAc[1][0] = oAn[1][0]; oAc[1][1] = oAn[1][1]; oBc[0] = oBn[0]; oBc[1] = oBn[1]; }
    }
    GF_WAIT_V(0);
    if (wr == 0) GF_BAR;
    GF_BAR;
#undef GF_SA
#undef GF_SB
#undef GF_STAGE
#undef GF_LDA
#undef GF_LDB
#undef GF_MMA
#undef GF_WAIT_V
#undef GF_WAIT_L
#undef GF_BAR
#undef GF_SCHED
#undef GF_SETOFF
}
}

__device__ __forceinline__ int uload(const int* p) { return __builtin_amdgcn_readfirstlane(__hip_atomic_load(p, __ATOMIC_RELAXED, __HIP_MEMORY_SCOPE_AGENT)); }
__device__ __forceinline__ int vcu_of(int bid, int nb) { return (nb % 8 == 0) ? (bid % 8) * (nb / 8) + bid / 8 : bid; }

struct SchedPlain {
    unsigned A, B; int lda, ldb, nt, nN, nU, G, c; long r0base;
    __device__ __forceinline__ bool next(int i, gf::Unit& u) const {
        const int L = i * G + c; if (L >= nU) return false;
        const int pm = L / nN, pn = L % nN;
        u.A = A + (unsigned)pm * 256u * lda; u.B = B + (unsigned)pn * 256u * ldb; u.rowidx = nullptr; u.lda = lda; u.ldb = ldb; u.nt = nt; u.keep = 0;
        u.kind = 0; u.r0 = (int)(r0base + pm * 256); u.c0 = pn * 256; u.x0 = 0; return true;
    }
};
struct EpiProj { bf16* O; __device__ __forceinline__ void operator()(f32x4 (&acc)[2][2][4][2], const gf::Unit& u, int wr, int wc, int fr, int fq) const { epi_bf16(acc, O, INW, u.r0, u.c0, wr, wc, fr, fq); } };
struct SchedProjPP {
    int G, c;
    __device__ __forceinline__ bool next(int i, gf::Unit& u) const {
        constexpr int nN = INW / 256, nProj = (T / 256) * nN, nPP = (T / 256) * 4;
        const int R = nProj / G, rem = nProj % G;
        u.rowidx = nullptr; u.keep = 0; u.x0 = 0;
        const int L = i * G + c;
        if (i < R || (i == R && c < rem)) { const int pm = L / nN, pn = L % nN;
            u.A = (unsigned)WS_XB + (unsigned)pm * 256u * (D * 2); u.B = (unsigned)WS_WINT + (unsigned)pn * 256u * (D * 2); u.lda = D * 2; u.ldb = D * 2; u.nt = D / 64; u.kind = 0; u.r0 = pm * 256; u.c0 = pn * 256; return true; }
        const int nw = G - rem, per = (nPP + nw - 1) / nw, j = i - R;
        if (c < rem || j >= per) return false;
        const int idx = (c - rem) * per + j; if (idx >= nPP) return false;
        const int pm = idx >> 2, pn = idx & 3;
        u.A = (unsigned)WS_PB + (unsigned)pm * 256u * (PLE * 2); u.B = (unsigned)WS_WPT + (unsigned)pn * 256u * (PLE * 2); u.lda = PLE * 2; u.ldb = PLE * 2; u.nt = PLE / 64; u.kind = 1; u.r0 = pm * 256; u.c0 = pn * 256; return true;
    }
};
struct EpiProjPP { bf16* proj; bf16* pp;
    __device__ __forceinline__ void operator()(f32x4 (&acc)[2][2][4][2], const gf::Unit& u, int wr, int wc, int fr, int fq) const {
        if (u.kind == 0) epi_bf16(acc, proj, INW, u.r0, u.c0, wr, wc, fr, fq); else epi_bf16(acc, pp, D, u.r0, u.c0, wr, wc, fr, fq);
    }
};
__device__ void phase_proj(const Args& a, LAS unsigned char* lds, int bid, int nb) {
    SchedProjPP S{nb, vcu_of(bid, nb)};
    EpiProjPP E{(bf16*)(a.ws + WS_BIG), (bf16*)(a.ws + WS_PP)};
    gf::gemm_fast<true>(lds, a.ws, S, E);
}

struct EpiWout { const float* x; float* y;
    __device__ __forceinline__ void operator()(f32x4 (&acc)[2][2][4][2], const gf::Unit& u, int wr, int wc, int fr, int fq) const {
#pragma unroll
        for (int ai = 0; ai < 2; ++ai)
#pragma unroll
            for (int mp = 0; mp < 2; ++mp) {
                f32x4 xv[2][2][2];
#pragma unroll
                for (int mm = 0; mm < 2; ++mm) { const int m = 2 * mp + mm;
                    const size_t off = (size_t)(u.r0 + 128 * ai + 64 * wr + 16 * m + fr) * D + u.c0 + 32 * wc + 8 * fq;
#pragma unroll
                    for (int bj = 0; bj < 2; ++bj)
#pragma unroll
                        for (int n = 0; n < 2; ++n) xv[mm][bj][n] = *(const f32x4*)(x + off + 128 * bj + 4 * n); }
#pragma unroll
                for (int mm = 0; mm < 2; ++mm) { const int m = 2 * mp + mm;
                    const size_t off = (size_t)(u.r0 + 128 * ai + 64 * wr + 16 * m + fr) * D + u.c0 + 32 * wc + 8 * fq;
#pragma unroll
                    for (int bj = 0; bj < 2; ++bj)
#pragma unroll
                        for (int n = 0; n < 2; ++n) *(f32x4*)(y + off + 128 * bj + 4 * n) = acc[ai][bj][m][n] + ALPHA * xv[mm][bj][n]; }
                asm volatile("" ::: "memory");
            }
    }
};
__device__ void phase_wout(const Args& a, LAS unsigned char* lds, int bid, int nb) {
    SchedPlain S{(unsigned)WS_MIXO, (unsigned)WS_WOUTT, D * 2, D * 2, D / 64, D / 256, (T / 256) * (D / 256), nb, vcu_of(bid, nb), 0};
    EpiWout E{a.in[I_X], a.out};
    gf::gemm_fast<false>(lds, a.ws, S, E);
}

constexpr int QS = 72;
constexpr int TS = 136;
constexpr int TS2 = 264;
constexpr int L_QS = 0;
constexpr int L_KS = L_QS + 128 * QS * 2;
constexpr int L_KTW = L_KS + 256 * QS * 2;
constexpr int L_VT = L_KTW + 64 * TS * 2;
constexpr int L_ST = L_VT + 64 * TS2 * 2;
constexpr int L_MIX_END = L_ST + 64 * QS * 2;
static_assert(L_MIX_END <= 128 * 1024, "mixer LDS");

__device__ __forceinline__ void stage_ret(const Args& a, LAS unsigned char* lds, int b, int h, int n, bool want_q, float l2g) {
    const int tid = hidden_tid();
    const bf16* proj = (const bf16*)(a.ws + WS_BIG);
    const float* tab = (const float*)(a.ws + WS_TAB);
    const float* cosr = tab, *sinr = tab + SEQ * 32;
    LAS bf16* Qs = (LAS bf16*)(lds + L_QS); LAS bf16* Ks = (LAS bf16*)(lds + L_KS); LAS bf16* Ktw = (LAS bf16*)(lds + L_KTW); LAS bf16* Vt = (LAS bf16*)(lds + L_VT);
    const int row = tid >> 2, i0 = (tid & 3) * 8;
    const int pos = n * CH + row;
    const size_t t = (size_t)b * SEQ + pos;
    const bf16* prow = proj + t * INW;
    f32x4 c0 = *(const f32x4*)(cosr + pos * 32 + i0), c1 = *(const f32x4*)(cosr + pos * 32 + i0 + 4);
    f32x4 s0 = *(const f32x4*)(sinr + pos * 32 + i0), s1 = *(const f32x4*)(sinr + pos * 32 + i0 + 4);
    float cs[8] = {c0[0], c0[1], c0[2], c0[3], c1[0], c1[1], c1[2], c1[3]}, sn[8] = {s0[0], s0[1], s0[2], s0[3], s1[0], s1[1], s1[2], s1[3]};
    if (want_q) {
        const bf16x8 x1 = *(const bf16x8*)(prow + C_RQ + h * 64 + i0), x2 = *(const bf16x8*)(prow + C_RQ + h * 64 + 32 + i0);
        float o1[8], o2[8];
#pragma unroll
        for (int j = 0; j < 8; ++j) { const float a1 = bf2f((unsigned short)x1[j]), a2 = bf2f((unsigned short)x2[j]); o1[j] = a1 * cs[j] - a2 * sn[j]; o2[j] = a2 * cs[j] + a1 * sn[j]; }
        u32x4 w1, w2;
        w1.x = cvt_pk_bf16(o1[0], o1[1]); w1.y = cvt_pk_bf16(o1[2], o1[3]); w1.z = cvt_pk_bf16(o1[4], o1[5]); w1.w = cvt_pk_bf16(o1[6], o1[7]);
        w2.x = cvt_pk_bf16(o2[0], o2[1]); w2.y = cvt_pk_bf16(o2[2], o2[3]); w2.z = cvt_pk_bf16(o2[4], o2[5]); w2.w = cvt_pk_bf16(o2[6], o2[7]);
        *(LAS u32x4*)(Qs + row * QS + i0) = w1; *(LAS u32x4*)(Qs + row * QS + 32 + i0) = w2;
    }
    {
        const bf16x8 x1 = *(const bf16x8*)(prow + C_RK + h * 64 + i0), x2 = *(const bf16x8*)(prow + C_RK + h * 64 + 32 + i0);
        const float kw = exp2f((float)(CH - 1 - row) * l2g);
        float o1[8], o2[8];
#pragma unroll
        for (int j = 0; j < 8; ++j) { const float a1 = bf2f((unsigned short)x1[j]), a2 = bf2f((unsigned short)x2[j]); o1[j] = (a1 * cs[j] - a2 * sn[j]) * 0.125f; o2[j] = (a2 * cs[j] + a1 * sn[j]) * 0.125f; }
        if (want_q) {
            u32x4 w1, w2;
            w1.x = cvt_pk_bf16(o1[0], o1[1]); w1.y = cvt_pk_bf16(o1[2], o1[3]); w1.z = cvt_pk_bf16(o1[4], o1[5]); w1.w = cvt_pk_bf16(o1[6], o1[7]);
            w2.x = cvt_pk_bf16(o2[0], o2[1]); w2.y = cvt_pk_bf16(o2[2], o2[3]); w2.z = cvt_pk_bf16(o2[4], o2[5]); w2.w = cvt_pk_bf16(o2[6], o2[7]);
            *(LAS u32x4*)(Ks + row * QS + i0) = w1; *(LAS u32x4*)(Ks + row * QS + 32 + i0) = w2;
        }
#pragma unroll
        for (int j = 0; j < 8; ++j) { Ktw[(i0 + j) * TS + row] = f2bf(o1[j] * kw); Ktw[(32 + i0 + j) * TS + row] = f2bf(o2[j] * kw); }
    }
    {
        const bf16x8 v1 = *(const bf16x8*)(prow + C_RV + h * 64 + i0), v2 = *(const bf16x8*)(prow + C_RV + h * 64 + 32 + i0);
#pragma unroll
        for (int j = 0; j < 8; ++j) { Vt[(i0 + j) * TS2 + row] = (bf16)v1[j]; Vt[(32 + i0 + j) * TS2 + row] = (bf16)v2[j]; }
    }
}
__device__ __forceinline__ void ret_kv(LAS unsigned char* lds, int wid, int fr, int fq, f32x4 (&kv)[2]) {
    LAS bf16* Ktw = (LAS bf16*)(lds + L_KTW); LAS bf16* Vt = (LAS bf16*)(lds + L_VT);
#pragma unroll
    for (int i = 0; i < 2; ++i) {
        const int tl = 2 * wid + i, dt = tl >> 2, et = tl & 3;
        f32x4 c = {0.f, 0.f, 0.f, 0.f};
#pragma unroll
        for (int ks = 0; ks < 4; ++ks) {
            const bf16x8 kf = *(const LAS bf16x8*)(Ktw + (16 * dt + fr) * TS + 32 * ks + 8 * fq);
            const bf16x8 vf = *(const LAS bf16x8*)(Vt + (16 * et + fr) * TS2 + 32 * ks + 8 * fq);
            c = __builtin_amdgcn_mfma_f32_16x16x32_bf16(kf, vf, c, 0, 0, 0);
        }
        kv[i] = c;
    }
}
__device__ __forceinline__ float head_l2g(int h) { return log2f(1.0f - exp2f(-5.0f - (float)h)); }

__device__ void phase_segtot(const Args& a, LAS unsigned char* lds, int bid, int nb) {
    WAVE_IDS();
    float* segt = (float*)(a.ws + WS_SEGT);
    for (int it = bid; it < BATCH * RH * NSEG; it += nb) {
        const int seg = it % NSEG, h = (it / NSEG) % RH, b = it / (NSEG * RH);
        const float l2g = head_l2g(h), cd = exp2f(128.0f * l2g);
        f32x4 S[2] = {{0.f, 0.f, 0.f, 0.f}, {0.f, 0.f, 0.f, 0.f}};
        for (int c = 0; c < SEGC; ++c) {
            __syncthreads();
            stage_ret(a, lds, b, h, seg * SEGC + c, false, l2g);
            __syncthreads();
            f32x4 kv[2]; ret_kv(lds, wid, fr, fq, kv);
            S[0] = S[0] * cd + kv[0]; S[1] = S[1] * cd + kv[1];
        }
        float* dst = segt + (size_t)((b * RH + h) * NSEG + seg) * 4096;
#pragma unroll
        for (int i = 0; i < 2; ++i) { const int tl = 2 * wid + i, dt = tl >> 2, et = tl & 3;
#pragma unroll
            for (int j = 0; j < 4; ++j) dst[(16 * dt + 4 * fq + j) * 64 + 16 * et + fr] = S[i][j]; }
    }
}

__device__ void phase_retention(const Args& a, LAS unsigned char* lds, int bid, int nb) {
    WAVE_IDS();
    const float* segt = (const float*)(a.ws + WS_SEGT);
    const bf16* proj = (const bf16*)(a.ws + WS_BIG);
    bf16* mixo = (bf16*)(a.ws + WS_MIXO);
    const float* gain = a.in[I_GN];
    LAS bf16* Qs = (LAS bf16*)(lds + L_QS); LAS bf16* Ks = (LAS bf16*)(lds + L_KS); LAS bf16* Vt = (LAS bf16*)(lds + L_VT); LAS bf16* St = (LAS bf16*)(lds + L_ST);
    for (int it = bid; it < BATCH * RH * NSEG; it += nb) {
        const int seg = it % NSEG, h = (it / NSEG) % RH, b = it / (NSEG * RH);
        const float l2g = head_l2g(h), cd = exp2f(128.0f * l2g);
        f32x4 S[2] = {{0.f, 0.f, 0.f, 0.f}, {0.f, 0.f, 0.f, 0.f}};
        for (int sp = 0; sp < seg; ++sp) {
            const float wgt = exp2f(128.0f * l2g * (float)(SEGC * (seg - 1 - sp)));
            const float* src = segt + (size_t)((b * RH + h) * NSEG + sp) * 4096;
#pragma unroll
            for (int i = 0; i < 2; ++i) { const int tl = 2 * wid + i, dt = tl >> 2, et = tl & 3;
#pragma unroll
                for (int j = 0; j < 4; ++j) S[i][j] += wgt * src[(16 * dt + 4 * fq + j) * 64 + 16 * et + fr]; }
        }
        for (int c = 0; c < SEGC; ++c) {
            const int n = seg * SEGC + c;
            __syncthreads();
            stage_ret(a, lds, b, h, n, true, l2g);
#pragma unroll
            for (int i = 0; i < 2; ++i) { const int tl = 2 * wid + i, dt = tl >> 2, et = tl & 3;
                u32x2 w; w.x = cvt_pk_bf16(S[i][0], S[i][1]); w.y = cvt_pk_bf16(S[i][2], S[i][3]);
                *(LAS u32x2*)(St + (16 * et + fr) * QS + 16 * dt + 4 * fq) = w; }
            __syncthreads();
            bf16x8 qf[2];
#pragma unroll
            for (int ks = 0; ks < 2; ++ks) qf[ks] = *(const LAS bf16x8*)(Qs + (16 * wid + fr) * QS + 32 * ks + 8 * fq);
            f32x4 sc[8];
#pragma unroll
            for (int jt = 0; jt < 8; ++jt) {
                sc[jt] = (f32x4){0.f, 0.f, 0.f, 0.f};
                if (jt <= wid) {
#pragma unroll
                    for (int ks = 0; ks < 2; ++ks) {
                        const bf16x8 kf = *(const LAS bf16x8*)(Ks + (16 * jt + fr) * QS + 32 * ks + 8 * fq);
                        sc[jt] = __builtin_amdgcn_mfma_f32_16x16x32_bf16(kf, qf[ks], sc[jt], 0, 0, 0);
                    }
                    const int i = 16 * wid + fr;
#pragma unroll
                    for (int r = 0; r < 4; ++r) { const int j = 16 * jt + 4 * fq + r; const float dcy = exp2f((float)(i - j) * l2g); sc[jt][r] = (i >= j) ? sc[jt][r] * dcy : 0.f; }
                    asm volatile("" : "+v"(sc[jt]) :: "memory");
                }
            }
            f32x4 o[4], oi[4];
#pragma unroll
            for (int et = 0; et < 4; ++et) { o[et] = (f32x4){0.f, 0.f, 0.f, 0.f}; oi[et] = (f32x4){0.f, 0.f, 0.f, 0.f}; }
#pragma unroll
            for (int k2 = 0; k2 < 4; ++k2) {
                if (2 * k2 <= wid) {
                    bf16x8 pf; u32x4 pw;
                    pw.x = cvt_pk_bf16(sc[2 * k2][0], sc[2 * k2][1]); pw.y = cvt_pk_bf16(sc[2 * k2][2], sc[2 * k2][3]);
                    pw.z = cvt_pk_bf16(sc[2 * k2 + 1][0], sc[2 * k2 + 1][1]); pw.w = cvt_pk_bf16(sc[2 * k2 + 1][2], sc[2 * k2 + 1][3]);
                    pf = __builtin_bit_cast(bf16x8, pw);
#pragma unroll
                    for (int et = 0; et < 4; ++et) {
                        const u32x2 va = *(const LAS u32x2*)(Vt + (16 * et + fr) * TS2 + 32 * k2 + 4 * fq);
                        const u32x2 vb = *(const LAS u32x2*)(Vt + (16 * et + fr) * TS2 + 32 * k2 + 16 + 4 * fq);
                        u32x4 vw; vw.x = va.x; vw.y = va.y; vw.z = vb.x; vw.w = vb.y;
                        o[et] = __builtin_amdgcn_mfma_f32_16x16x32_bf16(__builtin_bit_cast(bf16x8, vw), pf, o[et], 0, 0, 0);
                    }
                }
            }
#pragma unroll
            for (int et = 0; et < 4; ++et)
#pragma unroll
                for (int ks = 0; ks < 2; ++ks) {
                    const bf16x8 sf = *(const LAS bf16x8*)(St + (16 * et + fr) * QS + 32 * ks + 8 * fq);
                    oi[et] = __builtin_amdgcn_mfma_f32_16x16x32_bf16(sf, qf[ks], oi[et], 0, 0, 0);
                }
            {
                const int i = 16 * wid + fr;
                const float qw = exp2f((float)(i + 1) * l2g);
                float sum = 0.f;
#pragma unroll
                for (int et = 0; et < 4; ++et)
#pragma unroll
                    for (int r = 0; r < 4; ++r) { o[et][r] += qw * oi[et][r]; sum += o[et][r]; }
                sum += __shfl_xor(sum, 16); sum += __shfl_xor(sum, 32);
                const float mean = sum * (1.0f / 64.0f);
                float q = 0.f;
#pragma unroll
                for (int et = 0; et < 4; ++et)
#pragma unroll
                    for (int r = 0; r < 4; ++r) { const float d = o[et][r] - mean; q += d * d; }
                q += __shfl_xor(q, 16); q += __shfl_xor(q, 32);
                const float rstd = rsqrtf(q * (1.0f / 64.0f) + GN_EPS);
                const size_t t = (size_t)b * SEQ + n * CH + i;
#pragma unroll
                for (int et = 0; et < 4; ++et) {
                    const int e0 = 16 * et + 4 * fq;
                    const u32x2 gw = *(const u32x2*)(proj + t * INW + C_RG + h * 64 + e0);
                    const f32x4 gn = *(const f32x4*)(gain + h * 64 + e0);
                    const float g0 = bf2f(gw.x & 0xffffu), g1 = bf2f(gw.x >> 16), g2 = bf2f(gw.y & 0xffffu), g3 = bf2f(gw.y >> 16);
                    const float y0 = (o[et][0] - mean) * rstd * gn[0] * siluf_(g0), y1 = (o[et][1] - mean) * rstd * gn[1] * siluf_(g1);
                    const float y2 = (o[et][2] - mean) * rstd * gn[2] * siluf_(g2), y3 = (o[et][3] - mean) * rstd * gn[3] * siluf_(g3);
                    u32x2 w; w.x = cvt_pk_bf16(y0, y1); w.y = cvt_pk_bf16(y2, y3);
                    *(u32x2*)(mixo + t * D + h * 64 + e0) = w;
                }
            }
            f32x4 kv[2]; ret_kv(lds, wid, fr, fq, kv);
            S[0] = S[0] * cd + kv[0]; S[1] = S[1] * cd + kv[1];
        }
    }
}

__device__ void phase_swa(const Args& a, LAS unsigned char* lds, int bid, int nb) {
    WAVE_IDS();
    const bf16* proj = (const bf16*)(a.ws + WS_BIG);
    bf16* mixo = (bf16*)(a.ws + WS_MIXO);
    const float* tab = (const float*)(a.ws + WS_TAB);
    const float* coss = tab + SEQ * 64, *sins = tab + SEQ * 72;
    const float* ascale = a.in[I_ASC]; const float* sinks = a.in[I_SINK];
    LAS bf16* Qs = (LAS bf16*)(lds + L_QS); LAS bf16* Ks = (LAS bf16*)(lds + L_KS); LAS bf16* Vt = (LAS bf16*)(lds + L_VT);
    for (int it = bid; it < BATCH * NCH * QH; it += nb) {
        const int qh = it % QH, n = (it / QH) % NCH, b = it / (QH * NCH), kvh = qh >> 2;
        __syncthreads();
        {
            const int row = tid >> 2, cg = tid & 3, pos = n * CH + row;
            const bf16* src = proj + ((size_t)b * SEQ + pos) * INW + C_AQ + qh * 64 + cg * 16;
            bf16x8 x1 = *(const bf16x8*)src, x2 = *(const bf16x8*)(src + 8);
            if (cg == 0) {
                const f32x4 c0 = *(const f32x4*)(coss + pos * 8), c1 = *(const f32x4*)(coss + pos * 8 + 4), s0 = *(const f32x4*)(sins + pos * 8), s1 = *(const f32x4*)(sins + pos * 8 + 4);
                const float cs[8] = {c0[0], c0[1], c0[2], c0[3], c1[0], c1[1], c1[2], c1[3]}, sn[8] = {s0[0], s0[1], s0[2], s0[3], s1[0], s1[1], s1[2], s1[3]};
                float o1[8], o2[8];
#pragma unroll
                for (int j = 0; j < 8; ++j) { const float a1 = bf2f((unsigned short)x1[j]), a2 = bf2f((unsigned short)x2[j]); o1[j] = a1 * cs[j] - a2 * sn[j]; o2[j] = a2 * cs[j] + a1 * sn[j]; }
                u32x4 w1, w2;
                w1.x = cvt_pk_bf16(o1[0], o1[1]); w1.y = cvt_pk_bf16(o1[2], o1[3]); w1.z = cvt_pk_bf16(o1[4], o1[5]); w1.w = cvt_pk_bf16(o1[6], o1[7]);
                w2.x = cvt_pk_bf16(o2[0], o2[1]); w2.y = cvt_pk_bf16(o2[2], o2[3]); w2.z = cvt_pk_bf16(o2[4], o2[5]); w2.w = cvt_pk_bf16(o2[6], o2[7]);
                x1 = __builtin_bit_cast(bf16x8, w1); x2 = __builtin_bit_cast(bf16x8, w2);
            }
            *(LAS bf16x8*)(Qs + row * QS + cg * 16) = x1; *(LAS bf16x8*)(Qs + row * QS + cg * 16 + 8) = x2;
        }
#pragma unroll
        for (int rep = 0; rep < 2; ++rep) {
            const int q = tid + rep * NTHREADS, kj = q >> 2, cg = q & 3, pos = n * CH - CH + kj;
            bf16x8 k1 = {0, 0, 0, 0, 0, 0, 0, 0}, k2 = k1, v1 = k1, v2 = k1;
            if (pos >= 0) {
                const bf16* srow = proj + ((size_t)b * SEQ + pos) * INW;
                k1 = *(const bf16x8*)(srow + C_AK + kvh * 64 + cg * 16); k2 = *(const bf16x8*)(srow + C_AK + kvh * 64 + cg * 16 + 8);
                v1 = *(const bf16x8*)(srow + C_AV + kvh * 64 + cg * 16); v2 = *(const bf16x8*)(srow + C_AV + kvh * 64 + cg * 16 + 8);
                if (cg == 0) {
                    const f32x4 c0 = *(const f32x4*)(coss + pos * 8), c1 = *(const f32x4*)(coss + pos * 8 + 4), s0 = *(const f32x4*)(sins + pos * 8), s1 = *(const f32x4*)(sins + pos * 8 + 4);
                    const float cs[8] = {c0[0], c0[1], c0[2], c0[3], c1[0], c1[1], c1[2], c1[3]}, sn[8] = {s0[0], s0[1], s0[2], s0[3], s1[0], s1[1], s1[2], s1[3]};
                    float o1[8], o2[8];
#pragma unroll
                    for (int j = 0; j < 8; ++j) { const float a1 = bf2f((unsigned short)k1[j]), a2 = bf2f((unsigned short)k2[j]); o1[j] = a1 * cs[j] - a2 * sn[j]; o2[j] = a2 * cs[j] + a1 * sn[j]; }
                    u32x4 w1, w2;
                    w1.x = cvt_pk_bf16(o1[0], o1[1]); w1.y = cvt_pk_bf16(o1[2], o1[3]); w1.z = cvt_pk_bf16(o1[4], o1[5]); w1.w = cvt_pk_bf16(o1[6], o1[7]);
                    w2.x = cvt_pk_bf16(o2[0], o2[1]); w2.y = cvt_pk_bf16(o2[2], o2[3]); w2.z = cvt_pk_bf16(o2[4], o2[5]); w2.w = cvt_pk_bf16(o2[6], o2[7]);
                    k1 = __builtin_bit_cast(bf16x8, w1); k2 = __builtin_bit_cast(bf16x8, w2);
                }
            }
            *(LAS bf16x8*)(Ks + kj * QS + cg * 16) = k1; *(LAS bf16x8*)(Ks + kj * QS + cg * 16 + 8) = k2;
#pragma unroll
            for (int j = 0; j < 8; ++j) { Vt[(cg * 16 + j) * TS2 + kj] = (bf16)v1[j]; Vt[(cg * 16 + 8 + j) * TS2 + kj] = (bf16)v2[j]; }
        }
        __syncthreads();
        const int jt0 = wid & ~1;
        bf16x8 qf[2];
#pragma unroll
        for (int ks = 0; ks < 2; ++ks) qf[ks] = *(const LAS bf16x8*)(Qs + (16 * wid + fr) * QS + 32 * ks + 8 * fq);
        f32x4 sc[10];
        const int i = 16 * wid + fr;
        float mx = sinks[qh];
#pragma unroll
        for (int tt = 0; tt < 10; ++tt) {
            const int jt = jt0 + tt;
            f32x4 c = {0.f, 0.f, 0.f, 0.f};
#pragma unroll
            for (int ks = 0; ks < 2; ++ks) {
                const bf16x8 kf = *(const LAS bf16x8*)(Ks + (16 * jt + fr) * QS + 32 * ks + 8 * fq);
                c = __builtin_amdgcn_mfma_f32_16x16x32_bf16(kf, qf[ks], c, 0, 0, 0);
            }
#pragma unroll
            for (int r = 0; r < 4; ++r) {
                const int kj = 16 * jt + 4 * fq + r;
                const bool valid = (kj > i) && (kj <= i + CH) && (n * CH - CH + kj >= 0);
                c[r] = valid ? c[r] * 0.125f : -1e30f;
                mx = fmaxf(mx, c[r]);
            }
            sc[tt] = c;
        }
        mx = fmaxf(mx, __shfl_xor(mx, 16)); mx = fmaxf(mx, __shfl_xor(mx, 32));
        float den = 0.f;
#pragma unroll
        for (int tt = 0; tt < 10; ++tt)
#pragma unroll
            for (int r = 0; r < 4; ++r) { const float p = (sc[tt][r] > -1e29f) ? __expf(sc[tt][r] - mx) : 0.f; sc[tt][r] = p; den += p; }
        den += __shfl_xor(den, 16); den += __shfl_xor(den, 32);
        den += __expf(sinks[qh] - mx);
        const float inv = 1.0f / den;
        f32x4 o[4];
#pragma unroll
        for (int et = 0; et < 4; ++et) o[et] = (f32x4){0.f, 0.f, 0.f, 0.f};
#pragma unroll
        for (int k2 = 0; k2 < 5; ++k2) {
            u32x4 pw;
            pw.x = cvt_pk_bf16(sc[2 * k2][0] * inv, sc[2 * k2][1] * inv); pw.y = cvt_pk_bf16(sc[2 * k2][2] * inv, sc[2 * k2][3] * inv);
            pw.z = cvt_pk_bf16(sc[2 * k2 + 1][0] * inv, sc[2 * k2 + 1][1] * inv); pw.w = cvt_pk_bf16(sc[2 * k2 + 1][2] * inv, sc[2 * k2 + 1][3] * inv);
            const bf16x8 pf = __builtin_bit_cast(bf16x8, pw);
            const int kb = 16 * (jt0 + 2 * k2);
#pragma unroll
            for (int et = 0; et < 4; ++et) {
                const u32x2 va = *(const LAS u32x2*)(Vt + (16 * et + fr) * TS2 + kb + 4 * fq);
                const u32x2 vb = *(const LAS u32x2*)(Vt + (16 * et + fr) * TS2 + kb + 16 + 4 * fq);
                u32x4 vw; vw.x = va.x; vw.y = va.y; vw.z = vb.x; vw.w = vb.y;
                o[et] = __builtin_amdgcn_mfma_f32_16x16x32_bf16(__builtin_bit_cast(bf16x8, vw), pf, o[et], 0, 0, 0);
            }
        }
        const size_t t = (size_t)b * SEQ + n * CH + i;
#pragma unroll
        for (int et = 0; et < 4; ++et) {
            const int e0 = 16 * et + 4 * fq;
            const f32x4 as = *(const f32x4*)(ascale + qh * 64 + e0);
            u32x2 w; w.x = cvt_pk_bf16(o[et][0] * as[0], o[et][1] * as[1]); w.y = cvt_pk_bf16(o[et][2] * as[2], o[et][3] * as[3]);
            *(u32x2*)(mixo + t * D + 512 + qh * 64 + e0) = w;
        }
    }
}

template <int MODE>
__device__ void phase_ln(const float* src, const float* g, const float* bta, bf16* dstb, float* dstf, int bid, int nb) {
    const int tid = hidden_tid(), wid = tid >> 6, lane = tid & 63;
    f32x4 gv[4], bv[4];
#pragma unroll
    for (int i = 0; i < 4; ++i) { gv[i] = *(const f32x4*)(g + 256 * i + lane * 4); bv[i] = *(const f32x4*)(bta + 256 * i + lane * 4); }
    for (int row = bid * 8 + wid; row < T; row += nb * 8) {
        const float* r = src + (size_t)row * D;
        f32x4 v[4]; float s = 0.f;
#pragma unroll
        for (int i = 0; i < 4; ++i) { v[i] = *(const f32x4*)(r + 256 * i + lane * 4); s += (v[i][0] + v[i][1]) + (v[i][2] + v[i][3]); }
#pragma unroll
        for (int o = 32; o >= 1; o >>= 1) s += __shfl_xor(s, o);
        const float mean = s * (1.0f / D);
        float q = 0.f;
#pragma unroll
        for (int i = 0; i < 4; ++i) { const f32x4 d = v[i] - mean; q += (d[0] * d[0] + d[1] * d[1]) + (d[2] * d[2] + d[3] * d[3]); }
#pragma unroll
        for (int o = 32; o >= 1; o >>= 1) q += __shfl_xor(q, o);
        const float rstd = rsqrtf(q * (1.0f / D) + LN_EPS);
#pragma unroll
        for (int i = 0; i < 4; ++i) {
            const f32x4 y = (v[i] - mean) * rstd * gv[i] + bv[i];
            if (MODE == 0) { u32x2 w; w.x = cvt_pk_bf16(y[0], y[1]); w.y = cvt_pk_bf16(y[2], y[3]); *(u32x2*)(dstb + (size_t)row * D + 256 * i + lane * 4) = w; }
            else *(f32x4*)(dstf + (size_t)row * D + 256 * i + lane * 4) = y;
        }
    }
}

__device__ void phase_router(const Args& a, LAS unsigned char* lds, int bid, int nb) {
    WAVE_IDS();
    const bf16* x1b = (const bf16*)(a.ws + WS_XB); const bf16* wrt = (const bf16*)(a.ws + WS_WRT);
    unsigned char* ro = a.ws + WS_ROUT;
    int* ridx = (int*)(ro + RO_RIDX); float* rw = (float*)(ro + RO_RW); int* cnt = (int*)(ro + RO_CNT);
    const float* rbias = a.in[I_RB];
    LAS float* lg = (LAS float*)lds;
    LAS float* bi = lg + 128 * 65;
    LAS int* hist = (LAS int*)(bi + 128 * 65);
    for (int u = bid; u < T / 128; u += nb) {
        __syncthreads();
        if (tid < 64) hist[tid] = 0;
        {
            f32x4 c[4];
#pragma unroll
            for (int et = 0; et < 4; ++et) c[et] = (f32x4){0.f, 0.f, 0.f, 0.f};
            const bf16* xa = x1b + (size_t)(u * 128 + 16 * wid + fr) * D + 8 * fq;
#pragma unroll 4
            for (int k0 = 0; k0 < D; k0 += 32) {
                const bf16x8 xf = *(const bf16x8*)(xa + k0);
#pragma unroll
                for (int et = 0; et < 4; ++et) {
                    const bf16x8 wf = *(const bf16x8*)(wrt + (size_t)(16 * et + fr) * D + k0 + 8 * fq);
                    c[et] = __builtin_amdgcn_mfma_f32_16x16x32_bf16(wf, xf, c[et], 0, 0, 0);
                }
            }
#pragma unroll
            for (int et = 0; et < 4; ++et)
#pragma unroll
                for (int r = 0; r < 4; ++r) {
                    const int e = 16 * et + 4 * fq + r; const float s = sigmoidf_(c[et][r]);
                    lg[(16 * wid + fr) * 65 + e] = s; bi[(16 * wid + fr) * 65 + e] = s + rbias[e];
                }
        }
        __syncthreads();
        if (tid < 128) {
            const LAS float* mb = bi + tid * 65; const LAS float* ms = lg + tid * 65;
            float gs[8];
#pragma unroll
            for (int g = 0; g < 8; ++g) {
                float m1 = -3e38f, m2 = -3e38f;
#pragma unroll
                for (int j = 0; j < 8; ++j) { const float v = mb[g * 8 + j]; if (v > m1) { m2 = m1; m1 = v; } else if (v > m2) m2 = v; }
                gs[g] = m1 + m2;
            }
            unsigned gmask = 0;
#pragma unroll
            for (int rnd = 0; rnd < 4; ++rnd) {
                float best = -3e38f; int bg = 0;
#pragma unroll
                for (int g = 0; g < 8; ++g) { const bool ok = !((gmask >> g) & 1u) && gs[g] > best; best = ok ? gs[g] : best; bg = ok ? g : bg; }
                gmask |= 1u << bg;
            }
            unsigned long long taken = 0ull;
            int sel[8]; float wsel[8]; float wsum = 0.f;
#pragma unroll
            for (int rnd = 0; rnd < 8; ++rnd) {
                float best = -3e38f; int be = 0;
#pragma unroll 1
                for (int e = 0; e < 64; ++e) {
                    const bool ok = ((gmask >> (e >> 3)) & 1u) && !((taken >> e) & 1ull);
                    const float v = mb[e];
                    if (ok && v > best) { best = v; be = e; }
                }
                taken |= 1ull << be;
                sel[rnd] = be; wsel[rnd] = ms[be]; wsum += wsel[rnd];
            }
            const float sc = ROUTED_SCALE / wsum;
            const size_t t = (size_t)u * 128 + tid;
#pragma unroll
            for (int k = 0; k < 8; ++k) { ridx[t * 8 + k] = sel[k]; rw[t * 8 + k] = wsel[k] * sc; __hip_atomic_fetch_add(&hist[sel[k]], 1, __ATOMIC_RELAXED, __HIP_MEMORY_SCOPE_WORKGROUP); }
        }
        __syncthreads();
        if (tid < 64) cnt[u * 64 + tid] = hist[tid];
    }
}

__device__ void phase_sort(const Args& a, LAS unsigned char* lds, int bid, int nb) {
    const int tid = hidden_tid();
    unsigned char* ro = a.ws + WS_ROUT;
    const int* ridx = (const int*)(ro + RO_RIDX); const float* rw = (const float*)(ro + RO_RW); const int* cnt = (const int*)(ro + RO_CNT);
    int* stok = (int*)(ro + RO_STOK); int* dest = (int*)(ro + RO_DEST); float* rsc = (float*)(ro + RO_RSC); int* tile = (int*)(ro + RO_TILE);
    LAS int* tot = (LAS int*)lds; LAS int* pos0 = tot + 64; LAS int* lcnt = pos0 + 64; LAS int* base = lcnt + 64;
    constexpr int UPC = TC / 128;
    for (int u = bid; u < T / 128; u += nb) {
        const int c = u / UPC, ul = u % UPC;
        __syncthreads();
        if (tid < 64) {
            int tt = 0, pre = 0;
            for (int q = 0; q < UPC; ++q) { const int v = cnt[(c * UPC + q) * 64 + tid]; tt += v; pre += (q < ul) ? v : 0; }
            tot[tid] = tt; pos0[tid] = pre; lcnt[tid] = 0;
        }
        __syncthreads();
        if (tid == 0) { int acc = 0; for (int e = 0; e < 64; ++e) { base[e] = acc; acc += (tot[e] + 255) & ~255; } base[64] = acc; }
        __syncthreads();
        int* stok_c = stok + (size_t)c * RMAX; int* dest_c = dest + (size_t)c * RMAX; float* rsc_c = rsc + (size_t)c * RMAX;
#pragma unroll
        for (int rep = 0; rep < 2; ++rep) {
            const int pr = tid + rep * NTHREADS, tl = pr >> 3, k = pr & 7;
            const size_t t = (size_t)u * 128 + tl;
            const int e = ridx[t * 8 + k];
            const int rank = __hip_atomic_fetch_add(&lcnt[e], 1, __ATOMIC_RELAXED, __HIP_MEMORY_SCOPE_WORKGROUP);
            const int pos = base[e] + pos0[e] + rank;
            stok_c[pos] = (int)t; dest_c[pos] = (int)(t - (size_t)c * TC) * 8 + k; rsc_c[pos] = rw[t * 8 + k];
        }
        if (ul < 64) {
            const int e = ul, lo = base[e] + tot[e], hi = base[e + 1];
            for (int r = lo + tid; r < hi; r += NTHREADS) { stok_c[r] = c * TC; dest_c[r] = TC * 8; rsc_c[r] = 0.f; }
        }
        if (ul == 0) {
            const int ntl = base[64] / 256;
            for (int mt = tid; mt < ntl; mt += NTHREADS) { int e = 0; for (int q = 1; q < 64; ++q) e = (base[q] <= mt * 256) ? q : e; tile[c * TILE_STRIDE + mt] = e; }
            if (tid == 0) tile[c * TILE_STRIDE + TILE_STRIDE - 1] = ntl;
        }
    }
}

struct SchedShared {
    int G, c;
    __device__ __forceinline__ bool next(int i, gf::Unit& u) const {
        constexpr int nU1 = (T / 256) * 2;
        const int L = i * G + c; if (L >= nU1) return false;
        u.rowidx = nullptr; u.keep = 0; u.x0 = 0;
        const int pm = L >> 1, pn = L & 1; u.A = (unsigned)WS_XB + (unsigned)pm * 256u * (D * 2); u.B = (unsigned)WS_WS13T + (unsigned)pn * 256u * (D * 2); u.lda = D * 2; u.ldb = D * 2; u.nt = D / 64; u.kind = 0; u.r0 = pm * 256; u.c0 = pn * 128;
        return true;
    }
};
struct EpiShared { bf16* hs;
    __device__ __forceinline__ void operator()(f32x4 (&acc)[2][2][4][2], const gf::Unit& u, int wr, int wc, int fr, int fq) const { epi_gate(acc, hs, SDIM, u.r0, u.c0, wr, wc, fr, fq); }
};
__device__ void phase_shared(const Args& a, LAS unsigned char* lds, int bid, int nb) {
    SchedShared S{nb, vcu_of(bid, nb)};
    EpiShared E{(bf16*)(a.ws + WS_HS)};
    gf::gemm_fast<false>(lds, a.ws, S, E);
}

struct SchedBase {
    int G, c;
    __device__ __forceinline__ bool next(int i, gf::Unit& u) const {
        constexpr int nU = (T / 256) * 4;
        const int v = (i >> 1) * G + c, part = i & 1; if (v >= nU) return false;
        const int pm = v >> 2, pn = v & 3;
        u.rowidx = nullptr; u.x0 = 0; u.r0 = pm * 256; u.c0 = pn * 256; u.kind = part; u.keep = 1 - part;
        if (part == 0) { u.A = (unsigned)WS_XB + (unsigned)pm * 256u * (D * 2); u.B = (unsigned)WS_WGT + (unsigned)pn * 256u * (D * 2); u.lda = D * 2; u.ldb = D * 2; u.nt = D / 64; }
        else { u.A = (unsigned)WS_HS + (unsigned)pm * 256u * (SDIM * 2); u.B = (unsigned)WS_WS2T + (unsigned)pn * 256u * (SDIM * 2); u.lda = SDIM * 2; u.ldb = SDIM * 2; u.nt = SDIM / 64; }
        return true;
    }
};
struct EpiBase { const bf16* x1b; const bf16* pp; const float* bg; float* y;
    __device__ __forceinline__ void operator()(f32x4 (&acc)[2][2][4][2], const gf::Unit& u, int wr, int wc, int fr, int fq) const {
        if (u.kind == 0) {
            f32x4 bgv[2][2];
#pragma unroll
            for (int bj = 0; bj < 2; ++bj) { const int col = u.c0 + 128 * bj + 32 * wc + 8 * fq; bgv[bj][0] = *(const f32x4*)(bg + col); bgv[bj][1] = *(const f32x4*)(bg + col + 4); }
#pragma unroll
            for (int ai = 0; ai < 2; ++ai) {
                u32x4 pw[4][2], xw[4][2];
#pragma unroll
                for (int m = 0; m < 4; ++m) {
                    const size_t t = (size_t)(u.r0 + 128 * ai + 64 * wr + 16 * m + fr);
#pragma unroll
                    for (int bj = 0; bj < 2; ++bj) { const int col = u.c0 + 128 * bj + 32 * wc + 8 * fq; pw[m][bj] = *(const u32x4*)(pp + t * D + col); xw[m][bj] = *(const u32x4*)(x1b + t * D + col); }
                }
#pragma unroll
                for (int m = 0; m < 4; ++m)
#pragma unroll
                    for (int bj = 0; bj < 2; ++bj) {
                        const unsigned pws[4] = {pw[m][bj].x, pw[m][bj].y, pw[m][bj].z, pw[m][bj].w}, xws[4] = {xw[m][bj].x, xw[m][bj].y, xw[m][bj].z, xw[m][bj].w};
                        float v[8];
#pragma unroll
                        for (int j = 0; j < 8; ++j) {
                            const float gacc = acc[ai][bj][m][j >> 2][j & 3] + bgv[bj][j >> 2][j & 3];
                            const float ppv = (j & 1) ? bf2f(pws[j >> 1] >> 16) : bf2f(pws[j >> 1] & 0xffffu);
                            const float xv = (j & 1) ? bf2f(xws[j >> 1] >> 16) : bf2f(xws[j >> 1] & 0xffffu);
                            v[j] = sigmoidf_(gacc) * ppv + ALPHA * xv;
                        }
                        acc[ai][bj][m][0] = (f32x4){v[0], v[1], v[2], v[3]}; acc[ai][bj][m][1] = (f32x4){v[4], v[5], v[6], v[7]};
                    }
                asm volatile("" ::: "memory");
            }
        } else {
#pragma unroll
            for (int ai = 0; ai < 2; ++ai)
#pragma unroll
                for (int m = 0; m < 4; ++m) {
                    const size_t off = (size_t)(u.r0 + 128 * ai + 64 * wr + 16 * m + fr) * D + u.c0 + 32 * wc + 8 * fq;
#pragma unroll
                    for (int bj = 0; bj < 2; ++bj)
#pragma unroll
                        for (int n = 0; n < 2; ++n) *(f32x4*)(y + off + 128 * bj + 4 * n) = acc[ai][bj][m][n];
                }
        }
    }
};
__device__ void phase_base(const Args& a, LAS unsigned char* lds, int bid, int nb) {
    SchedBase S{nb, vcu_of(bid, nb)};
    EpiBase E{(const bf16*)(a.ws + WS_XB), (const bf16*)(a.ws + WS_PP), a.in[I_BG], a.out};
    gf::gemm_fast<true>(lds, a.ws, S, E);
}

struct SchedMoeUp {
    const int* stok; const int* tile; int nU, G, c;
    __device__ __forceinline__ bool next(int i, gf::Unit& u) const {
        const int L = i * G + c; if (L >= nU) return false;
        const int mt = L >> 1, pn = L & 1, e = uload(tile + mt);
        u.A = (unsigned)WS_XB; u.rowidx = stok + mt * 256; u.B = (unsigned)WS_W13T + ((unsigned)e * 512u + pn * 256u) * (D * 2); u.lda = D * 2; u.ldb = D * 2; u.nt = D / 64; u.keep = 0;
        u.kind = 0; u.r0 = mt * 256; u.c0 = pn * 128; u.x0 = 0; return true;
    }
};
struct EpiMoeUp { bf16* hsort; __device__ __forceinline__ void operator()(f32x4 (&acc)[2][2][4][2], const gf::Unit& u, int wr, int wc, int fr, int fq) const { epi_gate(acc, hsort, EDIM, u.r0, u.c0, wr, wc, fr, fq); } };
__device__ void phase_moe_up(const Args& a, LAS unsigned char* lds, int c, int bid, int nb) {
    unsigned char* ro = a.ws + WS_ROUT;
    const int* tile = (const int*)(ro + RO_TILE) + c * TILE_STRIDE;
    SchedMoeUp S{(const int*)(ro + RO_STOK) + (size_t)c * RMAX, tile, uload(tile + TILE_STRIDE - 1) * 2, nb, vcu_of(bid, nb)};
    EpiMoeUp E{(bf16*)(a.ws + WS_HSORT)};
    gf::gemm_fast<true>(lds, a.ws, S, E);
}
struct SchedMoeDown {
    const int* tile; int nU, G, c;
    __device__ __forceinline__ bool next(int i, gf::Unit& u) const {
        const int L = i * G + c; if (L >= nU) return false;
        const int mt = L >> 2, pn = L & 3, e = uload(tile + mt);
        u.A = (unsigned)WS_HSORT + (unsigned)mt * 256u * (EDIM * 2); u.rowidx = nullptr; u.B = (unsigned)WS_W2T + ((unsigned)e * D + pn * 256u) * (EDIM * 2); u.lda = EDIM * 2; u.ldb = EDIM * 2; u.nt = EDIM / 64; u.keep = 0;
        u.kind = 0; u.r0 = mt * 256; u.c0 = pn * 256; u.x0 = 0; return true;
    }
};
struct EpiMoeDown { const int* dest; const float* rsc; bf16* contrib;
    __device__ __forceinline__ void operator()(f32x4 (&acc)[2][2][4][2], const gf::Unit& u, int wr, int wc, int fr, int fq) const {
        int dr[2][4]; float sc[2][4];
#pragma unroll
        for (int ai = 0; ai < 2; ++ai)
#pragma unroll
            for (int m = 0; m < 4; ++m) { const int r = u.r0 + 128 * ai + 64 * wr + 16 * m + fr; dr[ai][m] = dest[r]; sc[ai][m] = rsc[r]; }
#pragma unroll
        for (int ai = 0; ai < 2; ++ai)
#pragma unroll
            for (int m = 0; m < 4; ++m) {
                const float s = sc[ai][m];
                bf16* rp = contrib + (size_t)dr[ai][m] * D + u.c0 + 32 * wc + 8 * fq;
#pragma unroll
                for (int bj = 0; bj < 2; ++bj) {
                    const f32x4 v0 = acc[ai][bj][m][0] * s, v1 = acc[ai][bj][m][1] * s;
                    u32x4 w; w.x = cvt_pk_bf16(v0[0], v0[1]); w.y = cvt_pk_bf16(v0[2], v0[3]); w.z = cvt_pk_bf16(v1[0], v1[1]); w.w = cvt_pk_bf16(v1[2], v1[3]);
                    *(u32x4*)(rp + 128 * bj) = w;
                }
            }
    }
};
__device__ void phase_moe_down(const Args& a, LAS unsigned char* lds, int c, int bid, int nb) {
    unsigned char* ro = a.ws + WS_ROUT;
    const int* tile = (const int*)(ro + RO_TILE) + c * TILE_STRIDE;
    SchedMoeDown S{tile, uload(tile + TILE_STRIDE - 1) * 4, nb, vcu_of(bid, nb)};
    EpiMoeDown E{(const int*)(ro + RO_DEST) + (size_t)c * RMAX, (const float*)(ro + RO_RSC) + (size_t)c * RMAX, (bf16*)(a.ws + WS_CONTRIB)};
    gf::gemm_fast<false>(lds, a.ws, S, E);
}
__device__ void phase_combine(const Args& a, int c, int bid, int nb) {
    const int tid = hidden_tid(), wid = tid >> 6, lane = tid & 63;
    const bf16* contrib = (const bf16*)(a.ws + WS_CONTRIB);
    const float* g = a.in[I_LN2G]; const float* bta = a.in[I_LN2B]; float* y = a.out;
    f32x4 gv[4], bv[4];
#pragma unroll
    for (int j = 0; j < 2; ++j) { gv[2 * j] = *(const f32x4*)(g + 512 * j + 8 * lane); gv[2 * j + 1] = *(const f32x4*)(g + 512 * j + 8 * lane + 4); bv[2 * j] = *(const f32x4*)(bta + 512 * j + 8 * lane); bv[2 * j + 1] = *(const f32x4*)(bta + 512 * j + 8 * lane + 4); }
    for (int rl = bid * 8 + wid; rl < TC; rl += nb * 8) {
        float* row = y + ((size_t)c * TC + rl) * D;
        f32x4 v[4];
#pragma unroll
        for (int j = 0; j < 2; ++j) { v[2 * j] = *(const f32x4*)(row + 512 * j + 8 * lane); v[2 * j + 1] = *(const f32x4*)(row + 512 * j + 8 * lane + 4); }
#pragma unroll
        for (int k = 0; k < 8; ++k) {
            const bf16* cr = contrib + ((size_t)rl * 8 + k) * D;
#pragma unroll
            for (int j = 0; j < 2; ++j) {
                const u32x4 cw = *(const u32x4*)(cr + 512 * j + 8 * lane);
                v[2 * j][0] += bf2f(cw.x & 0xffffu); v[2 * j][1] += bf2f(cw.x >> 16); v[2 * j][2] += bf2f(cw.y & 0xffffu); v[2 * j][3] += bf2f(cw.y >> 16);
                v[2 * j + 1][0] += bf2f(cw.z & 0xffffu); v[2 * j + 1][1] += bf2f(cw.z >> 16); v[2 * j + 1][2] += bf2f(cw.w & 0xffffu); v[2 * j + 1][3] += bf2f(cw.w >> 16);
            }
        }
        float s = 0.f;
#pragma unroll
        for (int i = 0; i < 4; ++i) s += (v[i][0] + v[i][1]) + (v[i][2] + v[i][3]);
#pragma unroll
        for (int o = 32; o >= 1; o >>= 1) s += __shfl_xor(s, o);
        const float mean = s * (1.0f / D);
        float q = 0.f;
#pragma unroll
        for (int i = 0; i < 4; ++i) { const f32x4 d = v[i] - mean; q += (d[0] * d[0] + d[1] * d[1]) + (d[2] * d[2] + d[3] * d[3]); }
#pragma unroll
        for (int o = 32; o >= 1; o >>= 1) q += __shfl_xor(q, o);
        const float rstd = rsqrtf(q * (1.0f / D) + LN_EPS);
#pragma unroll
        for (int j = 0; j < 2; ++j) {
            *(f32x4*)(row + 512 * j + 8 * lane) = (v[2 * j] - mean) * rstd * gv[2 * j] + bv[2 * j];
            *(f32x4*)(row + 512 * j + 8 * lane + 4) = (v[2 * j + 1] - mean) * rstd * gv[2 * j + 1] + bv[2 * j + 1];
        }
    }
}

#define XB_TMO      128
#define XB_XCNT(j)  (256  + 64 * (j))
#define XB_XSUB(j)  (1280 + 64 * (j))
#define XB_XGEN(j)  (2304 + 64 * (j))
#define XB_TOP      3328
#define XB_TOPGEN   3392
#define XCD_BAR_WORDS 3456
#define XB_SPIN_CAP (1u << 18)

__device__ __forceinline__ unsigned xb_ld(unsigned* p)              { return __hip_atomic_load(p, __ATOMIC_RELAXED, __HIP_MEMORY_SCOPE_AGENT); }
__device__ __forceinline__ unsigned xb_add(unsigned* p, unsigned v) { return __hip_atomic_fetch_add(p, v, __ATOMIC_RELAXED, __HIP_MEMORY_SCOPE_AGENT); }
__device__ __forceinline__ unsigned xb_xcc_id() { return (unsigned)__builtin_amdgcn_s_getreg((3 << 11) | 20) & 0xFu; }
#define XB_SPIN(cond, bar) do { unsigned _sp = 0; while (cond) { __builtin_amdgcn_s_sleep(1); \
    if ((++_sp & 255u) == 0u) { if (xb_ld(&(bar)[XB_TMO])) break; if (_sp > XB_SPIN_CAP) { atomicAdd(&(bar)[XB_TMO], 1u); break; } } } } while (0)

struct XcdBarrier {
    unsigned* bar; unsigned x;
    volatile LAS unsigned* st;
};
__device__ __forceinline__ XcdBarrier xcd_barrier_post(unsigned* bar, volatile LAS unsigned* st) {
    XcdBarrier b; b.bar = bar; b.x = xb_xcc_id(); b.st = st;
    if (threadIdx.x == 0) (void)xb_add(&bar[XB_XCNT(b.x)], 1u);
    return b;
}
__device__ __forceinline__ void xcd_barrier_complete(unsigned* bar, unsigned x, unsigned& nloc, unsigned& nx) {
    const unsigned G = gridDim.x * gridDim.y * gridDim.z;
    unsigned sum, cnt, mine, sp = 0u;
    for (;;) {
        sum = 0u; cnt = 0u; mine = 0u;
#pragma unroll
        for (unsigned j = 0; j < 16; ++j) { const unsigned c = xb_ld(&bar[XB_XCNT(j)]); sum += c; cnt += (c > 0u) ? 1u : 0u; mine = (j == x) ? c : mine; }
        if (sum == G) break;
        __builtin_amdgcn_s_sleep(1);
        if ((++sp & 255u) == 0u) { if (xb_ld(&bar[XB_TMO])) break; if (sp > XB_SPIN_CAP) { atomicAdd(&bar[XB_TMO], 1u); break; } }
    }
    nloc = mine > 0u ? mine : 1u; nx = cnt > 0u ? cnt : 1u;
}
__device__ __forceinline__ void xcd_barrier(const XcdBarrier& b) {
    asm volatile("s_waitcnt vmcnt(0)" ::: "memory");
    __syncthreads();
    if (threadIdx.x == 0) {
        unsigned* bar = b.bar;
        __builtin_amdgcn_s_waitcnt(0);
        unsigned nloc = b.st[0], nx = b.st[1];
        if (nloc == 0u) { xcd_barrier_complete(bar, b.x, nloc, nx); b.st[0] = nloc; b.st[1] = nx; }
        const unsigned old = xb_add(&bar[XB_XSUB(b.x)], 1u);
        const unsigned gen = old / nloc;
        if (old + 1u == (gen + 1u) * nloc) {
            __builtin_amdgcn_fence(__ATOMIC_RELEASE, "agent");
            asm volatile("s_waitcnt vmcnt(0)" ::: "memory");
            const unsigned og = xb_add(&bar[XB_TOP], 1u);
            const unsigned tg = og / nx;
            if (og + 1u == (tg + 1u) * nx) xb_add(&bar[XB_TOPGEN], 1u);
            else XB_SPIN(xb_ld(&bar[XB_TOPGEN]) == tg, bar);
            __builtin_amdgcn_fence(__ATOMIC_ACQUIRE, "agent");
            xb_add(&bar[XB_XGEN(b.x)], 1u);
            asm volatile("s_waitcnt vmcnt(0)" ::: "memory");
        } else {
            XB_SPIN(xb_ld(&bar[XB_XGEN(b.x)]) == gen, bar);
            __builtin_amdgcn_fence(__ATOMIC_ACQUIRE, "agent");
            asm volatile("s_waitcnt vmcnt(0)" ::: "memory");
        }
    }
    __syncthreads();
}

constexpr int PH_PROLOGUE = 0, PH_PROJ = 1, PH_MIX_A = 2, PH_MIX_B = 3, PH_WOUT = 4, PH_LN1 = 5, PH_ROUTER = 6, PH_SORT = 7, PH_MOE0 = 8, PH_END = PH_MOE0 + 3 * NH;
constexpr int LDS_BYTES = 147456;

constexpr int LDS_BAR_OFF = LDS_BYTES - 16;
#ifndef N_LAUNCHES
#define N_LAUNCHES 1
#endif
__global__ void __launch_bounds__(NTHREADS, 2) fwd(Args a) {
    extern __shared__ __attribute__((aligned(16))) unsigned char lds_raw[];
    LAS unsigned char* lds = (LAS unsigned char*)lds_raw;
    const int bid = blockIdx.x, nb = gridDim.x;
    if (threadIdx.x < 4) ((LAS unsigned*)(lds + LDS_BAR_OFF))[threadIdx.x] = 0u;
    __syncthreads();
    XcdBarrier bar = xcd_barrier_post((unsigned*)(a.ws + WS_CTL), (volatile LAS unsigned*)(lds + LDS_BAR_OFF));
    const int lo = a.ph_lo, hi = a.ph_hi;
#ifndef PHMASK
#define PHMASK 0xffffffffu
#endif
#define IN(k) (((PHMASK >> ((k) < PH_MOE0 ? (k) : 8 + ((k) - PH_MOE0) % 3)) & 1u) && lo <= (k) && (k) < hi)
#define SEAM(k) do { if (lo <= (k) && (k) + 1 < hi) xcd_barrier(bar); } while (0)
    if (IN(PH_PROLOGUE)) phase_prologue(a, lds, bid, nb);
    SEAM(PH_PROLOGUE);
    if (IN(PH_PROJ)) phase_proj(a, lds, bid, nb);
    SEAM(PH_PROJ);
    if (IN(PH_MIX_A)) { phase_segtot(a, lds, bid, nb); phase_swa(a, lds, bid, nb); }
    SEAM(PH_MIX_A);
    if (IN(PH_MIX_B)) phase_retention(a, lds, bid, nb);
    SEAM(PH_MIX_B);
    if (IN(PH_WOUT)) phase_wout(a, lds, bid, nb);
    SEAM(PH_WOUT);
    if (IN(PH_LN1)) phase_ln<0>(a.out, a.in[I_LN1G], a.in[I_LN1B], (bf16*)(a.ws + WS_XB), nullptr, bid, nb);
    SEAM(PH_LN1);
    if (IN(PH_ROUTER)) { phase_router(a, lds, bid, nb); __syncthreads(); phase_shared(a, lds, bid, nb); }
    SEAM(PH_ROUTER);
    if (IN(PH_SORT)) { phase_sort(a, lds, bid, nb); __syncthreads(); phase_base(a, lds, bid, nb); }
    SEAM(PH_SORT);
    for (int c = 0; c < NH; ++c) {
        if (IN(PH_MOE0 + 3 * c)) phase_moe_up(a, lds, c, bid, nb);
        SEAM(PH_MOE0 + 3 * c);
        if (IN(PH_MOE0 + 3 * c + 1)) phase_moe_down(a, lds, c, bid, nb);
        SEAM(PH_MOE0 + 3 * c + 1);
        if (IN(PH_MOE0 + 3 * c + 2)) phase_combine(a, c, bid, nb);
        SEAM(PH_MOE0 + 3 * c + 2);
    }
#undef IN
#undef SEAM
}

extern "C" void kernel_launch(void* const* d_in, const int* in_sizes, int n_in, void* d_out, int out_size, void* d_ws, size_t ws_size, hipStream_t stream) {
    static int grid = 0;
    if (grid == 0) {
        if (n_in != 22 || out_size != T * D || ws_size < WS_NEED) { fprintf(stderr, "kernel_launch: unexpected shapes: n_in %d out %d ws %zu (need %zu)\n", n_in, out_size, ws_size, (size_t)WS_NEED); grid = -1; return; }
        int dev = 0, cus = 0;
        (void)hipGetDevice(&dev); (void)hipDeviceGetAttribute(&cus, hipDeviceAttributeMultiprocessorCount, dev);
        if (hipFuncSetAttribute((const void*)fwd, hipFuncAttributeMaxDynamicSharedMemorySize, LDS_BYTES) != hipSuccess) { fprintf(stderr, "hipFuncSetAttribute failed\n"); grid = -1; return; }
        int per_cu = 0;
        if (hipOccupancyMaxActiveBlocksPerMultiprocessor(&per_cu, (const void*)fwd, NTHREADS, LDS_BYTES) != hipSuccess || per_cu < 1) { fprintf(stderr, "occupancy query: %d blocks per CU\n", per_cu); grid = -1; return; }
        (void)hipGetLastError();
        grid = cus > 0 ? cus : 256;
    }
    if (grid < 0) return;
    (void)hipMemsetAsync((char*)d_ws + WS_CTL, 0, 16384, stream);
    Args a{};
    for (int i = 0; i < 22; ++i) a.in[i] = (const float*)d_in[i];
    a.out = (float*)d_out; a.ws = (unsigned char*)d_ws;
#if N_LAUNCHES == 1
    a.ph_lo = 0; a.ph_hi = PH_END;
    hipLaunchKernelGGL(fwd, dim3(grid), dim3(NTHREADS), LDS_BYTES, stream, a);
#else
    for (int ph = 0; ph < PH_END; ++ph) {
        a.ph_lo = ph; a.ph_hi = ph + 1;
        hipLaunchKernelGGL(fwd, dim3(grid), dim3(NTHREADS), LDS_BYTES, stream, a);
    }
#endif
}
```

```cpp
#include <hip/hip_runtime.h>
#include <cstdio>
#include <cstdint>

#define LAS __attribute__((address_space(3)))
typedef unsigned short bf16;
typedef short bf16x8 __attribute__((ext_vector_type(8)));
typedef short bf16x4 __attribute__((ext_vector_type(4)));
typedef float f32x4 __attribute__((ext_vector_type(4)));
typedef unsigned u32x4 __attribute__((ext_vector_type(4)));
typedef unsigned u32x2 __attribute__((ext_vector_type(2)));

constexpr int D = 1024, BATCH = 8, SEQ = 4096, T = BATCH * SEQ;
constexpr int HD = 64, RH = 8, QH = 8, KVH = 2;
constexpr int INW = 2816;
constexpr int C_RQ = 0, C_RK = 512, C_RV = 1024, C_RG = 1536, C_AQ = 2048, C_AK = 2560, C_AV = 2688;
constexpr int CH = 128, NCH = SEQ / CH;
constexpr int SEGC = 8, NSEG = NCH / SEGC;
constexpr int NE = 64, TOPK = 8, EDIM = 256, SDIM = 256, PLE = 256;
constexpr float LN_EPS = 1e-5f, GN_EPS = 1e-6f;
constexpr float ALPHA = 1.189207115002721f;
constexpr float ROUTED_SCALE = 2.5f;
constexpr int NH = 1, TC = T / NH;
constexpr int RMAX = TC * TOPK + NE * 256;
constexpr int MAXTILES = RMAX / 256;
constexpr int NTHREADS = 512;
constexpr float W8_SCALE = 32.0f, W8_INV = 1.0f / 32.0f;
constexpr float C8_SCALE = 16.0f, C8_INV = 1.0f / 16.0f;

constexpr size_t MiB = 1u << 20;
constexpr size_t al(size_t x) { return (x + 255) & ~(size_t)255; }
constexpr size_t WS_CTL = 0, CTL_BYTES = 1 * MiB;
constexpr size_t WS_W13Q = WS_CTL + CTL_BYTES;
constexpr size_t WS_W2Q = WS_W13Q + al((size_t)NE * 512 * D);
constexpr size_t WS_ROUT = WS_W2Q + al((size_t)NE * D * EDIM);
constexpr size_t RO_RIDX = 0, RO_RW = RO_RIDX + (size_t)T * 8 * 4, RO_CNT = RO_RW + (size_t)T * 8 * 4, RO_STOK = RO_CNT + 256 * 64 * 4;
constexpr size_t RO_DEST = RO_STOK + (size_t)NH * RMAX * 4, RO_RSC = RO_DEST + (size_t)NH * RMAX * 4, RO_TILE = RO_RSC + (size_t)NH * RMAX * 4;
constexpr int TILE_STRIDE = 2048;
static_assert(MAXTILES < TILE_STRIDE - 1, "tile table");
constexpr size_t RO_END = RO_TILE + (size_t)NH * TILE_STRIDE * 4;
constexpr size_t WS_X1Q = WS_ROUT + al(RO_END);
constexpr size_t WS_XB = WS_X1Q + al((size_t)T * D);
constexpr size_t WS_DYN = WS_XB + al((size_t)T * D * 2);
constexpr size_t WS_WINT = WS_DYN;
constexpr size_t WS_WOUTT = WS_WINT + al((size_t)INW * D * 2);
constexpr size_t WS_WS13T = WS_WOUTT + al((size_t)D * D * 2);
constexpr size_t WS_WS2T = WS_WS13T + al((size_t)512 * D * 2);
constexpr size_t WS_WGT = WS_WS2T + al((size_t)D * SDIM * 2);
constexpr size_t WS_WPT = WS_WGT + al((size_t)D * D * 2);
constexpr size_t WS_WRT = WS_WPT + al((size_t)D * PLE * 2);
constexpr size_t WS_TAB = WS_WRT + al((size_t)NE * D * 2);
constexpr size_t TAB_BYTES = (size_t)SEQ * (32 + 32 + 8 + 8) * 4;
constexpr size_t WS_SEGT = WS_TAB + al(TAB_BYTES);
constexpr size_t WS_PB = WS_SEGT + al((size_t)BATCH * RH * NSEG * 64 * 64 * 4);
constexpr size_t WS_BIG = WS_PB + al((size_t)T * PLE * 2);
constexpr size_t WS_MIXO = WS_BIG + al((size_t)T * INW * 2);
constexpr size_t WS_PP = WS_MIXO + al((size_t)T * D * 2);
constexpr size_t WS_END1 = WS_PP + al((size_t)T * D * 2);
constexpr size_t WS_HS = WS_BIG;
constexpr size_t WS_HSORT = WS_DYN;
constexpr size_t WS_CONTRIB = WS_HSORT + al((size_t)RMAX * EDIM);
constexpr size_t WS_END2 = WS_CONTRIB + al(((size_t)TC * 8 + 1) * D);
constexpr size_t WS_NEED = WS_END1 > WS_END2 ? WS_END1 : WS_END2;
static_assert(WS_NEED <= 512 * MiB, "workspace map exceeds 512 MiB");

__device__ __forceinline__ int hidden_tid() { int t = threadIdx.x; asm volatile("" : "+v"(t)); return t; }
__device__ __forceinline__ float bf2f(unsigned v) { return __uint_as_float(v << 16); }
__device__ __forceinline__ unsigned cvt_pk_bf16(float lo, float hi) { unsigned r; asm volatile("v_cvt_pk_bf16_f32 %0, %1, %2" : "=v"(r) : "v"(lo), "v"(hi)); return r; }
__device__ __forceinline__ bf16 f2bf(float f) { return (bf16)(cvt_pk_bf16(f, 0.f) & 0xffffu); }
__device__ __forceinline__ float sigmoidf_(float x) { return __builtin_amdgcn_rcpf(1.0f + __expf(-x)); }
__device__ __forceinline__ float siluf_(float x) { return x * __builtin_amdgcn_rcpf(1.0f + __expf(-x)); }

struct Args {
    const float* in[22];
    float* out;
    unsigned char* ws;
    int ph_lo, ph_hi;
};
enum { I_X = 0, I_P, I_WIN, I_GN, I_ASC, I_SINK, I_WOUT, I_LN1G, I_LN1B, I_WR, I_RB, I_W1, I_W3, I_W2, I_WS1, I_WS3, I_WS2, I_WG, I_BG, I_WP, I_LN2G, I_LN2B };

struct TJob { const float* src; bf16* dst; int ld_src, ld_dst, sc0, dn0, k0, fp8; };
__device__ __forceinline__ bool get_tjob(const Args& a, int t, TJob& j) {
    unsigned char* ws = a.ws;
    if (t < NE * 32) { const int e = t >> 5, rem = t & 31, db = rem >> 2, kt = rem & 3, piece = db >> 1, which = piece & 1, pn = piece >> 1;
        j.src = (which ? a.in[I_W3] : a.in[I_W1]) + (size_t)e * D * EDIM; j.ld_src = EDIM; j.sc0 = pn * 128 + (db & 1) * 64;
        j.dst = (bf16*)(ws + WS_W13Q + (size_t)e * 512 * D); j.ld_dst = D; j.dn0 = db * 64; j.k0 = kt * 256; j.fp8 = 1; return true; }
    t -= NE * 32;
    if (t < NE * 16) { const int e = t >> 4, nt = t & 15;
        j.src = a.in[I_W2] + (size_t)e * EDIM * D; j.ld_src = D; j.sc0 = nt * 64; j.dst = (bf16*)(ws + WS_W2Q + (size_t)e * D * EDIM); j.ld_dst = EDIM; j.dn0 = nt * 64; j.k0 = 0; j.fp8 = 1; return true; }
    j.fp8 = 0;
    t -= NE * 16;
    if (t < 44 * 4) { j.src = a.in[I_WIN]; j.ld_src = INW; j.sc0 = (t >> 2) * 64; j.dst = (bf16*)(ws + WS_WINT); j.ld_dst = D; j.dn0 = (t >> 2) * 64; j.k0 = (t & 3) * 256; return true; }
    t -= 44 * 4;
    if (t < 16 * 4) { j.src = a.in[I_WOUT]; j.ld_src = D; j.sc0 = (t >> 2) * 64; j.dst = (bf16*)(ws + WS_WOUTT); j.ld_dst = D; j.dn0 = (t >> 2) * 64; j.k0 = (t & 3) * 256; return true; }
    t -= 16 * 4;
    if (t < 8 * 4) { const int db = t >> 2, piece = db >> 1, which = piece & 1, pn = piece >> 1;
        j.src = which ? a.in[I_WS3] : a.in[I_WS1]; j.ld_src = SDIM; j.sc0 = pn * 128 + (db & 1) * 64; j.dst = (bf16*)(ws + WS_WS13T); j.ld_dst = D; j.dn0 = db * 64; j.k0 = (t & 3) * 256; return true; }
    t -= 8 * 4;
    if (t < 16) { j.src = a.in[I_WS2]; j.ld_src = D; j.sc0 = t * 64; j.dst = (bf16*)(ws + WS_WS2T); j.ld_dst = SDIM; j.dn0 = t * 64; j.k0 = 0; return true; }
    t -= 16;
    if (t < 16 * 4) { j.src = a.in[I_WG]; j.ld_src = D; j.sc0 = (t >> 2) * 64; j.dst = (bf16*)(ws + WS_WGT); j.ld_dst = D; j.dn0 = (t >> 2) * 64; j.k0 = (t & 3) * 256; return true; }
    t -= 16 * 4;
    if (t < 16) { j.src = a.in[I_WP]; j.ld_src = D; j.sc0 = t * 64; j.dst = (bf16*)(ws + WS_WPT); j.ld_dst = PLE; j.dn0 = t * 64; j.k0 = 0; return true; }
    t -= 16;
    if (t < 4) { j.src = a.in[I_WR]; j.ld_src = NE; j.sc0 = 0; j.dst = (bf16*)(ws + WS_WRT); j.ld_dst = D; j.dn0 = 0; j.k0 = t * 256; return true; }
    return false;
}
constexpr int N_TJOBS = NE * 32 + NE * 16 + 44 * 4 + 16 * 4 + 8 * 4 + 16 + 16 * 4 + 16 + 4;

__device__ void phase_prologue(const Args& a, LAS unsigned char* lds, int bid, int nb) {
    LAS float* tile = (LAS float*)lds;
    unsigned char* ws = a.ws;
    const int tid = hidden_tid();
    {
        const int lr = tid >> 4, lc4 = (tid & 15) * 4;
        const int wn = tid & 63, wk = (tid >> 6) * 32;
        TJob j; f32x4 v[8];
        int t = bid;
        bool have = get_tjob(a, t, j);
        if (have) {
#pragma unroll
            for (int i = 0; i < 8; ++i) v[i] = *(const f32x4*)(j.src + (size_t)(j.k0 + lr + 32 * i) * j.ld_src + j.sc0 + lc4);
        }
        while (have) {
#pragma unroll
            for (int i = 0; i < 8; ++i) { LAS float* tp = tile + (lr + 32 * i) * 65 + lc4; tp[0] = v[i][0]; tp[1] = v[i][1]; tp[2] = v[i][2]; tp[3] = v[i][3]; }
            bf16* drow = j.dst + (size_t)(j.dn0 + wn) * j.ld_dst + j.k0 + wk;
            unsigned char* drow8 = (unsigned char*)j.dst + (size_t)(j.dn0 + wn) * j.ld_dst + j.k0 + wk;
            const int is8 = j.fp8;
            t += nb; TJob jn; const bool hn = get_tjob(a, t, jn);
            if (hn) {
#pragma unroll
                for (int i = 0; i < 8; ++i) v[i] = *(const f32x4*)(jn.src + (size_t)(jn.k0 + lr + 32 * i) * jn.ld_src + jn.sc0 + lc4);
            }
            __syncthreads();
            if (is8) {
#pragma unroll
                for (int q = 0; q < 2; ++q) {
                    int w[4];
#pragma unroll
                    for (int d = 0; d < 4; ++d) {
                        const int kk = wk + 16 * q + 4 * d;
                        int x = 0;
                        x = __builtin_amdgcn_cvt_pk_fp8_f32(tile[(kk + 0) * 65 + wn] * W8_SCALE, tile[(kk + 1) * 65 + wn] * W8_SCALE, x, false);
                        x = __builtin_amdgcn_cvt_pk_fp8_f32(tile[(kk + 2) * 65 + wn] * W8_SCALE, tile[(kk + 3) * 65 + wn] * W8_SCALE, x, true);
                        w[d] = x;
                    }
                    *(u32x4*)(drow8 + 16 * q) = (u32x4){(unsigned)w[0], (unsigned)w[1], (unsigned)w[2], (unsigned)w[3]};
                }
            } else {
#pragma unroll
                for (int q = 0; q < 4; ++q) {
                    u32x4 w;
                    w.x = cvt_pk_bf16(tile[(wk + 8 * q + 0) * 65 + wn], tile[(wk + 8 * q + 1) * 65 + wn]);
                    w.y = cvt_pk_bf16(tile[(wk + 8 * q + 2) * 65 + wn], tile[(wk + 8 * q + 3) * 65 + wn]);
                    w.z = cvt_pk_bf16(tile[(wk + 8 * q + 4) * 65 + wn], tile[(wk + 8 * q + 5) * 65 + wn]);
                    w.w = cvt_pk_bf16(tile[(wk + 8 * q + 6) * 65 + wn], tile[(wk + 8 * q + 7) * 65 + wn]);
                    *(u32x4*)(drow + 8 * q) = w;
                }
            }
            __syncthreads();
            j = jn; have = hn;
        }
    }
    {
        const size_t n8 = (size_t)T * D / 8;
        const float* x = a.in[I_X]; bf16* xb = (bf16*)(ws + WS_XB);
        for (size_t i = (size_t)bid * NTHREADS + tid; i < n8; i += (size_t)nb * NTHREADS) {
            const f32x4 v0 = *(const f32x4*)(x + i * 8), v1 = *(const f32x4*)(x + i * 8 + 4);
            u32x4 w; w.x = cvt_pk_bf16(v0[0], v0[1]); w.y = cvt_pk_bf16(v0[2], v0[3]); w.z = cvt_pk_bf16(v1[0], v1[1]); w.w = cvt_pk_bf16(v1[2], v1[3]);
            *(u32x4*)(xb + i * 8) = w;
        }
        const size_t m8 = (size_t)T * PLE / 8;
        const float* p = a.in[I_P]; bf16* pb = (bf16*)(ws + WS_PB);
        for (size_t i = (size_t)bid * NTHREADS + tid; i < m8; i += (size_t)nb * NTHREADS) {
            const f32x4 v0 = *(const f32x4*)(p + i * 8), v1 = *(const f32x4*)(p + i * 8 + 4);
            u32x4 w; w.x = cvt_pk_bf16(v0[0], v0[1]); w.y = cvt_pk_bf16(v0[2], v0[3]); w.z = cvt_pk_bf16(v1[0], v1[1]); w.w = cvt_pk_bf16(v1[2], v1[3]);
            *(u32x4*)(pb + i * 8) = w;
        }
    }
    {
        float* tab = (float*)(ws + WS_TAB);
        float* cosr = tab, *sinr = tab + SEQ * 32, *coss = tab + SEQ * 64, *sins = tab + SEQ * 72;
        for (int i = bid * NTHREADS + tid; i < SEQ * 40; i += nb * NTHREADS) {
            const int s = i / 40, j = i % 40;
            if (j < 32) {
                const float inv = (float)pow(10000.0, -(double)j / 32.0);
                const float ang = (float)s * inv;
                cosr[s * 32 + j] = (float)cos((double)ang); sinr[s * 32 + j] = (float)sin((double)ang);
            } else {
                const int jj = j - 32;
                const float inv = (float)pow(500000.0, -(double)jj / 8.0);
                const float ang = (float)s * inv;
                coss[s * 8 + jj] = (float)cos((double)ang); sins[s * 8 + jj] = (float)sin((double)ang);
            }
        }
    }
}

__device__ __forceinline__ int perm32(int rho) { const int n = rho >> 4, i = rho & 15; return 8 * (i >> 2) + 4 * n + (i & 3); }

struct GemmPart { const bf16* A; int lda; const int* rowidx; long arow0; const bf16* Bt; int ldb; int K; };

__device__ __forceinline__ void gemm_part(f32x4 (&acc)[2][2][4][2], const GemmPart& g, int wr, int wc, int fr, int fq) {
    unsigned oa[2][4], ob[2][2];
#pragma unroll
    for (int ai = 0; ai < 2; ++ai)
#pragma unroll
        for (int m = 0; m < 4; ++m) {
            const int r = 128 * ai + 64 * wr + 16 * m + fr;
            const long gr = g.rowidx ? (long)g.rowidx[r] : g.arow0 + r;
            oa[ai][m] = (unsigned)((gr * g.lda + 8 * fq) * 2);
        }
#pragma unroll
    for (int bj = 0; bj < 2; ++bj)
#pragma unroll
        for (int n = 0; n < 2; ++n) {
            const int rb = 128 * bj + 32 * wc + perm32(16 * n + fr);
            ob[bj][n] = (unsigned)((rb * g.ldb + 8 * fq) * 2);
        }
    const char* pA = (const char*)g.A; const char* pB = (const char*)g.Bt;
#pragma unroll 1
    for (int k0 = 0; k0 < g.K; k0 += 32) {
        bf16x8 af[2][4], bfr[2][2];
#pragma unroll
        for (int ai = 0; ai < 2; ++ai)
#pragma unroll
            for (int m = 0; m < 4; ++m) af[ai][m] = *(const bf16x8*)(pA + oa[ai][m]);
#pragma unroll
        for (int bj = 0; bj < 2; ++bj)
#pragma unroll
            for (int n = 0; n < 2; ++n) bfr[bj][n] = *(const bf16x8*)(pB + ob[bj][n]);
#pragma unroll
        for (int ai = 0; ai < 2; ++ai)
#pragma unroll
            for (int bj = 0; bj < 2; ++bj)
#pragma unroll
                for (int m = 0; m < 4; ++m)
#pragma unroll
                    for (int n = 0; n < 2; ++n)
                        acc[ai][bj][m][n] = __builtin_amdgcn_mfma_f32_16x16x32_bf16(bfr[bj][n], af[ai][m], acc[ai][bj][m][n], 0, 0, 0);
        pA += 64; pB += 64;
    }
}
__device__ __forceinline__ void zero_acc(f32x4 (&acc)[2][2][4][2]) {
#pragma unroll
    for (int a = 0; a < 2; ++a)
#pragma unroll
        for (int b = 0; b < 2; ++b)
#pragma unroll
            for (int m = 0; m < 4; ++m)
#pragma unroll
                for (int n = 0; n < 2; ++n) acc[a][b][m][n] = (f32x4){0.f, 0.f, 0.f, 0.f};
}
#define WAVE_IDS() int tid_ = threadIdx.x; asm volatile("" : "+v"(tid_)); const int tid = tid_, wid = __builtin_amdgcn_readfirstlane(tid >> 6), lane = tid & 63, wr = wid >> 2, wc = wid & 3, fr = lane & 15, fq = lane >> 4; (void)lane; (void)wr; (void)wc; (void)fr; (void)fq

__device__ __forceinline__ void epi_bf16(const f32x4 (&acc)[2][2][4][2], bf16* O, int ldo, long row0, int col0, int wr, int wc, int fr, int fq) {
#pragma unroll
    for (int ai = 0; ai < 2; ++ai)
#pragma unroll
        for (int m = 0; m < 4; ++m) {
            bf16* rp = O + (size_t)(row0 + 128 * ai + 64 * wr + 16 * m + fr) * ldo + col0 + 32 * wc + 8 * fq;
#pragma unroll
            for (int bj = 0; bj < 2; ++bj) {
                const f32x4 v0 = acc[ai][bj][m][0], v1 = acc[ai][bj][m][1];
                u32x4 w; w.x = cvt_pk_bf16(v0[0], v0[1]); w.y = cvt_pk_bf16(v0[2], v0[3]); w.z = cvt_pk_bf16(v1[0], v1[1]); w.w = cvt_pk_bf16(v1[2], v1[3]);
                *(u32x4*)(rp + 128 * bj) = w;
            }
        }
}
__device__ __forceinline__ void epi_gate(const f32x4 (&acc)[2][2][4][2], bf16* O, int ldo, long row0, int col0, int wr, int wc, int fr, int fq) {
#pragma unroll
    for (int ai = 0; ai < 2; ++ai)
#pragma unroll
        for (int m = 0; m < 4; ++m) {
            bf16* rp = O + (size_t)(row0 + 128 * ai + 64 * wr + 16 * m + fr) * ldo + col0 + 32 * wc + 8 * fq;
            float h[8];
#pragma unroll
            for (int n = 0; n < 2; ++n)
#pragma unroll
                for (int j = 0; j < 4; ++j) h[4 * n + j] = siluf_(acc[ai][0][m][n][j]) * acc[ai][1][m][n][j];
            u32x4 w; w.x = cvt_pk_bf16(h[0], h[1]); w.y = cvt_pk_bf16(h[2], h[3]); w.z = cvt_pk_bf16(h[4], h[5]); w.w = cvt_pk_bf16(h[6], h[7]);
            *(u32x4*)rp = w;
        }
}

namespace gf {
constexpr int BM = 256, BK = 64, HALF = 128, HTB = HALF * BK * 2, STAGE_BYTES = 8 * HTB;
__device__ __forceinline__ int lds_byte(int r, int c) { const int st = (r >> 4) * 2 + (c >> 5), rr = r & 15, cc = c & 31, ob = rr * 64 + cc * 2; return st * 1024 + (ob ^ (((ob >> 9) & 1) << 5)); }
__device__ __forceinline__ void stage_rc(int b, int& R, int& C) { const int st = b / 1024, sb = b % 1024, swz = sb ^ (((sb >> 9) & 1) << 5); R = (st >> 1) * 16 + swz / 64; C = (st & 1) * 32 + (swz % 64) / 2; }

struct Unit {
    unsigned A;
    unsigned B;
    const int* rowidx;
    int lda, ldb;
    int nt;
    int keep;
    int kind, r0, c0, x0;
};

typedef int v8i __attribute__((ext_vector_type(8)));
typedef int v4i __attribute__((ext_vector_type(4)));
template <bool GENERAL, int MODE, bool GENB, class Sched, class Epi>
__device__ __forceinline__ void gemm_fast(LAS unsigned char* lds, const unsigned char* ws, const Sched& S, const Epi& E) {
    const __amdgpu_buffer_rsrc_t rsrc = __builtin_amdgcn_make_buffer_rsrc((void*)ws, 0, 0x7ffffff0, 0x00020000);
    int tid = threadIdx.x; asm volatile("" : "+v"(tid));
    const int wid = __builtin_amdgcn_readfirstlane(tid >> 6), lane = tid & 63, wr = wid >> 2, wc = wid & 3, fr = lane & 15, fq = lane >> 4;
    const unsigned ldsw = (unsigned)wid * 1024u;
    const int aoff = lds_byte(wr * 64 + fr, fq * 8), boff = lds_byte(wc * 32 + fr, fq * 8);
    constexpr unsigned kstep = (unsigned)(BK * 2);
#define GF_SA(b, h) (((b) * 2 + (h)) * HTB)
#define GF_SB(b, h) ((4 + (b) * 2 + (h)) * HTB)
#define GF_STAGE(bufoff, soff, o0, o1) do { \
        __builtin_amdgcn_raw_ptr_buffer_load_lds(rsrc, (LAS void*)(lds + (bufoff) + ldsw), 16, (int)(o0), (int)(soff), 0, 0); \
        __builtin_amdgcn_raw_ptr_buffer_load_lds(rsrc, (LAS void*)(lds + (bufoff) + ldsw + 8192), 16, (int)(o1), (int)(soff), 0, 0); } while (0)
#define GF_LDA(dst, b, h) do { _Pragma("unroll") for (int m = 0; m < 4; ++m) _Pragma("unroll") for (int k = 0; k < 2; ++k) dst[m][k] = *(const LAS bf16x8*)(lds + GF_SA(b, h) + aoff + m * 2048 + k * 1024); } while (0)
#define GF_LDB(dst, b, h) do { _Pragma("unroll") for (int n = 0; n < 2; ++n) _Pragma("unroll") for (int k = 0; k < 2; ++k) dst[n][k] = *(const LAS bf16x8*)(lds + GF_SB(b, h) + boff + n * 2048 + k * 1024); } while (0)
#define GF_MMA(ai, bj, At, Bt) do { __builtin_amdgcn_s_setprio(1); \
        if (MODE == 0) { _Pragma("unroll") for (int m = 0; m < 4; ++m) _Pragma("unroll") for (int n = 0; n < 2; ++n) _Pragma("unroll") for (int k = 0; k < 2; ++k) \
            acc[ai][bj][m][n] = __builtin_amdgcn_mfma_f32_16x16x32_bf16(Bt[n][k], At[m][k], acc[ai][bj][m][n], 0, 0, 0); } \
        else { _Pragma("unroll") for (int m = 0; m < 4; ++m) _Pragma("unroll") for (int n = 0; n < 2; ++n) { \
            const v8i a8 = __builtin_shufflevector(__builtin_bit_cast(v4i, At[m][0]), __builtin_bit_cast(v4i, At[m][1]), 0, 1, 2, 3, 4, 5, 6, 7); \
            const v8i b8 = __builtin_shufflevector(__builtin_bit_cast(v4i, Bt[n][0]), __builtin_bit_cast(v4i, Bt[n][1]), 0, 1, 2, 3, 4, 5, 6, 7); \
            acc[ai][bj][m][n] = __builtin_amdgcn_mfma_scale_f32_16x16x128_f8f6f4(b8, a8, acc[ai][bj][m][n], 0, 0, 0, 0x7f7f7f7f, 0, 0x7f7f7f7f); } } \
        __builtin_amdgcn_s_setprio(0); } while (0)
#define GF_WAIT_V(n) asm volatile("s_waitcnt vmcnt(" #n ")" ::: "memory")
#define GF_WAIT_L(n) asm volatile("s_waitcnt lgkmcnt(" #n ")" ::: "memory")
#define GF_BAR __builtin_amdgcn_s_barrier()
#define GF_SCHED __builtin_amdgcn_sched_barrier(0)
#define GF_BROW(h, R) ((MODE == 2) ? (64 * ((R) >> 5) + 16 * (((R) & 15) >> 2) + 8 * (h) + 4 * (((R) >> 4) & 1) + ((R) & 3)) : (HALF * (h) + ((R) & ~31) + perm32((R) & 31)))
#define GF_SETOFF(u, oA, oB) do { \
        int tz = threadIdx.x; asm volatile("" : "+v"(tz)); \
        int R0, C0, R1, C1; stage_rc(tz * 16, R0, C0); stage_rc(tz * 16 + 8192, R1, C1); \
        int g00 = R0, g01 = R1, g10 = HALF + R0, g11 = HALF + R1; \
        if ((u).rowidx) { g00 = (u).rowidx[g00]; g01 = (u).rowidx[g01]; g10 = (u).rowidx[g10]; g11 = (u).rowidx[g11]; } \
        oA[0][0] = (unsigned)g00 * (unsigned)(u).lda + (unsigned)C0 * 2u; oA[0][1] = (unsigned)g01 * (unsigned)(u).lda + (unsigned)C1 * 2u; \
        oA[1][0] = (unsigned)g10 * (unsigned)(u).lda + (unsigned)C0 * 2u; oA[1][1] = (unsigned)g11 * (unsigned)(u).lda + (unsigned)C1 * 2u; \
        oB[0][0] = (unsigned)GF_BROW(0, R0) * (unsigned)(u).ldb + (unsigned)C0 * 2u; oB[0][1] = (unsigned)GF_BROW(0, R1) * (unsigned)(u).ldb + (unsigned)C1 * 2u; \
        oB[1][0] = (unsigned)GF_BROW(1, R0) * (unsigned)(u).ldb + (unsigned)C0 * 2u; oB[1][1] = (unsigned)GF_BROW(1, R1) * (unsigned)(u).ldb + (unsigned)C1 * 2u; } while (0)
    Unit cur, nxt; int ui = 0;
    if (!S.next(0, cur)) return;
    f32x4 acc[2][2][4][2];
#pragma unroll
    for (int a = 0; a < 2; ++a)
#pragma unroll
        for (int b = 0; b < 2; ++b)
#pragma unroll
            for (int m = 0; m < 4; ++m)
#pragma unroll
                for (int n = 0; n < 2; ++n) acc[a][b][m][n] = (f32x4){0.f, 0.f, 0.f, 0.f};
    bf16x8 At[4][2], B0[2][2], B1[2][2];
    unsigned oAc[2][2], oBc[2][2];
    GF_SETOFF(cur, oAc, oBc);
    LAS u32x4* stash = (LAS u32x4*)(lds + STAGE_BYTES) + 2 * tid;
    unsigned cA = cur.A, cB = cur.B;
    GF_STAGE(GF_SB(0, 0), cB, oBc[0][0], oBc[0][1]); GF_STAGE(GF_SA(0, 0), cA, oAc[0][0], oAc[0][1]); GF_STAGE(GF_SB(0, 1), cB, oBc[1][0], oBc[1][1]); GF_STAGE(GF_SA(0, 1), cA, oAc[1][0], oAc[1][1]);
    if (wr == 1) GF_BAR;
    GF_WAIT_V(4); GF_BAR;
    GF_STAGE(GF_SB(1, 0), cB + kstep, oBc[0][0], oBc[0][1]); GF_STAGE(GF_SA(1, 0), cA + kstep, oAc[0][0], oAc[0][1]); GF_STAGE(GF_SB(1, 1), cB + kstep, oBc[1][0], oBc[1][1]);
    GF_WAIT_V(6); GF_BAR;
    for (;;) {
        const bool has_next = S.next(ui + 1, nxt);
        unsigned nA, nB;
        if (has_next) { nA = nxt.A; nB = nxt.B; } else { nA = cA; nB = cB; }
        if (GENERAL) {
            unsigned tA[2][2], tB[2][2];
            if (has_next) { GF_SETOFF(nxt, tA, tB); }
            else {
#pragma unroll
                for (int h = 0; h < 2; ++h)
#pragma unroll
                    for (int i = 0; i < 2; ++i) { tA[h][i] = oAc[h][i]; tB[h][i] = oBc[h][i]; } }
            stash[0] = (u32x4){tA[0][0], tA[0][1], tA[1][0], tA[1][1]};
            if (GENB) stash[1] = (u32x4){tB[0][0], tB[0][1], tB[1][0], tB[1][1]};
        }
        const int nt = cur.nt;
#pragma unroll 1
        for (int t = 0; t < nt; t += 2) {
            const bool last = (t == nt - 2);
            const unsigned a1 = cA + (unsigned)(t + 1) * kstep;
            const unsigned a2 = last ? nA : cA + (unsigned)(t + 2) * kstep, b2 = last ? nB : cB + (unsigned)(t + 2) * kstep;
            const unsigned a3 = a2 + kstep, b3 = b2 + kstep;
            GF_LDB(B0, 0, 0); GF_SCHED; GF_LDA(At, 0, 0); GF_STAGE(GF_SA(1, 1), a1, oAc[1][0], oAc[1][1]);
            if (GENERAL && last) {
                const u32x4 sa = stash[0]; oAc[0][0] = sa.x; oAc[0][1] = sa.y; oAc[1][0] = sa.z; oAc[1][1] = sa.w;
                if (GENB) { const u32x4 sb = stash[1]; oBc[0][0] = sb.x; oBc[0][1] = sb.y; oBc[1][0] = sb.z; oBc[1][1] = sb.w; }
            }
            GF_WAIT_L(8); GF_BAR; GF_WAIT_L(0); GF_MMA(0, 0, At, B0); GF_BAR; GF_SCHED;
            GF_LDB(B1, 0, 1); GF_STAGE(GF_SB(0, 0), b2, oBc[0][0], oBc[0][1]);
            GF_BAR; GF_WAIT_L(0); GF_MMA(0, 1, At, B1); GF_BAR;
            GF_LDA(At, 0, 1); GF_STAGE(GF_SA(0, 0), a2, oAc[0][0], oAc[0][1]);
            GF_BAR; GF_WAIT_L(0); GF_MMA(1, 0, At, B0); GF_BAR; GF_SCHED;
            GF_STAGE(GF_SB(0, 1), b2, oBc[1][0], oBc[1][1]);
            GF_WAIT_V(6); GF_BAR; GF_MMA(1, 1, At, B1); GF_BAR;
            GF_LDB(B0, 1, 0); GF_SCHED; GF_LDA(At, 1, 0); GF_STAGE(GF_SA(0, 1), a2, oAc[1][0], oAc[1][1]);
            GF_WAIT_L(8); GF_BAR; GF_WAIT_L(0); GF_MMA(0, 0, At, B0); GF_BAR; GF_SCHED;
            GF_LDB(B1, 1, 1); GF_STAGE(GF_SB(1, 0), b3, oBc[0][0], oBc[0][1]);
            GF_BAR; GF_WAIT_L(0); GF_MMA(0, 1, At, B1); GF_BAR;
            GF_LDA(At, 1, 1); GF_STAGE(GF_SA(1, 0), a3, oAc[0][0], oAc[0][1]);
            GF_BAR; GF_WAIT_L(0); GF_MMA(1, 0, At, B0); GF_BAR; GF_SCHED;
            GF_STAGE(GF_SB(1, 1), b3, oBc[1][0], oBc[1][1]);
            GF_WAIT_V(6); GF_BAR; GF_MMA(1, 1, At, B1); GF_BAR;
        }
        {
            int tz = threadIdx.x; asm volatile("" : "+v"(tz) :: "memory");
            const int ewid = __builtin_amdgcn_readfirstlane(tz >> 6), el = tz & 63;
            E(acc, cur, ewid >> 2, ewid & 3, el & 15, el >> 4);
            asm volatile("" ::: "memory");
        }
        if (!has_next) break;
        if (!cur.keep) {
#pragma unroll
            for (int a = 0; a < 2; ++a)
#pragma unroll
                for (int b = 0; b < 2; ++b)
#pragma unroll
                    for (int m = 0; m < 4; ++m)
#pragma unroll
                        for (int n = 0; n < 2; ++n) acc[a][b][m][n] = (f32x4){0.f, 0.f, 0.f, 0.f};
        }
        cur = nxt; cA = nA; cB = nB; ++ui;
    }
    GF_WAIT_V(0);
    if (wr == 0) GF_BAR;
    GF_BAR;
#undef GF_SA
#undef GF_SB
#undef GF_STAGE
#undef GF_LDA
#undef GF_LDB
#undef GF_MMA
#undef GF_WAIT_V
#undef GF_WAIT_L
#undef GF_BAR
#undef GF_SCHED
#undef GF_SETOFF
#undef GF_BROW
}
}

__device__ __forceinline__ int uload(const int* p) { return __builtin_amdgcn_readfirstlane(__hip_atomic_load(p, __ATOMIC_RELAXED, __HIP_MEMORY_SCOPE_AGENT)); }
__device__ __forceinline__ int vcu_of(int bid, int nb) { return (nb % 8 == 0) ? (bid % 8) * (nb / 8) + bid / 8 : bid; }

struct SchedPlain {
    unsigned A, B; int lda, ldb, nt, nN, nU, G, c; long r0base;
    __device__ __forceinline__ bool next(int i, gf::Unit& u) const {
        const int L = i * G + c; if (L >= nU) return false;
        const int pm = L / nN, pn = L % nN;
        u.A = A + (unsigned)pm * 256u * lda; u.B = B + (unsigned)pn * 256u * ldb; u.rowidx = nullptr; u.lda = lda; u.ldb = ldb; u.nt = nt; u.keep = 0;
        u.kind = 0; u.r0 = (int)(r0base + pm * 256); u.c0 = pn * 256; u.x0 = 0; return true;
    }
};
struct EpiProj { bf16* O; __device__ __forceinline__ void operator()(f32x4 (&acc)[2][2][4][2], const gf::Unit& u, int wr, int wc, int fr, int fq) const { epi_bf16(acc, O, INW, u.r0, u.c0, wr, wc, fr, fq); } };
struct SchedProjPP {
    int G, c;
    __device__ __forceinline__ bool next(int i, gf::Unit& u) const {
        constexpr int nN = INW / 256, nProj = (T / 256) * nN, nPP = (T / 256) * 4;
        const int R = nProj / G, rem = nProj % G;
        u.rowidx = nullptr; u.keep = 0; u.x0 = 0;
        const int L = i * G + c;
        if (i < R || (i == R && c < rem)) { const int pm = L / nN, pn = L % nN;
            u.A = (unsigned)WS_XB + (unsigned)pm * 256u * (D * 2); u.B = (unsigned)WS_WINT + (unsigned)pn * 256u * (D * 2); u.lda = D * 2; u.ldb = D * 2; u.nt = D / 64; u.kind = 0; u.r0 = pm * 256; u.c0 = pn * 256; return true; }
        const int nw = G - rem, per = (nPP + nw - 1) / nw, j = i - R;
        if (c < rem || j >= per) return false;
        const int idx = (c - rem) * per + j; if (idx >= nPP) return false;
        const int pm = idx >> 2, pn = idx & 3;
        u.A = (unsigned)WS_PB + (unsigned)pm * 256u * (PLE * 2); u.B = (unsigned)WS_WPT + (unsigned)pn * 256u * (PLE * 2); u.lda = PLE * 2; u.ldb = PLE * 2; u.nt = PLE / 64; u.kind = 1; u.r0 = pm * 256; u.c0 = pn * 256; return true;
    }
};
struct EpiProjPP { bf16* proj; bf16* pp;
    __device__ __forceinline__ void operator()(f32x4 (&acc)[2][2][4][2], const gf::Unit& u, int wr, int wc, int fr, int fq) const {
        if (u.kind == 0) epi_bf16(acc, proj, INW, u.r0, u.c0, wr, wc, fr, fq); else epi_bf16(acc, pp, D, u.r0, u.c0, wr, wc, fr, fq);
    }
};
__device__ void phase_proj(const Args& a, LAS unsigned char* lds, int bid, int nb) {
    SchedProjPP S{nb, vcu_of(bid, nb)};
    EpiProjPP E{(bf16*)(a.ws + WS_BIG), (bf16*)(a.ws + WS_PP)};
    gf::gemm_fast<true, 0, true>(lds, a.ws, S, E);
}

struct EpiWout { const float* x; float* y;
    __device__ __forceinline__ void operator()(f32x4 (&acc)[2][2][4][2], const gf::Unit& u, int wr, int wc, int fr, int fq) const {
#pragma unroll
        for (int ai = 0; ai < 2; ++ai)
#pragma unroll
            for (int mp = 0; mp < 2; ++mp) {
                f32x4 xv[2][2][2];
#pragma unroll
                for (int mm = 0; mm < 2; ++mm) { const int m = 2 * mp + mm;
                    const size_t off = (size_t)(u.r0 + 128 * ai + 64 * wr + 16 * m + fr) * D + u.c0 + 32 * wc + 8 * fq;
#pragma unroll
                    for (int bj = 0; bj < 2; ++bj)
#pragma unroll
                        for (int n = 0; n < 2; ++n) xv[mm][bj][n] = *(const f32x4*)(x + off + 128 * bj + 4 * n); }
#pragma unroll
                for (int mm = 0; mm < 2; ++mm) { const int m = 2 * mp + mm;
                    const size_t off = (size_t)(u.r0 + 128 * ai + 64 * wr + 16 * m + fr) * D + u.c0 + 32 * wc + 8 * fq;
#pragma unroll
                    for (int bj = 0; bj < 2; ++bj)
#pragma unroll
                        for (int n = 0; n < 2; ++n) *(f32x4*)(y + off + 128 * bj + 4 * n) = acc[ai][bj][m][n] + ALPHA * xv[mm][bj][n]; }
                asm volatile("" ::: "memory"); __builtin_amdgcn_sched_barrier(0);
            }
    }
};
__device__ void phase_wout(const Args& a, LAS unsigned char* lds, int bid, int nb) {
    SchedPlain S{(unsigned)WS_MIXO, (unsigned)WS_WOUTT, D * 2, D * 2, D / 64, D / 256, (T / 256) * (D / 256), nb, vcu_of(bid, nb), 0};
    EpiWout E{a.in[I_X], a.out};
    gf::gemm_fast<false, 0, false>(lds, a.ws, S, E);
}

constexpr int QS = 72;
constexpr int TS = 136;
constexpr int TS2 = 264;
constexpr int L_QS = 0;
constexpr int L_KS = L_QS + 128 * QS * 2;
constexpr int L_KTW = L_KS + 256 * QS * 2;
constexpr int L_VT = L_KTW + 64 * TS * 2;
constexpr int L_ST = L_VT + 64 * TS2 * 2;
constexpr int L_MIX_END = L_ST + 64 * QS * 2;
static_assert(L_MIX_END <= 128 * 1024, "mixer LDS");

__device__ __forceinline__ void stage_ret(const Args& a, LAS unsigned char* lds, int b, int h, int n, bool want_q, float l2g) {
    const int tid = hidden_tid();
    const bf16* proj = (const bf16*)(a.ws + WS_BIG);
    const float* tab = (const float*)(a.ws + WS_TAB);
    const float* cosr = tab, *sinr = tab + SEQ * 32;
    LAS bf16* Qs = (LAS bf16*)(lds + L_QS); LAS bf16* Ks = (LAS bf16*)(lds + L_KS); LAS bf16* Ktw = (LAS bf16*)(lds + L_KTW); LAS bf16* Vt = (LAS bf16*)(lds + L_VT);
    const int row = tid >> 2, i0 = (tid & 3) * 8;
    const int pos = n * CH + row;
    const size_t t = (size_t)b * SEQ + pos;
    const bf16* prow = proj + t * INW;
    f32x4 c0 = *(const f32x4*)(cosr + pos * 32 + i0), c1 = *(const f32x4*)(cosr + pos * 32 + i0 + 4);
    f32x4 s0 = *(const f32x4*)(sinr + pos * 32 + i0), s1 = *(const f32x4*)(sinr + pos * 32 + i0 + 4);
    float cs[8] = {c0[0], c0[1], c0[2], c0[3], c1[0], c1[1], c1[2], c1[3]}, sn[8] = {s0[0], s0[1], s0[2], s0[3], s1[0], s1[1], s1[2], s1[3]};
    if (want_q) {
        const bf16x8 x1 = *(const bf16x8*)(prow + C_RQ + h * 64 + i0), x2 = *(const bf16x8*)(prow + C_RQ + h * 64 + 32 + i0);
        float o1[8], o2[8];
#pragma unroll
        for (int j = 0; j < 8; ++j) { const float a1 = bf2f((unsigned short)x1[j]), a2 = bf2f((unsigned short)x2[j]); o1[j] = a1 * cs[j] - a2 * sn[j]; o2[j] = a2 * cs[j] + a1 * sn[j]; }
        u32x4 w1, w2;
        w1.x = cvt_pk_bf16(o1[0], o1[1]); w1.y = cvt_pk_bf16(o1[2], o1[3]); w1.z = cvt_pk_bf16(o1[4], o1[5]); w1.w = cvt_pk_bf16(o1[6], o1[7]);
        w2.x = cvt_pk_bf16(o2[0], o2[1]); w2.y = cvt_pk_bf16(o2[2], o2[3]); w2.z = cvt_pk_bf16(o2[4], o2[5]); w2.w = cvt_pk_bf16(o2[6], o2[7]);
        *(LAS u32x4*)(Qs + row * QS + i0) = w1; *(LAS u32x4*)(Qs + row * QS + 32 + i0) = w2;
    }
    {
        const bf16x8 x1 = *(const bf16x8*)(prow + C_RK + h * 64 + i0), x2 = *(const bf16x8*)(prow + C_RK + h * 64 + 32 + i0);
        const float kw = exp2f((float)(CH - 1 - row) * l2g);
        float o1[8], o2[8];
#pragma unroll
        for (int j = 0; j < 8; ++j) { const float a1 = bf2f((unsigned short)x1[j]), a2 = bf2f((unsigned short)x2[j]); o1[j] = (a1 * cs[j] - a2 * sn[j]) * 0.125f; o2[j] = (a2 * cs[j] + a1 * sn[j]) * 0.125f; }
        if (want_q) {
            u32x4 w1, w2;
            w1.x = cvt_pk_bf16(o1[0], o1[1]); w1.y = cvt_pk_bf16(o1[2], o1[3]); w1.z = cvt_pk_bf16(o1[4], o1[5]); w1.w = cvt_pk_bf16(o1[6], o1[7]);
            w2.x = cvt_pk_bf16(o2[0], o2[1]); w2.y = cvt_pk_bf16(o2[2], o2[3]); w2.z = cvt_pk_bf16(o2[4], o2[5]); w2.w = cvt_pk_bf16(o2[6], o2[7]);
            *(LAS u32x4*)(Ks + row * QS + i0) = w1; *(LAS u32x4*)(Ks + row * QS + 32 + i0) = w2;
        }
#pragma unroll
        for (int j = 0; j < 8; ++j) { Ktw[(i0 + j) * TS + row] = f2bf(o1[j] * kw); Ktw[(32 + i0 + j) * TS + row] = f2bf(o2[j] * kw); }
    }
    {
        const bf16x8 v1 = *(const bf16x8*)(prow + C_RV + h * 64 + i0), v2 = *(const bf16x8*)(prow + C_RV + h * 64 + 32 + i0);
#pragma unroll
        for (int j = 0; j < 8; ++j) { Vt[(i0 + j) * TS2 + row] = (bf16)v1[j]; Vt[(32 + i0 + j) * TS2 + row] = (bf16)v2[j]; }
    }
}
__device__ __forceinline__ void ret_kv(LAS unsigned char* lds, int wid, int fr, int fq, f32x4 (&kv)[2]) {
    LAS bf16* Ktw = (LAS bf16*)(lds + L_KTW); LAS bf16* Vt = (LAS bf16*)(lds + L_VT);
#pragma unroll
    for (int i = 0; i < 2; ++i) {
        const int tl = 2 * wid + i, dt = tl >> 2, et = tl & 3;
        f32x4 c = {0.f, 0.f, 0.f, 0.f};
#pragma unroll
        for (int ks = 0; ks < 4; ++ks) {
            const bf16x8 kf = *(const LAS bf16x8*)(Ktw + (16 * dt + fr) * TS + 32 * ks + 8 * fq);
            const bf16x8 vf = *(const LAS bf16x8*)(Vt + (16 * et + fr) * TS2 + 32 * ks + 8 * fq);
            c = __builtin_amdgcn_mfma_f32_16x16x32_bf16(kf, vf, c, 0, 0, 0);
        }
        kv[i] = c;
    }
}
__device__ __forceinline__ float head_l2g(int h) { return log2f(1.0f - exp2f(-5.0f - (float)h)); }

__device__ void phase_segtot(const Args& a, LAS unsigned char* lds, int bid, int nb) {
    WAVE_IDS();
    float* segt = (float*)(a.ws + WS_SEGT);
    for (int it = bid; it < BATCH * RH * NSEG; it += nb) {
        const int seg = it % NSEG, h = (it / NSEG) % RH, b = it / (NSEG * RH);
        const float l2g = head_l2g(h), cd = exp2f(128.0f * l2g);
        f32x4 S[2] = {{0.f, 0.f, 0.f, 0.f}, {0.f, 0.f, 0.f, 0.f}};
        for (int c = 0; c < SEGC; ++c) {
            __syncthreads();
            stage_ret(a, lds, b, h, seg * SEGC + c, false, l2g);
            __syncthreads();
            f32x4 kv[2]; ret_kv(lds, wid, fr, fq, kv);
            S[0] = S[0] * cd + kv[0]; S[1] = S[1] * cd + kv[1];
        }
        float* dst = segt + (size_t)((b * RH + h) * NSEG + seg) * 4096;
#pragma unroll
        for (int i = 0; i < 2; ++i) { const int tl = 2 * wid + i, dt = tl >> 2, et = tl & 3;
#pragma unroll
            for (int j = 0; j < 4; ++j) dst[(16 * dt + 4 * fq + j) * 64 + 16 * et + fr] = S[i][j]; }
    }
}

__device__ void phase_retention(const Args& a, LAS unsigned char* lds, int bid, int nb) {
    WAVE_IDS();
    const float* segt = (const float*)(a.ws + WS_SEGT);
    const bf16* proj = (const bf16*)(a.ws + WS_BIG);
    bf16* mixo = (bf16*)(a.ws + WS_MIXO);
    const float* gain = a.in[I_GN];
    LAS bf16* Qs = (LAS bf16*)(lds + L_QS); LAS bf16* Ks = (LAS bf16*)(lds + L_KS); LAS bf16* Vt = (LAS bf16*)(lds + L_VT); LAS bf16* St = (LAS bf16*)(lds + L_ST);
    for (int it = bid; it < BATCH * RH * NSEG; it += nb) {
        const int seg = it % NSEG, h = (it / NSEG) % RH, b = it / (NSEG * RH);
        const float l2g = head_l2g(h), cd = exp2f(128.0f * l2g);
        f32x4 S[2] = {{0.f, 0.f, 0.f, 0.f}, {0.f, 0.f, 0.f, 0.f}};
        for (int sp = 0; sp < seg; ++sp) {
            const float wgt = exp2f(128.0f * l2g * (float)(SEGC * (seg - 1 - sp)));
            const float* src = segt + (size_t)((b * RH + h) * NSEG + sp) * 4096;
#pragma unroll
            for (int i = 0; i < 2; ++i) { const int tl = 2 * wid + i, dt = tl >> 2, et = tl & 3;
#pragma unroll
                for (int j = 0; j < 4; ++j) S[i][j] += wgt * src[(16 * dt + 4 * fq + j) * 64 + 16 * et + fr]; }
        }
        for (int c = 0; c < SEGC; ++c) {
            const int n = seg * SEGC + c;
            __syncthreads();
            stage_ret(a, lds, b, h, n, true, l2g);
#pragma unroll
            for (int i = 0; i < 2; ++i) { const int tl = 2 * wid + i, dt = tl >> 2, et = tl & 3;
                u32x2 w; w.x = cvt_pk_bf16(S[i][0], S[i][1]); w.y = cvt_pk_bf16(S[i][2], S[i][3]);
                *(LAS u32x2*)(St + (16 * et + fr) * QS + 16 * dt + 4 * fq) = w; }
            __syncthreads();
            bf16x8 qf[2];
#pragma unroll
            for (int ks = 0; ks < 2; ++ks) qf[ks] = *(const LAS bf16x8*)(Qs + (16 * wid + fr) * QS + 32 * ks + 8 * fq);
            f32x4 sc[8];
#pragma unroll
            for (int jt = 0; jt < 8; ++jt) {
                sc[jt] = (f32x4){0.f, 0.f, 0.f, 0.f};
                if (jt <= wid) {
#pragma unroll
                    for (int ks = 0; ks < 2; ++ks) {
                        const bf16x8 kf = *(const LAS bf16x8*)(Ks + (16 * jt + fr) * QS + 32 * ks + 8 * fq);
                        sc[jt] = __builtin_amdgcn_mfma_f32_16x16x32_bf16(kf, qf[ks], sc[jt], 0, 0, 0);
                    }
                    const int i = 16 * wid + fr;
#pragma unroll
                    for (int r = 0; r < 4; ++r) { const int j = 16 * jt + 4 * fq + r; const float dcy = exp2f((float)(i - j) * l2g); sc[jt][r] = (i >= j) ? sc[jt][r] * dcy : 0.f; }
                    asm volatile("" : "+v"(sc[jt]) :: "memory");
                }
            }
            f32x4 o[4], oi[4];
#pragma unroll
            for (int et = 0; et < 4; ++et) { o[et] = (f32x4){0.f, 0.f, 0.f, 0.f}; oi[et] = (f32x4){0.f, 0.f, 0.f, 0.f}; }
#pragma unroll
            for (int k2 = 0; k2 < 4; ++k2) {
                if (2 * k2 <= wid) {
                    bf16x8 pf; u32x4 pw;
                    pw.x = cvt_pk_bf16(sc[2 * k2][0], sc[2 * k2][1]); pw.y = cvt_pk_bf16(sc[2 * k2][2], sc[2 * k2][3]);
                    pw.z = cvt_pk_bf16(sc[2 * k2 + 1][0], sc[2 * k2 + 1][1]); pw.w = cvt_pk_bf16(sc[2 * k2 + 1][2], sc[2 * k2 + 1][3]);
                    pf = __builtin_bit_cast(bf16x8, pw);
#pragma unroll
                    for (int et = 0; et < 4; ++et) {
                        const u32x2 va = *(const LAS u32x2*)(Vt + (16 * et + fr) * TS2 + 32 * k2 + 4 * fq);
                        const u32x2 vb = *(const LAS u32x2*)(Vt + (16 * et + fr) * TS2 + 32 * k2 + 16 + 4 * fq);
                        u32x4 vw; vw.x = va.x; vw.y = va.y; vw.z = vb.x; vw.w = vb.y;
                        o[et] = __builtin_amdgcn_mfma_f32_16x16x32_bf16(__builtin_bit_cast(bf16x8, vw), pf, o[et], 0, 0, 0);
                    }
                }
            }
#pragma unroll
            for (int et = 0; et < 4; ++et)
#pragma unroll
                for (int ks = 0; ks < 2; ++ks) {
                    const bf16x8 sf = *(const LAS bf16x8*)(St + (16 * et + fr) * QS + 32 * ks + 8 * fq);
                    oi[et] = __builtin_amdgcn_mfma_f32_16x16x32_bf16(sf, qf[ks], oi[et], 0, 0, 0);
                }
            {
                const int i = 16 * wid + fr;
                const float qw = exp2f((float)(i + 1) * l2g);
                float sum = 0.f;
#pragma unroll
                for (int et = 0; et < 4; ++et)
#pragma unroll
                    for (int r = 0; r < 4; ++r) { o[et][r] += qw * oi[et][r]; sum += o[et][r]; }
                sum += __shfl_xor(sum, 16); sum += __shfl_xor(sum, 32);
                const float mean = sum * (1.0f / 64.0f);
                float q = 0.f;
#pragma unroll
                for (int et = 0; et < 4; ++et)
#pragma unroll
                    for (int r = 0; r < 4; ++r) { const float d = o[et][r] - mean; q += d * d; }
                q += __shfl_xor(q, 16); q += __shfl_xor(q, 32);
                const float rstd = rsqrtf(q * (1.0f / 64.0f) + GN_EPS);
                const size_t t = (size_t)b * SEQ + n * CH + i;
#pragma unroll
                for (int et = 0; et < 4; ++et) {
                    const int e0 = 16 * et + 4 * fq;
                    const u32x2 gw = *(const u32x2*)(proj + t * INW + C_RG + h * 64 + e0);
                    const f32x4 gn = *(const f32x4*)(gain + h * 64 + e0);
                    const float g0 = bf2f(gw.x & 0xffffu), g1 = bf2f(gw.x >> 16), g2 = bf2f(gw.y & 0xffffu), g3 = bf2f(gw.y >> 16);
                    const float y0 = (o[et][0] - mean) * rstd * gn[0] * siluf_(g0), y1 = (o[et][1] - mean) * rstd * gn[1] * siluf_(g1);
                    const float y2 = (o[et][2] - mean) * rstd * gn[2] * siluf_(g2), y3 = (o[et][3] - mean) * rstd * gn[3] * siluf_(g3);
                    u32x2 w; w.x = cvt_pk_bf16(y0, y1); w.y = cvt_pk_bf16(y2, y3);
                    *(u32x2*)(mixo + t * D + h * 64 + e0) = w;
                }
            }
            f32x4 kv[2]; ret_kv(lds, wid, fr, fq, kv);
            S[0] = S[0] * cd + kv[0]; S[1] = S[1] * cd + kv[1];
        }
    }
}

__device__ void phase_swa(const Args& a, LAS unsigned char* lds, int bid, int nb) {
    WAVE_IDS();
    const bf16* proj = (const bf16*)(a.ws + WS_BIG);
    bf16* mixo = (bf16*)(a.ws + WS_MIXO);
    const float* tab = (const float*)(a.ws + WS_TAB);
    const float* coss = tab + SEQ * 64, *sins = tab + SEQ * 72;
    const float* ascale = a.in[I_ASC]; const float* sinks = a.in[I_SINK];
    LAS bf16* Qs = (LAS bf16*)(lds + L_QS); LAS bf16* Ks = (LAS bf16*)(lds + L_KS); LAS bf16* Vt = (LAS bf16*)(lds + L_VT);
    for (int it = bid; it < BATCH * NCH * QH; it += nb) {
        const int qh = it % QH, n = (it / QH) % NCH, b = it / (QH * NCH), kvh = qh >> 2;
        __syncthreads();
        {
            const int row = tid >> 2, cg = tid & 3, pos = n * CH + row;
            const bf16* src = proj + ((size_t)b * SEQ + pos) * INW + C_AQ + qh * 64 + cg * 16;
            bf16x8 x1 = *(const bf16x8*)src, x2 = *(const bf16x8*)(src + 8);
            if (cg == 0) {
                const f32x4 c0 = *(const f32x4*)(coss + pos * 8), c1 = *(const f32x4*)(coss + pos * 8 + 4), s0 = *(const f32x4*)(sins + pos * 8), s1 = *(const f32x4*)(sins + pos * 8 + 4);
                const float cs[8] = {c0[0], c0[1], c0[2], c0[3], c1[0], c1[1], c1[2], c1[3]}, sn[8] = {s0[0], s0[1], s0[2], s0[3], s1[0], s1[1], s1[2], s1[3]};
                float o1[8], o2[8];
#pragma unroll
                for (int j = 0; j < 8; ++j) { const float a1 = bf2f((unsigned short)x1[j]), a2 = bf2f((unsigned short)x2[j]); o1[j] = a1 * cs[j] - a2 * sn[j]; o2[j] = a2 * cs[j] + a1 * sn[j]; }
                u32x4 w1, w2;
                w1.x = cvt_pk_bf16(o1[0], o1[1]); w1.y = cvt_pk_bf16(o1[2], o1[3]); w1.z = cvt_pk_bf16(o1[4], o1[5]); w1.w = cvt_pk_bf16(o1[6], o1[7]);
                w2.x = cvt_pk_bf16(o2[0], o2[1]); w2.y = cvt_pk_bf16(o2[2], o2[3]); w2.z = cvt_pk_bf16(o2[4], o2[5]); w2.w = cvt_pk_bf16(o2[6], o2[7]);
                x1 = __builtin_bit_cast(bf16x8, w1); x2 = __builtin_bit_cast(bf16x8, w2);
            }
            *(LAS bf16x8*)(Qs + row * QS + cg * 16) = x1; *(LAS bf16x8*)(Qs + row * QS + cg * 16 + 8) = x2;
        }
#pragma unroll
        for (int rep = 0; rep < 2; ++rep) {
            const int q = tid + rep * NTHREADS, kj = q >> 2, cg = q & 3, pos = n * CH - CH + kj;
            bf16x8 k1 = {0, 0, 0, 0, 0, 0, 0, 0}, k2 = k1, v1 = k1, v2 = k1;
            if (pos >= 0) {
                const bf16* srow = proj + ((size_t)b * SEQ + pos) * INW;
                k1 = *(const bf16x8*)(srow + C_AK + kvh * 64 + cg * 16); k2 = *(const bf16x8*)(srow + C_AK + kvh * 64 + cg * 16 + 8);
                v1 = *(const bf16x8*)(srow + C_AV + kvh * 64 + cg * 16); v2 = *(const bf16x8*)(srow + C_AV + kvh * 64 + cg * 16 + 8);
                if (cg == 0) {
                    const f32x4 c0 = *(const f32x4*)(coss + pos * 8), c1 = *(const f32x4*)(coss + pos * 8 + 4), s0 = *(const f32x4*)(sins + pos * 8), s1 = *(const f32x4*)(sins + pos * 8 + 4);
                    const float cs[8] = {c0[0], c0[1], c0[2], c0[3], c1[0], c1[1], c1[2], c1[3]}, sn[8] = {s0[0], s0[1], s0[2], s0[3], s1[0], s1[1], s1[2], s1[3]};
                    float o1[8], o2[8];
#pragma unroll
                    for (int j = 0; j < 8; ++j) { const float a1 = bf2f((unsigned short)k1[j]), a2 = bf2f((unsigned short)k2[j]); o1[j] = a1 * cs[j] - a2 * sn[j]; o2[j] = a2 * cs[j] + a1 * sn[j]; }
                    u32x4 w1, w2;
                    w1.x = cvt_pk_bf16(o1[0], o1[1]); w1.y = cvt_pk_bf16(o1[2], o1[3]); w1.z = cvt_pk_bf16(o1[4], o1[5]); w1.w = cvt_pk_bf16(o1[6], o1[7]);
                    w2.x = cvt_pk_bf16(o2[0], o2[1]); w2.y = cvt_pk_bf16(o2[2], o2[3]); w2.z = cvt_pk_bf16(o2[4], o2[5]); w2.w = cvt_pk_bf16(o2[6], o2[7]);
                    k1 = __builtin_bit_cast(bf16x8, w1); k2 = __builtin_bit_cast(bf16x8, w2);
                }
            }
            *(LAS bf16x8*)(Ks + kj * QS + cg * 16) = k1; *(LAS bf16x8*)(Ks + kj * QS + cg * 16 + 8) = k2;
#pragma unroll
            for (int j = 0; j < 8; ++j) { Vt[(cg * 16 + j) * TS2 + kj] = (bf16)v1[j]; Vt[(cg * 16 + 8 + j) * TS2 + kj] = (bf16)v2[j]; }
        }
        __syncthreads();
        const int jt0 = wid & ~1;
        bf16x8 qf[2];
#pragma unroll
        for (int ks = 0; ks < 2; ++ks) qf[ks] = *(const LAS bf16x8*)(Qs + (16 * wid + fr) * QS + 32 * ks + 8 * fq);
        f32x4 sc[10];
        const int i = 16 * wid + fr;
        float mx = sinks[qh];
#pragma unroll
        for (int tt = 0; tt < 10; ++tt) {
            const int jt = jt0 + tt;
            f32x4 c = {0.f, 0.f, 0.f, 0.f};
#pragma unroll
            for (int ks = 0; ks < 2; ++ks) {
                const bf16x8 kf = *(const LAS bf16x8*)(Ks + (16 * jt + fr) * QS + 32 * ks + 8 * fq);
                c = __builtin_amdgcn_mfma_f32_16x16x32_bf16(kf, qf[ks], c, 0, 0, 0);
            }
#pragma unroll
            for (int r = 0; r < 4; ++r) {
                const int kj = 16 * jt + 4 * fq + r;
                const bool valid = (kj > i) && (kj <= i + CH) && (n * CH - CH + kj >= 0);
                c[r] = valid ? c[r] * 0.125f : -1e30f;
                mx = fmaxf(mx, c[r]);
            }
            sc[tt] = c;
        }
        mx = fmaxf(mx, __shfl_xor(mx, 16)); mx = fmaxf(mx, __shfl_xor(mx, 32));
        float den = 0.f;
#pragma unroll
        for (int tt = 0; tt < 10; ++tt)
#pragma unroll
            for (int r = 0; r < 4; ++r) { const float p = (sc[tt][r] > -1e29f) ? __expf(sc[tt][r] - mx) : 0.f; sc[tt][r] = p; den += p; }
        den += __shfl_xor(den, 16); den += __shfl_xor(den, 32);
        den += __expf(sinks[qh] - mx);
        const float inv = 1.0f / den;
        f32x4 o[4];
#pragma unroll
        for (int et = 0; et < 4; ++et) o[et] = (f32x4){0.f, 0.f, 0.f, 0.f};
#pragma unroll
        for (int k2 = 0; k2 < 5; ++k2) {
            u32x4 pw;
            pw.x = cvt_pk_bf16(sc[2 * k2][0] * inv, sc[2 * k2][1] * inv); pw.y = cvt_pk_bf16(sc[2 * k2][2] * inv, sc[2 * k2][3] * inv);
            pw.z = cvt_pk_bf16(sc[2 * k2 + 1][0] * inv, sc[2 * k2 + 1][1] * inv); pw.w = cvt_pk_bf16(sc[2 * k2 + 1][2] * inv, sc[2 * k2 + 1][3] * inv);
            const bf16x8 pf = __builtin_bit_cast(bf16x8, pw);
            const int kb = 16 * (jt0 + 2 * k2);
#pragma unroll
            for (int et = 0; et < 4; ++et) {
                const u32x2 va = *(const LAS u32x2*)(Vt + (16 * et + fr) * TS2 + kb + 4 * fq);
                const u32x2 vb = *(const LAS u32x2*)(Vt + (16 * et + fr) * TS2 + kb + 16 + 4 * fq);
                u32x4 vw; vw.x = va.x; vw.y = va.y; vw.z = vb.x; vw.w = vb.y;
                o[et] = __builtin_amdgcn_mfma_f32_16x16x32_bf16(__builtin_bit_cast(bf16x8, vw), pf, o[et], 0, 0, 0);
            }
        }
        const size_t t = (size_t)b * SEQ + n * CH + i;
#pragma unroll
        for (int et = 0; et < 4; ++et) {
            const int e0 = 16 * et + 4 * fq;
            const f32x4 as = *(const f32x4*)(ascale + qh * 64 + e0);
            u32x2 w; w.x = cvt_pk_bf16(o[et][0] * as[0], o[et][1] * as[1]); w.y = cvt_pk_bf16(o[et][2] * as[2], o[et][3] * as[3]);
            *(u32x2*)(mixo + t * D + 512 + qh * 64 + e0) = w;
        }
    }
}

template <int MODE>
__device__ void phase_ln(const float* src, const float* g, const float* bta, bf16* dstb, unsigned char* dstq, float* dstf, int bid, int nb) {
    const int tid = hidden_tid(), wid = tid >> 6, lane = tid & 63;
    f32x4 gv[4], bv[4];
#pragma unroll
    for (int i = 0; i < 4; ++i) { gv[i] = *(const f32x4*)(g + 256 * i + lane * 4); bv[i] = *(const f32x4*)(bta + 256 * i + lane * 4); }
    for (int row = bid * 8 + wid; row < T; row += nb * 8) {
        const float* r = src + (size_t)row * D;
        f32x4 v[4]; float s = 0.f;
#pragma unroll
        for (int i = 0; i < 4; ++i) { v[i] = *(const f32x4*)(r + 256 * i + lane * 4); s += (v[i][0] + v[i][1]) + (v[i][2] + v[i][3]); }
#pragma unroll
        for (int o = 32; o >= 1; o >>= 1) s += __shfl_xor(s, o);
        const float mean = s * (1.0f / D);
        float q = 0.f;
#pragma unroll
        for (int i = 0; i < 4; ++i) { const f32x4 d = v[i] - mean; q += (d[0] * d[0] + d[1] * d[1]) + (d[2] * d[2] + d[3] * d[3]); }
#pragma unroll
        for (int o = 32; o >= 1; o >>= 1) q += __shfl_xor(q, o);
        const float rstd = rsqrtf(q * (1.0f / D) + LN_EPS);
#pragma unroll
        for (int i = 0; i < 4; ++i) {
            const f32x4 y = (v[i] - mean) * rstd * gv[i] + bv[i];
            if (MODE == 0) { u32x2 w; w.x = cvt_pk_bf16(y[0], y[1]); w.y = cvt_pk_bf16(y[2], y[3]); *(u32x2*)(dstb + (size_t)row * D + 256 * i + lane * 4) = w;
                int q = 0; q = __builtin_amdgcn_cvt_pk_fp8_f32(y[0], y[1], q, false); q = __builtin_amdgcn_cvt_pk_fp8_f32(y[2], y[3], q, true);
                *(int*)(dstq + (size_t)row * D + 256 * i + lane * 4) = q; }
            else *(f32x4*)(dstf + (size_t)row * D + 256 * i + lane * 4) = y;
        }
    }
}

__device__ void phase_router(const Args& a, LAS unsigned char* lds, int bid, int nb) {
    WAVE_IDS();
    const bf16* x1b = (const bf16*)(a.ws + WS_XB); const bf16* wrt = (const bf16*)(a.ws + WS_WRT);
    unsigned char* ro = a.ws + WS_ROUT;
    int* ridx = (int*)(ro + RO_RIDX); float* rw = (float*)(ro + RO_RW); int* cnt = (int*)(ro + RO_CNT);
    const float* rbias = a.in[I_RB];
    LAS float* lg = (LAS float*)lds;
    LAS float* bi = lg + 128 * 65;
    LAS int* hist = (LAS int*)(bi + 128 * 65);
    for (int u = bid; u < T / 128; u += nb) {
        __syncthreads();
        if (tid < 64) hist[tid] = 0;
        {
            f32x4 c[4];
#pragma unroll
            for (int et = 0; et < 4; ++et) c[et] = (f32x4){0.f, 0.f, 0.f, 0.f};
            const bf16* xa = x1b + (size_t)(u * 128 + 16 * wid + fr) * D + 8 * fq;
#pragma unroll 4
            for (int k0 = 0; k0 < D; k0 += 32) {
                const bf16x8 xf = *(const bf16x8*)(xa + k0);
#pragma unroll
                for (int et = 0; et < 4; ++et) {
                    const bf16x8 wf = *(const bf16x8*)(wrt + (size_t)(16 * et + fr) * D + k0 + 8 * fq);
                    c[et] = __builtin_amdgcn_mfma_f32_16x16x32_bf16(wf, xf, c[et], 0, 0, 0);
                }
            }
#pragma unroll
            for (int et = 0; et < 4; ++et)
#pragma unroll
                for (int r = 0; r < 4; ++r) {
                    const int e = 16 * et + 4 * fq + r; const float s = sigmoidf_(c[et][r]);
                    lg[(16 * wid + fr) * 65 + e] = s; bi[(16 * wid + fr) * 65 + e] = s + rbias[e];
                }
        }
        __syncthreads();
        if (tid < 128) {
            const LAS float* mb = bi + tid * 65; const LAS float* ms = lg + tid * 65;
            float gs[8];
#pragma unroll
            for (int g = 0; g < 8; ++g) {
                float m1 = -3e38f, m2 = -3e38f;
#pragma unroll
                for (int j = 0; j < 8; ++j) { const float v = mb[g * 8 + j]; if (v > m1) { m2 = m1; m1 = v; } else if (v > m2) m2 = v; }
                gs[g] = m1 + m2;
            }
            unsigned gmask = 0;
#pragma unroll
            for (int rnd = 0; rnd < 4; ++rnd) {
                float best = -3e38f; int bg = 0;
#pragma unroll
                for (int g = 0; g < 8; ++g) { const bool ok = !((gmask >> g) & 1u) && gs[g] > best; best = ok ? gs[g] : best; bg = ok ? g : bg; }
                gmask |= 1u << bg;
            }
            unsigned long long taken = 0ull;
            int sel[8]; float wsel[8]; float wsum = 0.f;
#pragma unroll
            for (int rnd = 0; rnd < 8; ++rnd) {
                float best = -3e38f; int be = 0;
#pragma unroll 1
                for (int e = 0; e < 64; ++e) {
                    const bool ok = ((gmask >> (e >> 3)) & 1u) && !((taken >> e) & 1ull);
                    const float v = mb[e];
                    if (ok && v > best) { best = v; be = e; }
                }
                taken |= 1ull << be;
                sel[rnd] = be; wsel[rnd] = ms[be]; wsum += wsel[rnd];
            }
            const float sc = ROUTED_SCALE / wsum;
            const size_t t = (size_t)u * 128 + tid;
#pragma unroll
            for (int k = 0; k < 8; ++k) { ridx[t * 8 + k] = sel[k]; rw[t * 8 + k] = wsel[k] * sc; __hip_atomic_fetch_add(&hist[sel[k]], 1, __ATOMIC_RELAXED, __HIP_MEMORY_SCOPE_WORKGROUP); }
        }
        __syncthreads();
        if (tid < 64) cnt[u * 64 + tid] = hist[tid];
    }
}

__device__ void phase_sort(const Args& a, LAS unsigned char* lds, int bid, int nb) {
    const int tid = hidden_tid();
    unsigned char* ro = a.ws + WS_ROUT;
    const int* ridx = (const int*)(ro + RO_RIDX); const float* rw = (const float*)(ro + RO_RW); const int* cnt = (const int*)(ro + RO_CNT);
    int* stok = (int*)(ro + RO_STOK); int* dest = (int*)(ro + RO_DEST); float* rsc = (float*)(ro + RO_RSC); int* tile = (int*)(ro + RO_TILE);
    LAS int* tot = (LAS int*)lds; LAS int* pos0 = tot + 64; LAS int* lcnt = pos0 + 64; LAS int* base = lcnt + 64;
    constexpr int UPC = TC / 128;
    for (int u = bid; u < T / 128; u += nb) {
        const int c = u / UPC, ul = u % UPC;
        __syncthreads();
        if (tid < 64) {
            int tt = 0, pre = 0;
            for (int q = 0; q < UPC; ++q) { const int v = cnt[(c * UPC + q) * 64 + tid]; tt += v; pre += (q < ul) ? v : 0; }
            tot[tid] = tt; pos0[tid] = pre; lcnt[tid] = 0;
        }
        __syncthreads();
        if (tid == 0) { int acc = 0; for (int e = 0; e < 64; ++e) { base[e] = acc; acc += (tot[e] + 255) & ~255; } base[64] = acc; }
        __syncthreads();
        int* stok_c = stok + (size_t)c * RMAX; int* dest_c = dest + (size_t)c * RMAX; float* rsc_c = rsc + (size_t)c * RMAX;
#pragma unroll
        for (int rep = 0; rep < 2; ++rep) {
            const int pr = tid + rep * NTHREADS, tl = pr >> 3, k = pr & 7;
            const size_t t = (size_t)u * 128 + tl;
            const int e = ridx[t * 8 + k];
            const int rank = __hip_atomic_fetch_add(&lcnt[e], 1, __ATOMIC_RELAXED, __HIP_MEMORY_SCOPE_WORKGROUP);
            const int pos = base[e] + pos0[e] + rank;
            stok_c[pos] = (int)t; dest_c[pos] = (int)(t - (size_t)c * TC) * 8 + k; rsc_c[pos] = rw[t * 8 + k];
        }
        if (ul < 64) {
            const int e = ul, lo = base[e] + tot[e], hi = base[e + 1];
            for (int r = lo + tid; r < hi; r += NTHREADS) { stok_c[r] = c * TC; dest_c[r] = TC * 8; rsc_c[r] = 0.f; }
        }
        if (ul == 0) {
            const int ntl = base[64] / 256;
            for (int mt = tid; mt < ntl; mt += NTHREADS) { int e = 0; for (int q = 1; q < 64; ++q) e = (base[q] <= mt * 256) ? q : e; tile[c * TILE_STRIDE + mt] = e; }
            if (tid == 0) tile[c * TILE_STRIDE + TILE_STRIDE - 1] = ntl;
        }
    }
}

struct SchedShared {
    int G, c;
    __device__ __forceinline__ bool next(int i, gf::Unit& u) const {
        constexpr int nU1 = (T / 256) * 2;
        const int L = i * G + c; if (L >= nU1) return false;
        u.rowidx = nullptr; u.keep = 0; u.x0 = 0;
        const int pm = L >> 1, pn = L & 1; u.A = (unsigned)WS_XB + (unsigned)pm * 256u * (D * 2); u.B = (unsigned)WS_WS13T + (unsigned)pn * 256u * (D * 2); u.lda = D * 2; u.ldb = D * 2; u.nt = D / 64; u.kind = 0; u.r0 = pm * 256; u.c0 = pn * 128;
        return true;
    }
};
struct EpiShared { bf16* hs;
    __device__ __forceinline__ void operator()(f32x4 (&acc)[2][2][4][2], const gf::Unit& u, int wr, int wc, int fr, int fq) const { epi_gate(acc, hs, SDIM, u.r0, u.c0, wr, wc, fr, fq); }
};
__device__ void phase_shared(const Args& a, LAS unsigned char* lds, int bid, int nb) {
    SchedShared S{nb, vcu_of(bid, nb)};
    EpiShared E{(bf16*)(a.ws + WS_HS)};
    gf::gemm_fast<false, 0, false>(lds, a.ws, S, E);
}

struct SchedBase {
    int G, c;
    __device__ __forceinline__ bool next(int i, gf::Unit& u) const {
        constexpr int nU = (T / 256) * 4;
        const int v = (i >> 1) * G + c, part = i & 1; if (v >= nU) return false;
        const int pm = v >> 2, pn = v & 3;
        u.rowidx = nullptr; u.x0 = 0; u.r0 = pm * 256; u.c0 = pn * 256; u.kind = part; u.keep = 1 - part;
        if (part == 0) { u.A = (unsigned)WS_XB + (unsigned)pm * 256u * (D * 2); u.B = (unsigned)WS_WGT + (unsigned)pn * 256u * (D * 2); u.lda = D * 2; u.ldb = D * 2; u.nt = D / 64; }
        else { u.A = (unsigned)WS_HS + (unsigned)pm * 256u * (SDIM * 2); u.B = (unsigned)WS_WS2T + (unsigned)pn * 256u * (SDIM * 2); u.lda = SDIM * 2; u.ldb = SDIM * 2; u.nt = SDIM / 64; }
        return true;
    }
};
struct EpiBase { const bf16* x1b; const bf16* pp; const float* bg; float* y;
    __device__ __forceinline__ void operator()(f32x4 (&acc)[2][2][4][2], const gf::Unit& u, int wr, int wc, int fr, int fq) const {
        if (u.kind == 0) {
            f32x4 bgv[2][2];
#pragma unroll
            for (int bj = 0; bj < 2; ++bj) { const int col = u.c0 + 128 * bj + 32 * wc + 8 * fq; bgv[bj][0] = *(const f32x4*)(bg + col); bgv[bj][1] = *(const f32x4*)(bg + col + 4); }
#pragma unroll
            for (int am = 0; am < 4; ++am) {
                const int ai = am >> 1, m0 = (am & 1) * 2;
                asm volatile("" : "+v"(acc[ai][0][m0][0]), "+v"(acc[ai][0][m0][1]), "+v"(acc[ai][1][m0][0]), "+v"(acc[ai][1][m0][1]),
                                  "+v"(acc[ai][0][m0 + 1][0]), "+v"(acc[ai][0][m0 + 1][1]), "+v"(acc[ai][1][m0 + 1][0]), "+v"(acc[ai][1][m0 + 1][1]) :: "memory");
                u32x4 pw[2][2], xw[2][2];
#pragma unroll
                for (int mm = 0; mm < 2; ++mm) {
                    const size_t t = (size_t)(u.r0 + 128 * ai + 64 * wr + 16 * (m0 + mm) + fr);
#pragma unroll
                    for (int bj = 0; bj < 2; ++bj) { const int col = u.c0 + 128 * bj + 32 * wc + 8 * fq; pw[mm][bj] = *(const u32x4*)(pp + t * D + col); xw[mm][bj] = *(const u32x4*)(x1b + t * D + col); }
                }
#pragma unroll
                for (int mm = 0; mm < 2; ++mm)
#pragma unroll
                    for (int bj = 0; bj < 2; ++bj) {
                        const int m = m0 + mm;
                        const unsigned pws[4] = {pw[mm][bj].x, pw[mm][bj].y, pw[mm][bj].z, pw[mm][bj].w}, xws[4] = {xw[mm][bj].x, xw[mm][bj].y, xw[mm][bj].z, xw[mm][bj].w};
                        float v[8];
#pragma unroll
                        for (int j = 0; j < 8; ++j) {
                            const float gacc = acc[ai][bj][m][j >> 2][j & 3] + bgv[bj][j >> 2][j & 3];
                            const float ppv = (j & 1) ? bf2f(pws[j >> 1] >> 16) : bf2f(pws[j >> 1] & 0xffffu);
                            const float xv = (j & 1) ? bf2f(xws[j >> 1] >> 16) : bf2f(xws[j >> 1] & 0xffffu);
                            v[j] = sigmoidf_(gacc) * ppv + ALPHA * xv;
                        }
                        acc[ai][bj][m][0] = (f32x4){v[0], v[1], v[2], v[3]}; acc[ai][bj][m][1] = (f32x4){v[4], v[5], v[6], v[7]};
                    }
                asm volatile("" ::: "memory"); __builtin_amdgcn_sched_barrier(0);
            }
        } else {
#pragma unroll
            for (int ai = 0; ai < 2; ++ai)
#pragma unroll
                for (int m = 0; m < 4; ++m) {
                    const size_t off = (size_t)(u.r0 + 128 * ai + 64 * wr + 16 * m + fr) * D + u.c0 + 32 * wc + 8 * fq;
#pragma unroll
                    for (int bj = 0; bj < 2; ++bj)
#pragma unroll
                        for (int n = 0; n < 2; ++n) *(f32x4*)(y + off + 128 * bj + 4 * n) = acc[ai][bj][m][n];
                }
        }
    }
};
__device__ void phase_base(const Args& a, LAS unsigned char* lds, int bid, int nb) {
    SchedBase S{nb, vcu_of(bid, nb)};
    EpiBase E{(const bf16*)(a.ws + WS_XB), (const bf16*)(a.ws + WS_PP), a.in[I_BG], a.out};
    gf::gemm_fast<true, 0, true>(lds, a.ws, S, E);
}

struct SchedMoeUp {
    const int* stok; const int* tile; int nU, G, c;
    __device__ __forceinline__ bool next(int i, gf::Unit& u) const {
        const int L = i * G + c; if (L >= nU) return false;
        const int mt = L >> 1, pn = L & 1, e = uload(tile + mt);
        u.A = (unsigned)WS_X1Q; u.rowidx = stok + mt * 256; u.B = (unsigned)WS_W13Q + ((unsigned)e * 512u + pn * 256u) * D; u.lda = D; u.ldb = D; u.nt = D / 128; u.keep = 0;
        u.kind = 0; u.r0 = mt * 256; u.c0 = pn * 128; u.x0 = 0; return true;
    }
};
struct EpiMoeUp { unsigned char* hsort;
    __device__ __forceinline__ void operator()(f32x4 (&acc)[2][2][4][2], const gf::Unit& u, int wr, int wc, int fr, int fq) const {
#pragma unroll
        for (int ai = 0; ai < 2; ++ai)
#pragma unroll
            for (int m = 0; m < 4; ++m) {
                unsigned char* rp = hsort + (size_t)(u.r0 + 128 * ai + 64 * wr + 16 * m + fr) * EDIM + u.c0 + 32 * wc + 8 * fq;
                asm volatile("" : "+v"(acc[ai][0][m][0]), "+v"(acc[ai][0][m][1]), "+v"(acc[ai][1][m][0]), "+v"(acc[ai][1][m][1]) :: "memory");
                float h[8];
#pragma unroll
                for (int n = 0; n < 2; ++n)
#pragma unroll
                    for (int j = 0; j < 4; ++j) h[4 * n + j] = siluf_(acc[ai][0][m][n][j] * W8_INV) * (acc[ai][1][m][n][j] * W8_INV);
                int q0 = 0, q1 = 0;
                q0 = __builtin_amdgcn_cvt_pk_fp8_f32(h[0], h[1], q0, false); q0 = __builtin_amdgcn_cvt_pk_fp8_f32(h[2], h[3], q0, true);
                q1 = __builtin_amdgcn_cvt_pk_fp8_f32(h[4], h[5], q1, false); q1 = __builtin_amdgcn_cvt_pk_fp8_f32(h[6], h[7], q1, true);
                *(u32x2*)rp = (u32x2){(unsigned)q0, (unsigned)q1};
            }
    }
};
__device__ void phase_moe_up(const Args& a, LAS unsigned char* lds, int c, int bid, int nb) {
    unsigned char* ro = a.ws + WS_ROUT;
    const int* tile = (const int*)(ro + RO_TILE) + c * TILE_STRIDE;
    SchedMoeUp S{(const int*)(ro + RO_STOK) + (size_t)c * RMAX, tile, uload(tile + TILE_STRIDE - 1) * 2, nb, vcu_of(bid, nb)};
    EpiMoeUp E{a.ws + WS_HSORT};
    gf::gemm_fast<true, 1, false>(lds, a.ws, S, E);
}
struct SchedMoeDown {
    const int* tile; int nU, G, c;
    __device__ __forceinline__ bool next(int i, gf::Unit& u) const {
        const int L = i * G + c; if (L >= nU) return false;
        const int mt = L >> 2, pn = L & 3, e = uload(tile + mt);
        u.A = (unsigned)WS_HSORT + (unsigned)mt * 256u * EDIM; u.rowidx = nullptr; u.B = (unsigned)WS_W2Q + ((unsigned)e * D + pn * 256u) * EDIM; u.lda = EDIM; u.ldb = EDIM; u.nt = EDIM / 128; u.keep = 0;
        u.kind = 0; u.r0 = mt * 256; u.c0 = pn * 256; u.x0 = 0; return true;
    }
};
struct EpiMoeDown { const int* dest; const float* rsc; unsigned char* contrib;
    __device__ __forceinline__ void operator()(f32x4 (&acc)[2][2][4][2], const gf::Unit& u, int wr, int wc, int fr, int fq) const {
#pragma unroll
        for (int ai = 0; ai < 2; ++ai) {
            int dr[4]; float sc[4];
#pragma unroll
            for (int m = 0; m < 4; ++m) { const int r = u.r0 + 128 * ai + 64 * wr + 16 * m + fr; dr[m] = dest[r]; sc[m] = rsc[r] * (W8_INV * C8_SCALE); }
#pragma unroll
            for (int m = 0; m < 4; ++m) {
                const float s = sc[m];
                unsigned char* rp = contrib + (size_t)dr[m] * D + u.c0 + 64 * wc + 16 * fq;
                int w[4];
#pragma unroll
                for (int bj = 0; bj < 2; ++bj)
#pragma unroll
                    for (int n = 0; n < 2; ++n) {
                        const f32x4 v = acc[ai][bj][m][n] * s; int x = 0;
                        x = __builtin_amdgcn_cvt_pk_fp8_f32(v[0], v[1], x, false); x = __builtin_amdgcn_cvt_pk_fp8_f32(v[2], v[3], x, true);
                        w[2 * bj + n] = x;
                    }
                *(u32x4*)rp = (u32x4){(unsigned)w[0], (unsigned)w[1], (unsigned)w[2], (unsigned)w[3]};
            }
            asm volatile("" ::: "memory"); __builtin_amdgcn_sched_barrier(0);
        }
    }
};
__device__ void phase_moe_down(const Args& a, LAS unsigned char* lds, int c, int bid, int nb) {
    unsigned char* ro = a.ws + WS_ROUT;
    const int* tile = (const int*)(ro + RO_TILE) + c * TILE_STRIDE;
    SchedMoeDown S{tile, uload(tile + TILE_STRIDE - 1) * 4, nb, vcu_of(bid, nb)};
    EpiMoeDown E{(const int*)(ro + RO_DEST) + (size_t)c * RMAX, (const float*)(ro + RO_RSC) + (size_t)c * RMAX, a.ws + WS_CONTRIB};
    gf::gemm_fast<false, 2, false>(lds, a.ws, S, E);
}
__device__ void phase_combine(const Args& a, int c, int bid, int nb) {
    typedef float f32x2 __attribute__((ext_vector_type(2)));
    const int tid = hidden_tid(), wid = tid >> 6, lane = tid & 63;
    const unsigned char* contrib = a.ws + WS_CONTRIB;
    const float* g = a.in[I_LN2G]; const float* bta = a.in[I_LN2B]; float* y = a.out;
    f32x4 gv[4], bv[4];
#pragma unroll
    for (int j = 0; j < 4; ++j) { gv[j] = *(const f32x4*)(g + 16 * lane + 4 * j); bv[j] = *(const f32x4*)(bta + 16 * lane + 4 * j); }
    for (int rl = bid * 8 + wid; rl < TC; rl += nb * 8) {
        float* row = y + ((size_t)c * TC + rl) * D;
        f32x4 v[4];
#pragma unroll
        for (int j = 0; j < 4; ++j) v[j] = *(const f32x4*)(row + 16 * lane + 4 * j);
        u32x4 cw[8];
#pragma unroll
        for (int k = 0; k < 8; ++k) cw[k] = *(const u32x4*)(contrib + ((size_t)rl * 8 + k) * D + 16 * lane);
        f32x4 s4[4];
#pragma unroll
        for (int j = 0; j < 4; ++j) s4[j] = (f32x4){0.f, 0.f, 0.f, 0.f};
#pragma unroll
        for (int k = 0; k < 8; ++k) {
            const unsigned ws4[4] = {cw[k].x, cw[k].y, cw[k].z, cw[k].w};
#pragma unroll
            for (int j = 0; j < 4; ++j) {
                const f32x2 lo = __builtin_amdgcn_cvt_pk_f32_fp8((int)ws4[j], false), hi = __builtin_amdgcn_cvt_pk_f32_fp8((int)ws4[j], true);
                s4[j][0] += lo.x; s4[j][1] += lo.y; s4[j][2] += hi.x; s4[j][3] += hi.y;
            }
        }
#pragma unroll
        for (int j = 0; j < 4; ++j) v[j] += s4[j] * C8_INV;
        float s = 0.f;
#pragma unroll
        for (int i = 0; i < 4; ++i) s += (v[i][0] + v[i][1]) + (v[i][2] + v[i][3]);
#pragma unroll
        for (int o = 32; o >= 1; o >>= 1) s += __shfl_xor(s, o);
        const float mean = s * (1.0f / D);
        float q = 0.f;
#pragma unroll
        for (int i = 0; i < 4; ++i) { const f32x4 d = v[i] - mean; q += (d[0] * d[0] + d[1] * d[1]) + (d[2] * d[2] + d[3] * d[3]); }
#pragma unroll
        for (int o = 32; o >= 1; o >>= 1) q += __shfl_xor(q, o);
        const float rstd = rsqrtf(q * (1.0f / D) + LN_EPS);
#pragma unroll
        for (int j = 0; j < 4; ++j) *(f32x4*)(row + 16 * lane + 4 * j) = (v[j] - mean) * rstd * gv[j] + bv[j];
    }
}

#define XB_TMO      128
#define XB_XCNT(j)  (256  + 64 * (j))
#define XB_XSUB(j)  (1280 + 64 * (j))
#define XB_XGEN(j)  (2304 + 64 * (j))
#define XB_TOP      3328
#define XB_TOPGEN   3392
#define XCD_BAR_WORDS 3456
#define XB_SPIN_CAP (1u << 18)

__device__ __forceinline__ unsigned xb_ld(unsigned* p)              { return __hip_atomic_load(p, __ATOMIC_RELAXED, __HIP_MEMORY_SCOPE_AGENT); }
__device__ __forceinline__ unsigned xb_add(unsigned* p, unsigned v) { return __hip_atomic_fetch_add(p, v, __ATOMIC_RELAXED, __HIP_MEMORY_SCOPE_AGENT); }
__device__ __forceinline__ unsigned xb_xcc_id() { return (unsigned)__builtin_amdgcn_s_getreg((3 << 11) | 20) & 0xFu; }
#define XB_SPIN(cond, bar) do { unsigned _sp = 0; while (cond) { __builtin_amdgcn_s_sleep(1); \
    if ((++_sp & 255u) == 0u) { if (xb_ld(&(bar)[XB_TMO])) break; if (_sp > XB_SPIN_CAP) { atomicAdd(&(bar)[XB_TMO], 1u); break; } } } } while (0)

struct XcdBarrier {
    unsigned* bar; unsigned x;
    volatile LAS unsigned* st;
};
__device__ __forceinline__ XcdBarrier xcd_barrier_post(unsigned* bar, volatile LAS unsigned* st) {
    XcdBarrier b; b.bar = bar; b.x = xb_xcc_id(); b.st = st;
    if (threadIdx.x == 0) (void)xb_add(&bar[XB_XCNT(b.x)], 1u);
    return b;
}
__device__ __forceinline__ void xcd_barrier_complete(unsigned* bar, unsigned x, unsigned& nloc, unsigned& nx) {
    const unsigned G = gridDim.x * gridDim.y * gridDim.z;
    unsigned sum, cnt, mine, sp = 0u;
    for (;;) {
        sum = 0u; cnt = 0u; mine = 0u;
#pragma unroll
        for (unsigned j = 0; j < 16; ++j) { const unsigned c = xb_ld(&bar[XB_XCNT(j)]); sum += c; cnt += (c > 0u) ? 1u : 0u; mine = (j == x) ? c : mine; }
        if (sum == G) break;
        __builtin_amdgcn_s_sleep(1);
        if ((++sp & 255u) == 0u) { if (xb_ld(&bar[XB_TMO])) break; if (sp > XB_SPIN_CAP) { atomicAdd(&bar[XB_TMO], 1u); break; } }
    }
    nloc = mine > 0u ? mine : 1u; nx = cnt > 0u ? cnt : 1u;
}
__device__ __forceinline__ void xcd_barrier(const XcdBarrier& b) {
    asm volatile("s_waitcnt vmcnt(0)" ::: "memory");
    __syncthreads();
    if (threadIdx.x == 0) {
        unsigned* bar = b.bar;
        __builtin_amdgcn_s_waitcnt(0);
        unsigned nloc = b.st[0], nx = b.st[1];
        if (nloc == 0u) { xcd_barrier_complete(bar, b.x, nloc, nx); b.st[0] = nloc; b.st[1] = nx; }
        const unsigned old = xb_add(&bar[XB_XSUB(b.x)], 1u);
        const unsigned gen = old / nloc;
        if (old + 1u == (gen + 1u) * nloc) {
            __builtin_amdgcn_fence(__ATOMIC_RELEASE, "agent");
            asm volatile("s_waitcnt vmcnt(0)" ::: "memory");
            const unsigned og = xb_add(&bar[XB_TOP], 1u);
            const unsigned tg = og / nx;
            if (og + 1u == (tg + 1u) * nx) xb_add(&bar[XB_TOPGEN], 1u);
            else XB_SPIN(xb_ld(&bar[XB_TOPGEN]) == tg, bar);
            __builtin_amdgcn_fence(__ATOMIC_ACQUIRE, "agent");
            xb_add(&bar[XB_XGEN(b.x)], 1u);
            asm volatile("s_waitcnt vmcnt(0)" ::: "memory");
        } else {
            XB_SPIN(xb_ld(&bar[XB_XGEN(b.x)]) == gen, bar);
            __builtin_amdgcn_fence(__ATOMIC_ACQUIRE, "agent");
            asm volatile("s_waitcnt vmcnt(0)" ::: "memory");
        }
    }
    __syncthreads();
}

constexpr int PH_PROLOGUE = 0, PH_PROJ = 1, PH_MIX_A = 2, PH_MIX_B = 3, PH_WOUT = 4, PH_LN1 = 5, PH_ROUTER = 6, PH_SORT = 7, PH_MOE0 = 8, PH_END = PH_MOE0 + 3 * NH;
constexpr int LDS_BYTES = 148480;

constexpr int LDS_BAR_OFF = LDS_BYTES - 16;
#ifndef N_LAUNCHES
#define N_LAUNCHES 1
#endif
__global__ void __launch_bounds__(NTHREADS, 2) fwd(Args a) {
    extern __shared__ __attribute__((aligned(16))) unsigned char lds_raw[];
    LAS unsigned char* lds = (LAS unsigned char*)lds_raw;
    const int bid = blockIdx.x, nb = gridDim.x;
    if (threadIdx.x < 4) ((LAS unsigned*)(lds + LDS_BAR_OFF))[threadIdx.x] = 0u;
    __syncthreads();
    XcdBarrier bar = xcd_barrier_post((unsigned*)(a.ws + WS_CTL), (volatile LAS unsigned*)(lds + LDS_BAR_OFF));
    const int lo = a.ph_lo, hi = a.ph_hi;
#ifndef PHMASK
#define PHMASK 0xffffffffu
#endif
#define IN(k) (((PHMASK >> ((k) < PH_MOE0 ? (k) : 8 + ((k) - PH_MOE0) % 3)) & 1u) && lo <= (k) && (k) < hi)
#define SEAM(k) do { if (lo <= (k) && (k) + 1 < hi) xcd_barrier(bar); } while (0)
    if (IN(PH_PROLOGUE)) phase_prologue(a, lds, bid, nb);
    SEAM(PH_PROLOGUE);
    if (IN(PH_PROJ)) phase_proj(a, lds, bid, nb);
    SEAM(PH_PROJ);
    if (IN(PH_MIX_A)) { phase_segtot(a, lds, bid, nb); phase_swa(a, lds, bid, nb); }
    SEAM(PH_MIX_A);
    if (IN(PH_MIX_B)) phase_retention(a, lds, bid, nb);
    SEAM(PH_MIX_B);
    if (IN(PH_WOUT)) phase_wout(a, lds, bid, nb);
    SEAM(PH_WOUT);
    if (IN(PH_LN1)) phase_ln<0>(a.out, a.in[I_LN1G], a.in[I_LN1B], (bf16*)(a.ws + WS_XB), a.ws + WS_X1Q, nullptr, bid, nb);
    SEAM(PH_LN1);
    if (IN(PH_ROUTER)) { phase_router(a, lds, bid, nb); __syncthreads(); phase_shared(a, lds, bid, nb); }
    SEAM(PH_ROUTER);
    if (IN(PH_SORT)) {
#ifndef NO_SORT
        phase_sort(a, lds, bid, nb); __syncthreads();
#endif
        phase_base(a, lds, bid, nb); }
    SEAM(PH_SORT);
    for (int c = 0; c < NH; ++c) {
        if (IN(PH_MOE0 + 3 * c)) phase_moe_up(a, lds, c, bid, nb);
        SEAM(PH_MOE0 + 3 * c);
        if (IN(PH_MOE0 + 3 * c + 1)) phase_moe_down(a, lds, c, bid, nb);
        SEAM(PH_MOE0 + 3 * c + 1);
        if (IN(PH_MOE0 + 3 * c + 2)) phase_combine(a, c, bid, nb);
        SEAM(PH_MOE0 + 3 * c + 2);
    }
#undef IN
#undef SEAM
}

extern "C" void kernel_launch(void* const* d_in, const int* in_sizes, int n_in, void* d_out, int out_size, void* d_ws, size_t ws_size, hipStream_t stream) {
    static int grid = 0;
    if (grid == 0) {
        if (n_in != 22 || out_size != T * D || ws_size < WS_NEED) { fprintf(stderr, "kernel_launch: unexpected shapes: n_in %d out %d ws %zu (need %zu)\n", n_in, out_size, ws_size, (size_t)WS_NEED); grid = -1; return; }
        int dev = 0, cus = 0;
        (void)hipGetDevice(&dev); (void)hipDeviceGetAttribute(&cus, hipDeviceAttributeMultiprocessorCount, dev);
        if (hipFuncSetAttribute((const void*)fwd, hipFuncAttributeMaxDynamicSharedMemorySize, LDS_BYTES) != hipSuccess) { fprintf(stderr, "hipFuncSetAttribute failed\n"); grid = -1; return; }
        int per_cu = 0;
        if (hipOccupancyMaxActiveBlocksPerMultiprocessor(&per_cu, (const void*)fwd, NTHREADS, LDS_BYTES) != hipSuccess || per_cu < 1) { fprintf(stderr, "occupancy query: %d blocks per CU\n", per_cu); grid = -1; return; }
        (void)hipGetLastError();
        grid = cus > 0 ? cus : 256;
    }
    if (grid < 0) return;
    (void)hipMemsetAsync((char*)d_ws + WS_CTL, 0, 16384, stream);
    Args a{};
    for (int i = 0; i < 22; ++i) a.in[i] = (const float*)d_in[i];
    a.out = (float*)d_out; a.ws = (unsigned char*)d_ws;
#if N_LAUNCHES == 1
    a.ph_lo = 0; a.ph_hi = PH_END;
    hipLaunchKernelGGL(fwd, dim3(grid), dim3(NTHREADS), LDS_BYTES, stream, a);
#else
    for (int ph = 0; ph < PH_END; ++ph) {
        a.ph_lo = ph; a.ph_hi = ph + 1;
        hipLaunchKernelGGL(fwd, dim3(grid), dim3(NTHREADS), LDS_BYTES, stream, a);
    }
#endif
}
```

```cpp
#include <hip/hip_runtime.h>
#include <cstdio>
#include <cstdint>

#define LAS __attribute__((address_space(3)))
typedef unsigned short bf16;
typedef short bf16x8 __attribute__((ext_vector_type(8)));
typedef short bf16x4 __attribute__((ext_vector_type(4)));
typedef float f32x4 __attribute__((ext_vector_type(4)));
typedef unsigned u32x4 __attribute__((ext_vector_type(4)));
typedef unsigned u32x2 __attribute__((ext_vector_type(2)));

constexpr int D = 1024, BATCH = 8, SEQ = 4096, T = BATCH * SEQ;
constexpr int HD = 64, RH = 8, QH = 8, KVH = 2;
constexpr int INW = 2816;
constexpr int C_RQ = 0, C_RK = 512, C_RV = 1024, C_RG = 1536, C_AQ = 2048, C_AK = 2560, C_AV = 2688;
constexpr int CH = 128, NCH = SEQ / CH;
constexpr int SEGC = 8, NSEG = NCH / SEGC;
constexpr int NE = 64, TOPK = 8, EDIM = 256, SDIM = 256, PLE = 256;
constexpr float LN_EPS = 1e-5f, GN_EPS = 1e-6f;
constexpr float ALPHA = 1.189207115002721f;
constexpr float ROUTED_SCALE = 2.5f;
constexpr int NH = 1, TC = T / NH;
constexpr int RMAX = TC * TOPK + NE * 256;
constexpr int MAXTILES = RMAX / 256;
constexpr int NTHREADS = 512;
constexpr float W8_SCALE = 32.0f, W8_INV = 1.0f / 32.0f;
constexpr float C8_SCALE = 16.0f, C8_INV = 1.0f / 16.0f;

constexpr size_t MiB = 1u << 20;
constexpr size_t al(size_t x) { return (x + 255) & ~(size_t)255; }
constexpr size_t WS_CTL = 0, CTL_BYTES = 1 * MiB;
constexpr size_t WS_W13Q = WS_CTL + CTL_BYTES;
constexpr size_t WS_W2Q = WS_W13Q + al((size_t)NE * 512 * D);
constexpr size_t WS_ROUT = WS_W2Q + al((size_t)NE * D * EDIM);
constexpr size_t RO_RIDX = 0, RO_RW = RO_RIDX + (size_t)T * 8 * 4, RO_CNT = RO_RW + (size_t)T * 8 * 4, RO_STOK = RO_CNT + 256 * 64 * 4;
constexpr size_t RO_DEST = RO_STOK + (size_t)NH * RMAX * 4, RO_RSC = RO_DEST + (size_t)NH * RMAX * 4, RO_TILE = RO_RSC + (size_t)NH * RMAX * 4;
constexpr int TILE_STRIDE = 2048;
static_assert(MAXTILES < TILE_STRIDE - 1, "tile table");
constexpr size_t RO_END = RO_TILE + (size_t)NH * TILE_STRIDE * 4;
constexpr size_t WS_X1Q = WS_ROUT + al(RO_END);
constexpr size_t WS_XB = WS_X1Q + al((size_t)T * D);
constexpr size_t WS_DYN = WS_XB + al((size_t)T * D * 2);
constexpr size_t WS_WINT = WS_DYN;
constexpr size_t WS_WOUTT = WS_WINT + al((size_t)INW * D * 2);
constexpr size_t WS_WS13T = WS_WOUTT + al((size_t)D * D * 2);
constexpr size_t WS_WS2T = WS_WS13T + al((size_t)512 * D * 2);
constexpr size_t WS_WGT = WS_WS2T + al((size_t)D * SDIM * 2);
constexpr size_t WS_WPT = WS_WGT + al((size_t)D * D * 2);
constexpr size_t WS_WRT = WS_WPT + al((size_t)D * PLE * 2);
constexpr size_t WS_TAB = WS_WRT + al((size_t)NE * D * 2);
constexpr size_t TAB_BYTES = (size_t)SEQ * (32 + 32 + 8 + 8) * 4;
constexpr size_t WS_SEGT = WS_TAB + al(TAB_BYTES);
constexpr size_t WS_PB = WS_SEGT + al((size_t)BATCH * RH * NSEG * 64 * 64 * 4);
constexpr size_t WS_BIG = WS_PB + al((size_t)T * PLE * 2);
constexpr size_t WS_MIXO = WS_BIG + al((size_t)T * INW * 2);
constexpr size_t WS_PP = WS_MIXO + al((size_t)T * D * 2);
constexpr size_t WS_END1 = WS_PP + al((size_t)T * D * 2);
constexpr size_t WS_HS = WS_BIG;
constexpr size_t WS_HSORT = WS_DYN;
constexpr size_t WS_CONTRIB = WS_HSORT + al((size_t)RMAX * EDIM);
constexpr size_t WS_END2 = WS_CONTRIB + al(((size_t)TC * 8 + 1) * D);
constexpr size_t WS_NEED = WS_END1 > WS_END2 ? WS_END1 : WS_END2;
static_assert(WS_NEED <= 512 * MiB, "workspace map exceeds 512 MiB");

__device__ __forceinline__ int hidden_tid() { int t = threadIdx.x; asm volatile("" : "+v"(t)); return t; }
__device__ __forceinline__ float bf2f(unsigned v) { return __uint_as_float(v << 16); }
__device__ __forceinline__ unsigned cvt_pk_bf16(float lo, float hi) { unsigned r; asm volatile("v_cvt_pk_bf16_f32 %0, %1, %2" : "=v"(r) : "v"(lo), "v"(hi)); return r; }
__device__ __forceinline__ bf16 f2bf(float f) { return (bf16)(cvt_pk_bf16(f, 0.f) & 0xffffu); }
__device__ __forceinline__ float sigmoidf_(float x) { return __builtin_amdgcn_rcpf(1.0f + __expf(-x)); }
__device__ __forceinline__ float siluf_(float x) { return x * __builtin_amdgcn_rcpf(1.0f + __expf(-x)); }

struct Args {
    const float* in[22];
    float* out;
    unsigned char* ws;
    int ph_lo, ph_hi;
};
#if defined(__HIP_DEVICE_COMPILE__)
typedef const __attribute__((address_space(4))) Args* KArgs;
#else
typedef const Args* KArgs;
#endif
__device__ __forceinline__ Args ld_args(KArgs k) { Args a;
#pragma unroll
    for (int i = 0; i < 22; ++i) a.in[i] = k->in[i];
    a.out = k->out; a.ws = k->ws; a.ph_lo = k->ph_lo; a.ph_hi = k->ph_hi; return a; }
enum { I_X = 0, I_P, I_WIN, I_GN, I_ASC, I_SINK, I_WOUT, I_LN1G, I_LN1B, I_WR, I_RB, I_W1, I_W3, I_W2, I_WS1, I_WS3, I_WS2, I_WG, I_BG, I_WP, I_LN2G, I_LN2B };

struct TJob { const float* src; bf16* dst; int ld_src, ld_dst, sc0, dn0, k0, fp8; };
__device__ __forceinline__ bool get_tjob(const Args& a, int t, TJob& j) {
    unsigned char* ws = a.ws;
    if (t < NE * 32) { const int e = t >> 5, rem = t & 31, db = rem >> 2, kt = rem & 3, piece = db >> 1, which = piece & 1, pn = piece >> 1;
        j.src = (which ? a.in[I_W3] : a.in[I_W1]) + (size_t)e * D * EDIM; j.ld_src = EDIM; j.sc0 = pn * 128 + (db & 1) * 64;
        j.dst = (bf16*)(ws + WS_W13Q + (size_t)e * 512 * D); j.ld_dst = D; j.dn0 = db * 64; j.k0 = kt * 256; j.fp8 = 1; return true; }
    t -= NE * 32;
    if (t < NE * 16) { const int e = t >> 4, nt = t & 15;
        j.src = a.in[I_W2] + (size_t)e * EDIM * D; j.ld_src = D; j.sc0 = nt * 64; j.dst = (bf16*)(ws + WS_W2Q + (size_t)e * D * EDIM); j.ld_dst = EDIM; j.dn0 = nt * 64; j.k0 = 0; j.fp8 = 1; return true; }
    j.fp8 = 0;
    t -= NE * 16;
    if (t < 44 * 4) { j.src = a.in[I_WIN]; j.ld_src = INW; j.sc0 = (t >> 2) * 64; j.dst = (bf16*)(ws + WS_WINT); j.ld_dst = D; j.dn0 = (t >> 2) * 64; j.k0 = (t & 3) * 256; return true; }
    t -= 44 * 4;
    if (t < 16 * 4) { j.src = a.in[I_WOUT]; j.ld_src = D; j.sc0 = (t >> 2) * 64; j.dst = (bf16*)(ws + WS_WOUTT); j.ld_dst = D; j.dn0 = (t >> 2) * 64; j.k0 = (t & 3) * 256; return true; }
    t -= 16 * 4;
    if (t < 8 * 4) { const int db = t >> 2, piece = db >> 1, which = piece & 1, pn = piece >> 1;
        j.src = which ? a.in[I_WS3] : a.in[I_WS1]; j.ld_src = SDIM; j.sc0 = pn * 128 + (db & 1) * 64; j.dst = (bf16*)(ws + WS_WS13T); j.ld_dst = D; j.dn0 = db * 64; j.k0 = (t & 3) * 256; return true; }
    t -= 8 * 4;
    if (t < 16) { j.src = a.in[I_WS2]; j.ld_src = D; j.sc0 = t * 64; j.dst = (bf16*)(ws + WS_WS2T); j.ld_dst = SDIM; j.dn0 = t * 64; j.k0 = 0; return true; }
    t -= 16;
    if (t < 16 * 4) { j.src = a.in[I_WG]; j.ld_src = D; j.sc0 = (t >> 2) * 64; j.dst = (bf16*)(ws + WS_WGT); j.ld_dst = D; j.dn0 = (t >> 2) * 64; j.k0 = (t & 3) * 256; return true; }
    t -= 16 * 4;
    if (t < 16) { j.src = a.in[I_WP]; j.ld_src = D; j.sc0 = t * 64; j.dst = (bf16*)(ws + WS_WPT); j.ld_dst = PLE; j.dn0 = t * 64; j.k0 = 0; return true; }
    t -= 16;
    if (t < 4) { j.src = a.in[I_WR]; j.ld_src = NE; j.sc0 = 0; j.dst = (bf16*)(ws + WS_WRT); j.ld_dst = D; j.dn0 = 0; j.k0 = t * 256; return true; }
    return false;
}
constexpr int N_TJOBS = NE * 32 + NE * 16 + 44 * 4 + 16 * 4 + 8 * 4 + 16 + 16 * 4 + 16 + 4;

__device__ void phase_prologue(KArgs ka, LAS unsigned char* lds, int bid, int nb) {
    const Args a = ld_args(ka);
    LAS float* tile = (LAS float*)lds;
    unsigned char* ws = a.ws;
    const int tid = hidden_tid();
    {
        const int lr = tid >> 4, lc4 = (tid & 15) * 4;
        const int wn = tid & 63, wk = (tid >> 6) * 32;
        TJob j; f32x4 v[8];
        int t = bid;
        bool have = get_tjob(a, t, j);
        if (have) {
#pragma unroll
            for (int i = 0; i < 8; ++i) v[i] = *(const f32x4*)(j.src + (size_t)(j.k0 + lr + 32 * i) * j.ld_src + j.sc0 + lc4);
        }
        while (have) {
#pragma unroll
            for (int i = 0; i < 8; ++i) { LAS float* tp = tile + (lr + 32 * i) * 65 + lc4; tp[0] = v[i][0]; tp[1] = v[i][1]; tp[2] = v[i][2]; tp[3] = v[i][3]; }
            bf16* drow = j.dst + (size_t)(j.dn0 + wn) * j.ld_dst + j.k0 + wk;
            unsigned char* drow8 = (unsigned char*)j.dst + (size_t)(j.dn0 + wn) * j.ld_dst + j.k0 + wk;
            const int is8 = j.fp8;
            t += nb; TJob jn; const bool hn = get_tjob(a, t, jn);
            if (hn) {
#pragma unroll
                for (int i = 0; i < 8; ++i) v[i] = *(const f32x4*)(jn.src + (size_t)(jn.k0 + lr + 32 * i) * jn.ld_src + jn.sc0 + lc4);
            }
            __syncthreads();
            if (is8) {
#pragma unroll
                for (int q = 0; q < 2; ++q) {
                    int w[4];
#pragma unroll
                    for (int d = 0; d < 4; ++d) {
                        const int kk = wk + 16 * q + 4 * d;
                        int x = 0;
                        x = __builtin_amdgcn_cvt_pk_fp8_f32(tile[(kk + 0) * 65 + wn] * W8_SCALE, tile[(kk + 1) * 65 + wn] * W8_SCALE, x, false);
                        x = __builtin_amdgcn_cvt_pk_fp8_f32(tile[(kk + 2) * 65 + wn] * W8_SCALE, tile[(kk + 3) * 65 + wn] * W8_SCALE, x, true);
                        w[d] = x;
                    }
                    *(u32x4*)(drow8 + 16 * q) = (u32x4){(unsigned)w[0], (unsigned)w[1], (unsigned)w[2], (unsigned)w[3]};
                }
            } else {
#pragma unroll
                for (int q = 0; q < 4; ++q) {
                    u32x4 w;
                    w.x = cvt_pk_bf16(tile[(wk + 8 * q + 0) * 65 + wn], tile[(wk + 8 * q + 1) * 65 + wn]);
                    w.y = cvt_pk_bf16(tile[(wk + 8 * q + 2) * 65 + wn], tile[(wk + 8 * q + 3) * 65 + wn]);
                    w.z = cvt_pk_bf16(tile[(wk + 8 * q + 4) * 65 + wn], tile[(wk + 8 * q + 5) * 65 + wn]);
                    w.w = cvt_pk_bf16(tile[(wk + 8 * q + 6) * 65 + wn], tile[(wk + 8 * q + 7) * 65 + wn]);
                    *(u32x4*)(drow + 8 * q) = w;
                }
            }
            __syncthreads();
            j = jn; have = hn;
        }
    }
    {
        const size_t n8 = (size_t)T * D / 8;
        const float* x = a.in[I_X]; bf16* xb = (bf16*)(ws + WS_XB);
        for (size_t i = (size_t)bid * NTHREADS + tid; i < n8; i += (size_t)nb * NTHREADS) {
            const f32x4 v0 = *(const f32x4*)(x + i * 8), v1 = *(const f32x4*)(x + i * 8 + 4);
            u32x4 w; w.x = cvt_pk_bf16(v0[0], v0[1]); w.y = cvt_pk_bf16(v0[2], v0[3]); w.z = cvt_pk_bf16(v1[0], v1[1]); w.w = cvt_pk_bf16(v1[2], v1[3]);
            *(u32x4*)(xb + i * 8) = w;
        }
        const size_t m8 = (size_t)T * PLE / 8;
        const float* p = a.in[I_P]; bf16* pb = (bf16*)(ws + WS_PB);
        for (size_t i = (size_t)bid * NTHREADS + tid; i < m8; i += (size_t)nb * NTHREADS) {
            const f32x4 v0 = *(const f32x4*)(p + i * 8), v1 = *(const f32x4*)(p + i * 8 + 4);
            u32x4 w; w.x = cvt_pk_bf16(v0[0], v0[1]); w.y = cvt_pk_bf16(v0[2], v0[3]); w.z = cvt_pk_bf16(v1[0], v1[1]); w.w = cvt_pk_bf16(v1[2], v1[3]);
            *(u32x4*)(pb + i * 8) = w;
        }
    }
    {
        float* tab = (float*)(ws + WS_TAB);
        float* cosr = tab, *sinr = tab + SEQ * 32, *coss = tab + SEQ * 64, *sins = tab + SEQ * 72;
        for (int i = bid * NTHREADS + tid; i < SEQ * 40; i += nb * NTHREADS) {
            const int s = i / 40, j = i % 40;
            if (j < 32) {
                const float inv = (float)pow(10000.0, -(double)j / 32.0);
                const float ang = (float)s * inv;
                cosr[s * 32 + j] = (float)cos((double)ang); sinr[s * 32 + j] = (float)sin((double)ang);
            } else {
                const int jj = j - 32;
                const float inv = (float)pow(500000.0, -(double)jj / 8.0);
                const float ang = (float)s * inv;
                coss[s * 8 + jj] = (float)cos((double)ang); sins[s * 8 + jj] = (float)sin((double)ang);
            }
        }
    }
}

__device__ __forceinline__ int perm32(int rho) { const int n = rho >> 4, i = rho & 15; return 8 * (i >> 2) + 4 * n + (i & 3); }

struct GemmPart { const bf16* A; int lda; const int* rowidx; long arow0; const bf16* Bt; int ldb; int K; };

__device__ __forceinline__ void gemm_part(f32x4 (&acc)[2][2][4][2], const GemmPart& g, int wr, int wc, int fr, int fq) {
    unsigned oa[2][4], ob[2][2];
#pragma unroll
    for (int ai = 0; ai < 2; ++ai)
#pragma unroll
        for (int m = 0; m < 4; ++m) {
            const int r = 128 * ai + 64 * wr + 16 * m + fr;
            const long gr = g.rowidx ? (long)g.rowidx[r] : g.arow0 + r;
            oa[ai][m] = (unsigned)((gr * g.lda + 8 * fq) * 2);
        }
#pragma unroll
    for (int bj = 0; bj < 2; ++bj)
#pragma unroll
        for (int n = 0; n < 2; ++n) {
            const int rb = 128 * bj + 32 * wc + perm32(16 * n + fr);
            ob[bj][n] = (unsigned)((rb * g.ldb + 8 * fq) * 2);
        }
    const char* pA = (const char*)g.A; const char* pB = (const char*)g.Bt;
#pragma unroll 1
    for (int k0 = 0; k0 < g.K; k0 += 32) {
        bf16x8 af[2][4], bfr[2][2];
#pragma unroll
        for (int ai = 0; ai < 2; ++ai)
#pragma unroll
            for (int m = 0; m < 4; ++m) af[ai][m] = *(const bf16x8*)(pA + oa[ai][m]);
#pragma unroll
        for (int bj = 0; bj < 2; ++bj)
#pragma unroll
            for (int n = 0; n < 2; ++n) bfr[bj][n] = *(const bf16x8*)(pB + ob[bj][n]);
#pragma unroll
        for (int ai = 0; ai < 2; ++ai)
#pragma unroll
            for (int bj = 0; bj < 2; ++bj)
#pragma unroll
                for (int m = 0; m < 4; ++m)
#pragma unroll
                    for (int n = 0; n < 2; ++n)
                        acc[ai][bj][m][n] = __builtin_amdgcn_mfma_f32_16x16x32_bf16(bfr[bj][n], af[ai][m], acc[ai][bj][m][n], 0, 0, 0);
        pA += 64; pB += 64;
    }
}
__device__ __forceinline__ void zero_acc(f32x4 (&acc)[2][2][4][2]) {
#pragma unroll
    for (int a = 0; a < 2; ++a)
#pragma unroll
        for (int b = 0; b < 2; ++b)
#pragma unroll
            for (int m = 0; m < 4; ++m)
#pragma unroll
                for (int n = 0; n < 2; ++n) acc[a][b][m][n] = (f32x4){0.f, 0.f, 0.f, 0.f};
}
#define WAVE_IDS() int tid_ = threadIdx.x; asm volatile("" : "+v"(tid_)); const int tid = tid_, wid = __builtin_amdgcn_readfirstlane(tid >> 6), lane = tid & 63, wr = wid >> 2, wc = wid & 3, fr = lane & 15, fq = lane >> 4; (void)lane; (void)wr; (void)wc; (void)fr; (void)fq

__device__ __forceinline__ void epi_bf16(const f32x4 (&acc)[2][2][4][2], bf16* O, int ldo, long row0, int col0, int wr, int wc, int fr, int fq) {
#pragma unroll
    for (int ai = 0; ai < 2; ++ai)
#pragma unroll
        for (int m = 0; m < 4; ++m) {
            bf16* rp = O + (size_t)(row0 + 128 * ai + 64 * wr + 16 * m + fr) * ldo + col0 + 32 * wc + 8 * fq;
#pragma unroll
            for (int bj = 0; bj < 2; ++bj) {
                const f32x4 v0 = acc[ai][bj][m][0], v1 = acc[ai][bj][m][1];
                u32x4 w; w.x = cvt_pk_bf16(v0[0], v0[1]); w.y = cvt_pk_bf16(v0[2], v0[3]); w.z = cvt_pk_bf16(v1[0], v1[1]); w.w = cvt_pk_bf16(v1[2], v1[3]);
                *(u32x4*)(rp + 128 * bj) = w;
            }
        }
}
__device__ __forceinline__ void epi_gate(const f32x4 (&acc)[2][2][4][2], bf16* O, int ldo, long row0, int col0, int wr, int wc, int fr, int fq) {
#pragma unroll
    for (int ai = 0; ai < 2; ++ai)
#pragma unroll
        for (int m = 0; m < 4; ++m) {
            bf16* rp = O + (size_t)(row0 + 128 * ai + 64 * wr + 16 * m + fr) * ldo + col0 + 32 * wc + 8 * fq;
            float h[8];
#pragma unroll
            for (int n = 0; n < 2; ++n)
#pragma unroll
                for (int j = 0; j < 4; ++j) h[4 * n + j] = siluf_(acc[ai][0][m][n][j]) * acc[ai][1][m][n][j];
            u32x4 w; w.x = cvt_pk_bf16(h[0], h[1]); w.y = cvt_pk_bf16(h[2], h[3]); w.z = cvt_pk_bf16(h[4], h[5]); w.w = cvt_pk_bf16(h[6], h[7]);
            *(u32x4*)rp = w;
        }
}

namespace gf {
constexpr int BM = 256, BK = 64, HALF = 128, HTB = HALF * BK * 2, STAGE_BYTES = 8 * HTB;
__device__ __forceinline__ int lds_byte(int r, int c) { const int st = (r >> 4) * 2 + (c >> 5), rr = r & 15, cc = c & 31, ob = rr * 64 + cc * 2; return st * 1024 + (ob ^ (((ob >> 9) & 1) << 5)); }
__device__ __forceinline__ void stage_rc(int b, int& R, int& C) { const int st = b / 1024, sb = b % 1024, swz = sb ^ (((sb >> 9) & 1) << 5); R = (st >> 1) * 16 + swz / 64; C = (st & 1) * 32 + (swz % 64) / 2; }

struct Unit {
    unsigned A;
    unsigned B;
    const int* rowidx;
    int lda, ldb;
    int nt;
    int keep;
    int kind, r0, c0, x0;
    unsigned aux0, aux1;
};

typedef int v8i __attribute__((ext_vector_type(8)));
typedef int v4i __attribute__((ext_vector_type(4)));
template <bool GENERAL, int MODE, bool GENB, int AUX, class Sched, class Epi>
__device__ __forceinline__ void gemm_fast(LAS unsigned char* lds, const unsigned char* ws, const Sched& S, const Epi& E) {
    const __amdgpu_buffer_rsrc_t rsrc = __builtin_amdgcn_make_buffer_rsrc((void*)ws, 0, 0x7ffffff0, 0x00020000);
    int tid = threadIdx.x; asm volatile("" : "+v"(tid));
    const int wid = __builtin_amdgcn_readfirstlane(tid >> 6), lane = tid & 63, wr = wid >> 2, wc = wid & 3, fr = lane & 15, fq = lane >> 4;
    const unsigned ldsw = (unsigned)wid * 1024u;
    const int aoff = lds_byte(wr * 64 + fr, fq * 8), boff = lds_byte(wc * 32 + fr, fq * 8);
    constexpr unsigned kstep = (unsigned)(BK * 2);
#define GF_SA(b, h) (((b) * 2 + (h)) * HTB)
#define GF_SB(b, h) ((4 + (b) * 2 + (h)) * HTB)
#define GF_STAGE(bufoff, soff, o0, o1) do { \
        __builtin_amdgcn_raw_ptr_buffer_load_lds(rsrc, (LAS void*)(lds + (bufoff) + ldsw), 16, (int)(o0), (int)(soff), 0, 0); \
        __builtin_amdgcn_raw_ptr_buffer_load_lds(rsrc, (LAS void*)(lds + (bufoff) + ldsw + 8192), 16, (int)(o1), (int)(soff), 0, 0); } while (0)
#define GF_LDA(dst, b, h) do { _Pragma("unroll") for (int m = 0; m < 4; ++m) _Pragma("unroll") for (int k = 0; k < 2; ++k) dst[m][k] = *(const LAS bf16x8*)(lds + GF_SA(b, h) + aoff + m * 2048 + k * 1024); } while (0)
#define GF_LDB(dst, b, h) do { _Pragma("unroll") for (int n = 0; n < 2; ++n) _Pragma("unroll") for (int k = 0; k < 2; ++k) dst[n][k] = *(const LAS bf16x8*)(lds + GF_SB(b, h) + boff + n * 2048 + k * 1024); } while (0)
#define GF_MMA(ai, bj, At, Bt) do { __builtin_amdgcn_s_setprio(1); \
        if (MODE == 0) { _Pragma("unroll") for (int m = 0; m < 4; ++m) _Pragma("unroll") for (int n = 0; n < 2; ++n) _Pragma("unroll") for (int k = 0; k < 2; ++k) \
            acc[ai][bj][m][n] = __builtin_amdgcn_mfma_f32_16x16x32_bf16(Bt[n][k], At[m][k], acc[ai][bj][m][n], 0, 0, 0); } \
        else { _Pragma("unroll") for (int m = 0; m < 4; ++m) _Pragma("unroll") for (int n = 0; n < 2; ++n) { \
            const v8i a8 = __builtin_shufflevector(__builtin_bit_cast(v4i, At[m][0]), __builtin_bit_cast(v4i, At[m][1]), 0, 1, 2, 3, 4, 5, 6, 7); \
            const v8i b8 = __builtin_shufflevector(__builtin_bit_cast(v4i, Bt[n][0]), __builtin_bit_cast(v4i, Bt[n][1]), 0, 1, 2, 3, 4, 5, 6, 7); \
            acc[ai][bj][m][n] = __builtin_amdgcn_mfma_scale_f32_16x16x128_f8f6f4(b8, a8, acc[ai][bj][m][n], 0, 0, 0, 0x7f7f7f7f, 0, 0x7f7f7f7f); } } \
        __builtin_amdgcn_s_setprio(0); } while (0)
#define GF_WAIT_V(n) asm volatile("s_waitcnt vmcnt(" #n ")" ::: "memory")
#define GF_WAIT_L(n) asm volatile("s_waitcnt lgkmcnt(" #n ")" ::: "memory")
#define GF_BAR __builtin_amdgcn_s_barrier()
#define GF_SCHED __builtin_amdgcn_sched_barrier(0)
#define GF_BROW(h, R) ((MODE == 2) ? (64 * ((R) >> 5) + 16 * (((R) & 15) >> 2) + 8 * (h) + 4 * (((R) >> 4) & 1) + ((R) & 3)) : (HALF * (h) + ((R) & ~31) + perm32((R) & 31)))
#define GF_AUXDMA(u, slot) do { if (AUX != 0 && wid == 0) { \
        __builtin_amdgcn_raw_ptr_buffer_load_lds(rsrc, (LAS void*)(lds + STAGE_BYTES + (slot) * 2048), 16, lane * 16, (int)(u).aux0, 0, 0); \
        if (AUX == 2) __builtin_amdgcn_raw_ptr_buffer_load_lds(rsrc, (LAS void*)(lds + STAGE_BYTES + (slot) * 2048 + 1024), 16, lane * 16, (int)(u).aux1, 0, 0); } } while (0)
#define GF_SETOFF(u, slot, oA, oB) do { \
        int tz = threadIdx.x; asm volatile("" : "+v"(tz)); \
        int R0, C0, R1, C1; stage_rc(tz * 16, R0, C0); stage_rc(tz * 16 + 8192, R1, C1); \
        int g00 = R0, g01 = R1, g10 = HALF + R0, g11 = HALF + R1; \
        if (AUX == 1) { const LAS int* ri = (const LAS int*)(lds + STAGE_BYTES + (slot) * 2048); g00 = ri[g00]; g01 = ri[g01]; g10 = ri[g10]; g11 = ri[g11]; } \
        oA[0][0] = (unsigned)g00 * (unsigned)(u).lda + (unsigned)C0 * 2u; oA[0][1] = (unsigned)g01 * (unsigned)(u).lda + (unsigned)C1 * 2u; \
        if (AUX == 1) { oA[1][0] = (unsigned)g10 * (unsigned)(u).lda + (unsigned)C0 * 2u; oA[1][1] = (unsigned)g11 * (unsigned)(u).lda + (unsigned)C1 * 2u; } \
        oB[0] = (unsigned)GF_BROW(0, R0) * (unsigned)(u).ldb + (unsigned)C0 * 2u; oB[1] = (unsigned)GF_BROW(0, R1) * (unsigned)(u).ldb + (unsigned)C1 * 2u; } while (0)
#define GF_HA(u) ((AUX == 1) ? 0u : (unsigned)HALF * (unsigned)(u).lda)
#define GF_HB(u) ((unsigned)((MODE == 2) ? 8 : HALF) * (unsigned)(u).ldb)
#define GF_OA1(i) ((AUX == 1) ? oAc[1][i] : oAc[0][i])
    Unit cur, nxt; int ui = 0;
    if (!S.next(0, cur)) return;
    f32x4 acc[2][2][4][2];
#pragma unroll
    for (int a = 0; a < 2; ++a)
#pragma unroll
        for (int b = 0; b < 2; ++b)
#pragma unroll
            for (int m = 0; m < 4; ++m)
#pragma unroll
                for (int n = 0; n < 2; ++n) acc[a][b][m][n] = (f32x4){0.f, 0.f, 0.f, 0.f};
    bf16x8 At[4][2], B0[2][2], B1[2][2];
    unsigned oAc[2][2], oBc[2];
    GF_AUXDMA(cur, 0);
    if (AUX == 1) { GF_WAIT_V(0); __syncthreads(); }
    GF_SETOFF(cur, 0, oAc, oBc);
    unsigned cA = cur.A, cB = cur.B, chA = GF_HA(cur), chB = GF_HB(cur);
    GF_STAGE(GF_SB(0, 0), cB, oBc[0], oBc[1]); GF_STAGE(GF_SA(0, 0), cA, oAc[0][0], oAc[0][1]); GF_STAGE(GF_SB(0, 1), cB + chB, oBc[0], oBc[1]); GF_STAGE(GF_SA(0, 1), cA + chA, GF_OA1(0), GF_OA1(1));
    if (wr == 1) GF_BAR;
    GF_WAIT_V(4); GF_BAR;
    GF_STAGE(GF_SB(1, 0), cB + kstep, oBc[0], oBc[1]); GF_STAGE(GF_SA(1, 0), cA + kstep, oAc[0][0], oAc[0][1]); GF_STAGE(GF_SB(1, 1), cB + chB + kstep, oBc[0], oBc[1]);
    GF_WAIT_V(6); GF_BAR;
    for (;;) {
        const bool has_next = S.next(ui + 1, nxt);
        unsigned nA, nB, nhA, nhB;
        if (has_next) { nA = nxt.A; nB = nxt.B; nhA = GF_HA(nxt); nhB = GF_HB(nxt); GF_AUXDMA(nxt, (ui + 1) & 3); } else { nA = cA; nB = cB; nhA = chA; nhB = chB; }
        const int nt = cur.nt;
#pragma unroll 1
        for (int t = 0; t < nt; t += 2) {
            const bool last = (t == nt - 2);
            const unsigned a1 = cA + (unsigned)(t + 1) * kstep;
            const unsigned a2 = last ? nA : cA + (unsigned)(t + 2) * kstep, b2 = last ? nB : cB + (unsigned)(t + 2) * kstep;
            const unsigned a3 = a2 + kstep, b3 = b2 + kstep;
            const unsigned hA2 = last ? nhA : chA, hB2 = last ? nhB : chB;
            GF_LDB(B0, 0, 0); GF_SCHED; GF_LDA(At, 0, 0); GF_STAGE(GF_SA(1, 1), a1 + chA, GF_OA1(0), GF_OA1(1));
            if (GENERAL && last && has_next) {
                unsigned tB[2]; GF_SETOFF(nxt, (ui + 1) & 3, oAc, tB);
                if (GENB) { oBc[0] = tB[0]; oBc[1] = tB[1]; }
            }
            GF_WAIT_L(8); GF_BAR; GF_WAIT_L(0); GF_MMA(0, 0, At, B0); GF_BAR; GF_SCHED;
            GF_LDB(B1, 0, 1); GF_STAGE(GF_SB(0, 0), b2, oBc[0], oBc[1]);
            GF_BAR; GF_WAIT_L(0); GF_MMA(0, 1, At, B1); GF_BAR;
            GF_LDA(At, 0, 1); GF_STAGE(GF_SA(0, 0), a2, oAc[0][0], oAc[0][1]);
            GF_BAR; GF_WAIT_L(0); GF_MMA(1, 0, At, B0); GF_BAR; GF_SCHED;
            GF_STAGE(GF_SB(0, 1), b2 + hB2, oBc[0], oBc[1]);
            GF_WAIT_V(6); GF_BAR; GF_MMA(1, 1, At, B1); GF_BAR;
            GF_LDB(B0, 1, 0); GF_SCHED; GF_LDA(At, 1, 0); GF_STAGE(GF_SA(0, 1), a2 + hA2, GF_OA1(0), GF_OA1(1));
            GF_WAIT_L(8); GF_BAR; GF_WAIT_L(0); GF_MMA(0, 0, At, B0); GF_BAR; GF_SCHED;
            GF_LDB(B1, 1, 1); GF_STAGE(GF_SB(1, 0), b3, oBc[0], oBc[1]);
            GF_BAR; GF_WAIT_L(0); GF_MMA(0, 1, At, B1); GF_BAR;
            GF_LDA(At, 1, 1); GF_STAGE(GF_SA(1, 0), a3, oAc[0][0], oAc[0][1]);
            GF_BAR; GF_WAIT_L(0); GF_MMA(1, 0, At, B0); GF_BAR; GF_SCHED;
            GF_STAGE(GF_SB(1, 1), b3 + hB2, oBc[0], oBc[1]);
            GF_WAIT_V(6); GF_BAR; GF_MMA(1, 1, At, B1); GF_BAR;
        }
        {
            int tz = threadIdx.x; asm volatile("" : "+v"(tz) :: "memory");
            const int ewid = __builtin_amdgcn_readfirstlane(tz >> 6), el = tz & 63;
            E(acc, cur, ewid >> 2, ewid & 3, el & 15, el >> 4, (const LAS int*)(lds + STAGE_BYTES + (ui & 3) * 2048));
            asm volatile("" ::: "memory");
        }
        if (!has_next) break;
        if (!cur.keep) {
#pragma unroll
            for (int a = 0; a < 2; ++a)
#pragma unroll
                for (int b = 0; b < 2; ++b)
#pragma unroll
                    for (int m = 0; m < 4; ++m)
#pragma unroll
                        for (int n = 0; n < 2; ++n) acc[a][b][m][n] = (f32x4){0.f, 0.f, 0.f, 0.f};
        }
        cur = nxt; cA = nA; cB = nB; chA = nhA; chB = nhB; ++ui;
    }
    GF_WAIT_V(0);
    if (wr == 0) GF_BAR;
    GF_BAR;
#undef GF_SA
#undef GF_SB
#undef GF_STAGE
#undef GF_LDA
#undef GF_LDB
#undef GF_MMA
#undef GF_WAIT_V
#undef GF_WAIT_L
#undef GF_BAR
#undef GF_SCHED
#undef GF_SETOFF
#undef GF_AUXDMA
#undef GF_HA
#undef GF_HB
#undef GF_OA1
#undef GF_BROW
}
}

__device__ __forceinline__ int uload(const int* p) { return __builtin_amdgcn_readfirstlane(__hip_atomic_load(p, __ATOMIC_RELAXED, __HIP_MEMORY_SCOPE_AGENT)); }
__device__ __forceinline__ int vcu_of(int bid, int nb) { return (nb % 8 == 0) ? (bid % 8) * (nb / 8) + bid / 8 : bid; }

struct SchedPlain {
    unsigned A, B; int lda, ldb, nt, nN, nU, G, c; long r0base;
    __device__ __forceinline__ bool next(int i, gf::Unit& u) const {
        const int L = i * G + c; if (L >= nU) return false;
        const int pm = L / nN, pn = L % nN;
        u.A = A + (unsigned)pm * 256u * lda; u.B = B + (unsigned)pn * 256u * ldb; u.rowidx = nullptr; u.lda = lda; u.ldb = ldb; u.nt = nt; u.keep = 0;
        u.kind = 0; u.r0 = (int)(r0base + pm * 256); u.c0 = pn * 256; u.x0 = 0; u.aux0 = 0; u.aux1 = 0; return true;
    }
};
struct EpiProj { bf16* O; __device__ __forceinline__ void operator()(f32x4 (&acc)[2][2][4][2], const gf::Unit& u, int wr, int wc, int fr, int fq, const LAS int* aux) const { epi_bf16(acc, O, INW, u.r0, u.c0, wr, wc, fr, fq); } };
struct SchedProjPP {
    int G, c;
    __device__ __forceinline__ bool next(int i, gf::Unit& u) const {
        constexpr int nN = INW / 256, nProj = (T / 256) * nN, nPP = (T / 256) * 4;
        const int R = nProj / G, rem = nProj % G;
        u.rowidx = nullptr; u.keep = 0; u.x0 = 0; u.aux0 = 0; u.aux1 = 0;
        const int L = i * G + c;
        if (i < R || (i == R && c < rem)) { const int pm = L / nN, pn = L % nN;
            u.A = (unsigned)WS_XB + (unsigned)pm * 256u * (D * 2); u.B = (unsigned)WS_WINT + (unsigned)pn * 256u * (D * 2); u.lda = D * 2; u.ldb = D * 2; u.nt = D / 64; u.kind = 0; u.r0 = pm * 256; u.c0 = pn * 256; return true; }
        const int nw = G - rem, per = (nPP + nw - 1) / nw, j = i - R;
        if (c < rem || j >= per) return false;
        const int idx = (c - rem) * per + j; if (idx >= nPP) return false;
        const int pm = idx >> 2, pn = idx & 3;
        u.A = (unsigned)WS_PB + (unsigned)pm * 256u * (PLE * 2); u.B = (unsigned)WS_WPT + (unsigned)pn * 256u * (PLE * 2); u.lda = PLE * 2; u.ldb = PLE * 2; u.nt = PLE / 64; u.kind = 1; u.r0 = pm * 256; u.c0 = pn * 256; return true;
    }
};
struct EpiProjPP { bf16* proj; bf16* pp;
    __device__ __forceinline__ void operator()(f32x4 (&acc)[2][2][4][2], const gf::Unit& u, int wr, int wc, int fr, int fq, const LAS int* aux) const {
        if (u.kind == 0) epi_bf16(acc, proj, INW, u.r0, u.c0, wr, wc, fr, fq); else epi_bf16(acc, pp, D, u.r0, u.c0, wr, wc, fr, fq);
    }
};
__device__ void phase_proj(KArgs ka, LAS unsigned char* lds, int bid, int nb) {
    const Args a = ld_args(ka);
    SchedProjPP S{nb, vcu_of(bid, nb)};
    EpiProjPP E{(bf16*)(a.ws + WS_BIG), (bf16*)(a.ws + WS_PP)};
    gf::gemm_fast<true, 0, true, 0>(lds, a.ws, S, E);
}

struct EpiWout { const float* x; float* y;
    __device__ __forceinline__ void operator()(f32x4 (&acc)[2][2][4][2], const gf::Unit& u, int wr, int wc, int fr, int fq, const LAS int* aux) const {
#pragma unroll
        for (int ai = 0; ai < 2; ++ai)
#pragma unroll
            for (int mp = 0; mp < 2; ++mp) {
                f32x4 xv[2][2][2];
#pragma unroll
                for (int mm = 0; mm < 2; ++mm) { const int m = 2 * mp + mm;
                    const size_t off = (size_t)(u.r0 + 128 * ai + 64 * wr + 16 * m + fr) * D + u.c0 + 32 * wc + 8 * fq;
#pragma unroll
                    for (int bj = 0; bj < 2; ++bj)
#pragma unroll
                        for (int n = 0; n < 2; ++n) xv[mm][bj][n] = *(const f32x4*)(x + off + 128 * bj + 4 * n); }
#pragma unroll
                for (int mm = 0; mm < 2; ++mm) { const int m = 2 * mp + mm;
                    const size_t off = (size_t)(u.r0 + 128 * ai + 64 * wr + 16 * m + fr) * D + u.c0 + 32 * wc + 8 * fq;
#pragma unroll
                    for (int bj = 0; bj < 2; ++bj)
#pragma unroll
                        for (int n = 0; n < 2; ++n) *(f32x4*)(y + off + 128 * bj + 4 * n) = acc[ai][bj][m][n] + ALPHA * xv[mm][bj][n]; }
                asm volatile("" ::: "memory"); __builtin_amdgcn_sched_barrier(0);
            }
    }
};
__device__ void phase_wout(KArgs ka, LAS unsigned char* lds, int bid, int nb) {
    const Args a = ld_args(ka);
    SchedPlain S{(unsigned)WS_MIXO, (unsigned)WS_WOUTT, D * 2, D * 2, D / 64, D / 256, (T / 256) * (D / 256), nb, vcu_of(bid, nb), 0};
    EpiWout E{a.in[I_X], a.out};
    gf::gemm_fast<false, 0, false, 0>(lds, a.ws, S, E);
}

constexpr int QS = 72;
constexpr int TS = 136;
constexpr int TS2 = 264;
constexpr int L_QS = 0;
constexpr int L_KS = L_QS + 128 * QS * 2;
constexpr int L_KTW = L_KS + 256 * QS * 2;
constexpr int L_VT = L_KTW + 64 * TS * 2;
constexpr int L_ST = L_VT + 64 * TS2 * 2;
constexpr int L_MIX_END = L_ST + 64 * QS * 2;
static_assert(L_MIX_END <= 128 * 1024, "mixer LDS");

__device__ __forceinline__ void stage_ret(const Args& a, LAS unsigned char* lds, int b, int h, int n, bool want_q, float l2g) {
    const int tid = hidden_tid();
    const bf16* proj = (const bf16*)(a.ws + WS_BIG);
    const float* tab = (const float*)(a.ws + WS_TAB);
    const float* cosr = tab, *sinr = tab + SEQ * 32;
    LAS bf16* Qs = (LAS bf16*)(lds + L_QS); LAS bf16* Ks = (LAS bf16*)(lds + L_KS); LAS bf16* Ktw = (LAS bf16*)(lds + L_KTW); LAS bf16* Vt = (LAS bf16*)(lds + L_VT);
    const int row = tid >> 2, i0 = (tid & 3) * 8;
    const int pos = n * CH + row;
    const size_t t = (size_t)b * SEQ + pos;
    const bf16* prow = proj + t * INW;
    f32x4 c0 = *(const f32x4*)(cosr + pos * 32 + i0), c1 = *(const f32x4*)(cosr + pos * 32 + i0 + 4);
    f32x4 s0 = *(const f32x4*)(sinr + pos * 32 + i0), s1 = *(const f32x4*)(sinr + pos * 32 + i0 + 4);
    float cs[8] = {c0[0], c0[1], c0[2], c0[3], c1[0], c1[1], c1[2], c1[3]}, sn[8] = {s0[0], s0[1], s0[2], s0[3], s1[0], s1[1], s1[2], s1[3]};
    if (want_q) {
        const bf16x8 x1 = *(const bf16x8*)(prow + C_RQ + h * 64 + i0), x2 = *(const bf16x8*)(prow + C_RQ + h * 64 + 32 + i0);
        float o1[8], o2[8];
#pragma unroll
        for (int j = 0; j < 8; ++j) { const float a1 = bf2f((unsigned short)x1[j]), a2 = bf2f((unsigned short)x2[j]); o1[j] = a1 * cs[j] - a2 * sn[j]; o2[j] = a2 * cs[j] + a1 * sn[j]; }
        u32x4 w1, w2;
        w1.x = cvt_pk_bf16(o1[0], o1[1]); w1.y = cvt_pk_bf16(o1[2], o1[3]); w1.z = cvt_pk_bf16(o1[4], o1[5]); w1.w = cvt_pk_bf16(o1[6], o1[7]);
        w2.x = cvt_pk_bf16(o2[0], o2[1]); w2.y = cvt_pk_bf16(o2[2], o2[3]); w2.z = cvt_pk_bf16(o2[4], o2[5]); w2.w = cvt_pk_bf16(o2[6], o2[7]);
        *(LAS u32x4*)(Qs + row * QS + i0) = w1; *(LAS u32x4*)(Qs + row * QS + 32 + i0) = w2;
    }
    {
        const bf16x8 x1 = *(const bf16x8*)(prow + C_RK + h * 64 + i0), x2 = *(const bf16x8*)(prow + C_RK + h * 64 + 32 + i0);
        const float kw = exp2f((float)(CH - 1 - row) * l2g);
        float o1[8], o2[8];
#pragma unroll
        for (int j = 0; j < 8; ++j) { const float a1 = bf2f((unsigned short)x1[j]), a2 = bf2f((unsigned short)x2[j]); o1[j] = (a1 * cs[j] - a2 * sn[j]) * 0.125f; o2[j] = (a2 * cs[j] + a1 * sn[j]) * 0.125f; }
        if (want_q) {
            u32x4 w1, w2;
            w1.x = cvt_pk_bf16(o1[0], o1[1]); w1.y = cvt_pk_bf16(o1[2], o1[3]); w1.z = cvt_pk_bf16(o1[4], o1[5]); w1.w = cvt_pk_bf16(o1[6], o1[7]);
            w2.x = cvt_pk_bf16(o2[0], o2[1]); w2.y = cvt_pk_bf16(o2[2], o2[3]); w2.z = cvt_pk_bf16(o2[4], o2[5]); w2.w = cvt_pk_bf16(o2[6], o2[7]);
            *(LAS u32x4*)(Ks + row * QS + i0) = w1; *(LAS u32x4*)(Ks + row * QS + 32 + i0) = w2;
        }
#pragma unroll
        for (int j = 0; j < 8; ++j) { Ktw[(i0 + j) * TS + row] = f2bf(o1[j] * kw); Ktw[(32 + i0 + j) * TS + row] = f2bf(o2[j] * kw); }
    }
    {
        const bf16x8 v1 = *(const bf16x8*)(prow + C_RV + h * 64 + i0), v2 = *(const bf16x8*)(prow + C_RV + h * 64 + 32 + i0);
#pragma unroll
        for (int j = 0; j < 8; ++j) { Vt[(i0 + j) * TS2 + row] = (bf16)v1[j]; Vt[(32 + i0 + j) * TS2 + row] = (bf16)v2[j]; }
    }
}
__device__ __forceinline__ void ret_kv(LAS unsigned char* lds, int wid, int fr, int fq, f32x4 (&kv)[2]) {
    LAS bf16* Ktw = (LAS bf16*)(lds + L_KTW); LAS bf16* Vt = (LAS bf16*)(lds + L_VT);
#pragma unroll
    for (int i = 0; i < 2; ++i) {
        const int tl = 2 * wid + i, dt = tl >> 2, et = tl & 3;
        f32x4 c = {0.f, 0.f, 0.f, 0.f};
#pragma unroll
        for (int ks = 0; ks < 4; ++ks) {
            const bf16x8 kf = *(const LAS bf16x8*)(Ktw + (16 * dt + fr) * TS + 32 * ks + 8 * fq);
            const bf16x8 vf = *(const LAS bf16x8*)(Vt + (16 * et + fr) * TS2 + 32 * ks + 8 * fq);
            c = __builtin_amdgcn_mfma_f32_16x16x32_bf16(kf, vf, c, 0, 0, 0);
        }
        kv[i] = c;
    }
}
__device__ __forceinline__ float head_l2g(int h) { return log2f(1.0f - exp2f(-5.0f - (float)h)); }

__device__ void phase_segtot(KArgs ka, LAS unsigned char* lds, int bid, int nb) {
    const Args a = ld_args(ka);
    WAVE_IDS();
    float* segt = (float*)(a.ws + WS_SEGT);
    for (int it = bid; it < BATCH * RH * NSEG; it += nb) {
        const int seg = it % NSEG, h = (it / NSEG) % RH, b = it / (NSEG * RH);
        const float l2g = head_l2g(h), cd = exp2f(128.0f * l2g);
        f32x4 S[2] = {{0.f, 0.f, 0.f, 0.f}, {0.f, 0.f, 0.f, 0.f}};
        for (int c = 0; c < SEGC; ++c) {
            __syncthreads();
            stage_ret(a, lds, b, h, seg * SEGC + c, false, l2g);
            __syncthreads();
            f32x4 kv[2]; ret_kv(lds, wid, fr, fq, kv);
            S[0] = S[0] * cd + kv[0]; S[1] = S[1] * cd + kv[1];
        }
        float* dst = segt + (size_t)((b * RH + h) * NSEG + seg) * 4096;
#pragma unroll
        for (int i = 0; i < 2; ++i) { const int tl = 2 * wid + i, dt = tl >> 2, et = tl & 3;
#pragma unroll
            for (int j = 0; j < 4; ++j) dst[(16 * dt + 4 * fq + j) * 64 + 16 * et + fr] = S[i][j]; }
    }
}

__device__ void phase_retention(KArgs ka, LAS unsigned char* lds, int bid, int nb) {
    const Args a = ld_args(ka);
    WAVE_IDS();
    const float* segt = (const float*)(a.ws + WS_SEGT);
    const bf16* proj = (const bf16*)(a.ws + WS_BIG);
    bf16* mixo = (bf16*)(a.ws + WS_MIXO);
    const float* gain = a.in[I_GN];
    LAS bf16* Qs = (LAS bf16*)(lds + L_QS); LAS bf16* Ks = (LAS bf16*)(lds + L_KS); LAS bf16* Vt = (LAS bf16*)(lds + L_VT); LAS bf16* St = (LAS bf16*)(lds + L_ST);
    for (int it = bid; it < BATCH * RH * NSEG; it += nb) {
        const int seg = it % NSEG, h = (it / NSEG) % RH, b = it / (NSEG * RH);
        const float l2g = head_l2g(h), cd = exp2f(128.0f * l2g);
        f32x4 S[2] = {{0.f, 0.f, 0.f, 0.f}, {0.f, 0.f, 0.f, 0.f}};
        for (int sp = 0; sp < seg; ++sp) {
            const float wgt = exp2f(128.0f * l2g * (float)(SEGC * (seg - 1 - sp)));
            const float* src = segt + (size_t)((b * RH + h) * NSEG + sp) * 4096;
#pragma unroll
            for (int i = 0; i < 2; ++i) { const int tl = 2 * wid + i, dt = tl >> 2, et = tl & 3;
#pragma unroll
                for (int j = 0; j < 4; ++j) S[i][j] += wgt * src[(16 * dt + 4 * fq + j) * 64 + 16 * et + fr]; }
        }
        for (int c = 0; c < SEGC; ++c) {
            const int n = seg * SEGC + c;
            __syncthreads();
            stage_ret(a, lds, b, h, n, true, l2g);
#pragma unroll
            for (int i = 0; i < 2; ++i) { const int tl = 2 * wid + i, dt = tl >> 2, et = tl & 3;
                u32x2 w; w.x = cvt_pk_bf16(S[i][0], S[i][1]); w.y = cvt_pk_bf16(S[i][2], S[i][3]);
                *(LAS u32x2*)(St + (16 * et + fr) * QS + 16 * dt + 4 * fq) = w; }
            __syncthreads();
            bf16x8 qf[2];
#pragma unroll
            for (int ks = 0; ks < 2; ++ks) qf[ks] = *(const LAS bf16x8*)(Qs + (16 * wid + fr) * QS + 32 * ks + 8 * fq);
            f32x4 sc[8];
#pragma unroll
            for (int jt = 0; jt < 8; ++jt) {
                sc[jt] = (f32x4){0.f, 0.f, 0.f, 0.f};
                if (jt <= wid) {
#pragma unroll
                    for (int ks = 0; ks < 2; ++ks) {
                        const bf16x8 kf = *(const LAS bf16x8*)(Ks + (16 * jt + fr) * QS + 32 * ks + 8 * fq);
                        sc[jt] = __builtin_amdgcn_mfma_f32_16x16x32_bf16(kf, qf[ks], sc[jt], 0, 0, 0);
                    }
                    const int i = 16 * wid + fr;
#pragma unroll
                    for (int r = 0; r < 4; ++r) { const int j = 16 * jt + 4 * fq + r; const float dcy = exp2f((float)(i - j) * l2g); sc[jt][r] = (i >= j) ? sc[jt][r] * dcy : 0.f; }
                    asm volatile("" : "+v"(sc[jt]) :: "memory");
                }
            }
            f32x4 o[4], oi[4];
#pragma unroll
            for (int et = 0; et < 4; ++et) { o[et] = (f32x4){0.f, 0.f, 0.f, 0.f}; oi[et] = (f32x4){0.f, 0.f, 0.f, 0.f}; }
#pragma unroll
            for (int k2 = 0; k2 < 4; ++k2) {
                if (2 * k2 <= wid) {
                    bf16x8 pf; u32x4 pw;
                    pw.x = cvt_pk_bf16(sc[2 * k2][0], sc[2 * k2][1]); pw.y = cvt_pk_bf16(sc[2 * k2][2], sc[2 * k2][3]);
                    pw.z = cvt_pk_bf16(sc[2 * k2 + 1][0], sc[2 * k2 + 1][1]); pw.w = cvt_pk_bf16(sc[2 * k2 + 1][2], sc[2 * k2 + 1][3]);
                    pf = __builtin_bit_cast(bf16x8, pw);
#pragma unroll
                    for (int et = 0; et < 4; ++et) {
                        const u32x2 va = *(const LAS u32x2*)(Vt + (16 * et + fr) * TS2 + 32 * k2 + 4 * fq);
                        const u32x2 vb = *(const LAS u32x2*)(Vt + (16 * et + fr) * TS2 + 32 * k2 + 16 + 4 * fq);
                        u32x4 vw; vw.x = va.x; vw.y = va.y; vw.z = vb.x; vw.w = vb.y;
                        o[et] = __builtin_amdgcn_mfma_f32_16x16x32_bf16(__builtin_bit_cast(bf16x8, vw), pf, o[et], 0, 0, 0);
                    }
                }
            }
#pragma unroll
            for (int et = 0; et < 4; ++et)
#pragma unroll
                for (int ks = 0; ks < 2; ++ks) {
                    const bf16x8 sf = *(const LAS bf16x8*)(St + (16 * et + fr) * QS + 32 * ks + 8 * fq);
                    oi[et] = __builtin_amdgcn_mfma_f32_16x16x32_bf16(sf, qf[ks], oi[et], 0, 0, 0);
                }
            {
                const int i = 16 * wid + fr;
                const float qw = exp2f((float)(i + 1) * l2g);
                float sum = 0.f;
#pragma unroll
                for (int et = 0; et < 4; ++et)
#pragma unroll
                    for (int r = 0; r < 4; ++r) { o[et][r] += qw * oi[et][r]; sum += o[et][r]; }
                sum += __shfl_xor(sum, 16); sum += __shfl_xor(sum, 32);
                const float mean = sum * (1.0f / 64.0f);
                float q = 0.f;
#pragma unroll
                for (int et = 0; et < 4; ++et)
#pragma unroll
                    for (int r = 0; r < 4; ++r) { const float d = o[et][r] - mean; q += d * d; }
                q += __shfl_xor(q, 16); q += __shfl_xor(q, 32);
                const float rstd = rsqrtf(q * (1.0f / 64.0f) + GN_EPS);
                const size_t t = (size_t)b * SEQ + n * CH + i;
#pragma unroll
                for (int et = 0; et < 4; ++et) {
                    const int e0 = 16 * et + 4 * fq;
                    const u32x2 gw = *(const u32x2*)(proj + t * INW + C_RG + h * 64 + e0);
                    const f32x4 gn = *(const f32x4*)(gain + h * 64 + e0);
                    const float g0 = bf2f(gw.x & 0xffffu), g1 = bf2f(gw.x >> 16), g2 = bf2f(gw.y & 0xffffu), g3 = bf2f(gw.y >> 16);
                    const float y0 = (o[et][0] - mean) * rstd * gn[0] * siluf_(g0), y1 = (o[et][1] - mean) * rstd * gn[1] * siluf_(g1);
                    const float y2 = (o[et][2] - mean) * rstd * gn[2] * siluf_(g2), y3 = (o[et][3] - mean) * rstd * gn[3] * siluf_(g3);
                    u32x2 w; w.x = cvt_pk_bf16(y0, y1); w.y = cvt_pk_bf16(y2, y3);
                    *(u32x2*)(mixo + t * D + h * 64 + e0) = w;
                }
            }
            f32x4 kv[2]; ret_kv(lds, wid, fr, fq, kv);
            S[0] = S[0] * cd + kv[0]; S[1] = S[1] * cd + kv[1];
        }
    }
}

__device__ void phase_swa(KArgs ka, LAS unsigned char* lds, int bid, int nb) {
    const Args a = ld_args(ka);
    WAVE_IDS();
    const bf16* proj = (const bf16*)(a.ws + WS_BIG);
    bf16* mixo = (bf16*)(a.ws + WS_MIXO);
    const float* tab = (const float*)(a.ws + WS_TAB);
    const float* coss = tab + SEQ * 64, *sins = tab + SEQ * 72;
    const float* ascale = a.in[I_ASC]; const float* sinks = a.in[I_SINK];
    LAS bf16* Qs = (LAS bf16*)(lds + L_QS); LAS bf16* Ks = (LAS bf16*)(lds + L_KS); LAS bf16* Vt = (LAS bf16*)(lds + L_VT);
    for (int it = bid; it < BATCH * NCH * QH; it += nb) {
        const int qh = it % QH, n = (it / QH) % NCH, b = it / (QH * NCH), kvh = qh >> 2;
        __syncthreads();
        {
            const int row = tid >> 2, cg = tid & 3, pos = n * CH + row;
            const bf16* src = proj + ((size_t)b * SEQ + pos) * INW + C_AQ + qh * 64 + cg * 16;
            bf16x8 x1 = *(const bf16x8*)src, x2 = *(const bf16x8*)(src + 8);
            if (cg == 0) {
                const f32x4 c0 = *(const f32x4*)(coss + pos * 8), c1 = *(const f32x4*)(coss + pos * 8 + 4), s0 = *(const f32x4*)(sins + pos * 8), s1 = *(const f32x4*)(sins + pos * 8 + 4);
                const float cs[8] = {c0[0], c0[1], c0[2], c0[3], c1[0], c1[1], c1[2], c1[3]}, sn[8] = {s0[0], s0[1], s0[2], s0[3], s1[0], s1[1], s1[2], s1[3]};
                float o1[8], o2[8];
#pragma unroll
                for (int j = 0; j < 8; ++j) { const float a1 = bf2f((unsigned short)x1[j]), a2 = bf2f((unsigned short)x2[j]); o1[j] = a1 * cs[j] - a2 * sn[j]; o2[j] = a2 * cs[j] + a1 * sn[j]; }
                u32x4 w1, w2;
                w1.x = cvt_pk_bf16(o1[0], o1[1]); w1.y = cvt_pk_bf16(o1[2], o1[3]); w1.z = cvt_pk_bf16(o1[4], o1[5]); w1.w = cvt_pk_bf16(o1[6], o1[7]);
                w2.x = cvt_pk_bf16(o2[0], o2[1]); w2.y = cvt_pk_bf16(o2[2], o2[3]); w2.z = cvt_pk_bf16(o2[4], o2[5]); w2.w = cvt_pk_bf16(o2[6], o2[7]);
                x1 = __builtin_bit_cast(bf16x8, w1); x2 = __builtin_bit_cast(bf16x8, w2);
            }
            *(LAS bf16x8*)(Qs + row * QS + cg * 16) = x1; *(LAS bf16x8*)(Qs + row * QS + cg * 16 + 8) = x2;
        }
#pragma unroll
        for (int rep = 0; rep < 2; ++rep) {
            const int q = tid + rep * NTHREADS, kj = q >> 2, cg = q & 3, pos = n * CH - CH + kj;
            bf16x8 k1 = {0, 0, 0, 0, 0, 0, 0, 0}, k2 = k1, v1 = k1, v2 = k1;
            if (pos >= 0) {
                const bf16* srow = proj + ((size_t)b * SEQ + pos) * INW;
                k1 = *(const bf16x8*)(srow + C_AK + kvh * 64 + cg * 16); k2 = *(const bf16x8*)(srow + C_AK + kvh * 64 + cg * 16 + 8);
                v1 = *(const bf16x8*)(srow + C_AV + kvh * 64 + cg * 16); v2 = *(const bf16x8*)(srow + C_AV + kvh * 64 + cg * 16 + 8);
                if (cg == 0) {
                    const f32x4 c0 = *(const f32x4*)(coss + pos * 8), c1 = *(const f32x4*)(coss + pos * 8 + 4), s0 = *(const f32x4*)(sins + pos * 8), s1 = *(const f32x4*)(sins + pos * 8 + 4);
                    const float cs[8] = {c0[0], c0[1], c0[2], c0[3], c1[0], c1[1], c1[2], c1[3]}, sn[8] = {s0[0], s0[1], s0[2], s0[3], s1[0], s1[1], s1[2], s1[3]};
                    float o1[8], o2[8];
#pragma unroll
                    for (int j = 0; j < 8; ++j) { const float a1 = bf2f((unsigned short)k1[j]), a2 = bf2f((unsigned short)k2[j]); o1[j] = a1 * cs[j] - a2 * sn[j]; o2[j] = a2 * cs[j] + a1 * sn[j]; }
                    u32x4 w1, w2;
                    w1.x = cvt_pk_bf16(o1[0], o1[1]); w1.y = cvt_pk_bf16(o1[2], o1[3]); w1.z = cvt_pk_bf16(o1[4], o1[5]); w1.w = cvt_pk_bf16(o1[6], o1[7]);
                    w2.x = cvt_pk_bf16(o2[0], o2[1]); w2.y = cvt_pk_bf16(o2[2], o2[3]); w2.z = cvt_pk_bf16(o2[4], o2[5]); w2.w = cvt_pk_bf16(o2[6], o2[7]);
                    k1 = __builtin_bit_cast(bf16x8, w1); k2 = __builtin_bit_cast(bf16x8, w2);
                }
            }
            *(LAS bf16x8*)(Ks + kj * QS + cg * 16) = k1; *(LAS bf16x8*)(Ks + kj * QS + cg * 16 + 8) = k2;
#pragma unroll
            for (int j = 0; j < 8; ++j) { Vt[(cg * 16 + j) * TS2 + kj] = (bf16)v1[j]; Vt[(cg * 16 + 8 + j) * TS2 + kj] = (bf16)v2[j]; }
        }
        __syncthreads();
        const int jt0 = wid & ~1;
        bf16x8 qf[2];
#pragma unroll
        for (int ks = 0; ks < 2; ++ks) qf[ks] = *(const LAS bf16x8*)(Qs + (16 * wid + fr) * QS + 32 * ks + 8 * fq);
        f32x4 sc[10];
        const int i = 16 * wid + fr;
        float mx = sinks[qh];
#pragma unroll
        for (int tt = 0; tt < 10; ++tt) {
            const int jt = jt0 + tt;
            f32x4 c = {0.f, 0.f, 0.f, 0.f};
#pragma unroll
            for (int ks = 0; ks < 2; ++ks) {
                const bf16x8 kf = *(const LAS bf16x8*)(Ks + (16 * jt + fr) * QS + 32 * ks + 8 * fq);
                c = __builtin_amdgcn_mfma_f32_16x16x32_bf16(kf, qf[ks], c, 0, 0, 0);
            }
#pragma unroll
            for (int r = 0; r < 4; ++r) {
                const int kj = 16 * jt + 4 * fq + r;
                const bool valid = (kj > i) && (kj <= i + CH) && (n * CH - CH + kj >= 0);
                c[r] = valid ? c[r] * 0.125f : -1e30f;
                mx = fmaxf(mx, c[r]);
            }
            sc[tt] = c;
        }
        mx = fmaxf(mx, __shfl_xor(mx, 16)); mx = fmaxf(mx, __shfl_xor(mx, 32));
        float den = 0.f;
#pragma unroll
        for (int tt = 0; tt < 10; ++tt)
#pragma unroll
            for (int r = 0; r < 4; ++r) { const float p = (sc[tt][r] > -1e29f) ? __expf(sc[tt][r] - mx) : 0.f; sc[tt][r] = p; den += p; }
        den += __shfl_xor(den, 16); den += __shfl_xor(den, 32);
        den += __expf(sinks[qh] - mx);
        const float inv = 1.0f / den;
        f32x4 o[4];
#pragma unroll
        for (int et = 0; et < 4; ++et) o[et] = (f32x4){0.f, 0.f, 0.f, 0.f};
#pragma unroll
        for (int k2 = 0; k2 < 5; ++k2) {
            u32x4 pw;
            pw.x = cvt_pk_bf16(sc[2 * k2][0] * inv, sc[2 * k2][1] * inv); pw.y = cvt_pk_bf16(sc[2 * k2][2] * inv, sc[2 * k2][3] * inv);
            pw.z = cvt_pk_bf16(sc[2 * k2 + 1][0] * inv, sc[2 * k2 + 1][1] * inv); pw.w = cvt_pk_bf16(sc[2 * k2 + 1][2] * inv, sc[2 * k2 + 1][3] * inv);
            const bf16x8 pf = __builtin_bit_cast(bf16x8, pw);
            const int kb = 16 * (jt0 + 2 * k2);
#pragma unroll
            for (int et = 0; et < 4; ++et) {
                const u32x2 va = *(const LAS u32x2*)(Vt + (16 * et + fr) * TS2 + kb + 4 * fq);
                const u32x2 vb = *(const LAS u32x2*)(Vt + (16 * et + fr) * TS2 + kb + 16 + 4 * fq);
                u32x4 vw; vw.x = va.x; vw.y = va.y; vw.z = vb.x; vw.w = vb.y;
                o[et] = __builtin_amdgcn_mfma_f32_16x16x32_bf16(__builtin_bit_cast(bf16x8, vw), pf, o[et], 0, 0, 0);
            }
        }
        const size_t t = (size_t)b * SEQ + n * CH + i;
#pragma unroll
        for (int et = 0; et < 4; ++et) {
            const int e0 = 16 * et + 4 * fq;
            const f32x4 as = *(const f32x4*)(ascale + qh * 64 + e0);
            u32x2 w; w.x = cvt_pk_bf16(o[et][0] * as[0], o[et][1] * as[1]); w.y = cvt_pk_bf16(o[et][2] * as[2], o[et][3] * as[3]);
            *(u32x2*)(mixo + t * D + 512 + qh * 64 + e0) = w;
        }
    }
}

template <int MODE>
__device__ void phase_ln(const float* src, const float* g, const float* bta, bf16* dstb, unsigned char* dstq, float* dstf, int bid, int nb) {
    const int tid = hidden_tid(), wid = tid >> 6, lane = tid & 63;
    f32x4 gv[4], bv[4];
#pragma unroll
    for (int i = 0; i < 4; ++i) { gv[i] = *(const f32x4*)(g + 256 * i + lane * 4); bv[i] = *(const f32x4*)(bta + 256 * i + lane * 4); }
    for (int row = bid * 8 + wid; row < T; row += nb * 8) {
        const float* r = src + (size_t)row * D;
        f32x4 v[4]; float s = 0.f;
#pragma unroll
        for (int i = 0; i < 4; ++i) { v[i] = *(const f32x4*)(r + 256 * i + lane * 4); s += (v[i][0] + v[i][1]) + (v[i][2] + v[i][3]); }
#pragma unroll
        for (int o = 32; o >= 1; o >>= 1) s += __shfl_xor(s, o);
        const float mean = s * (1.0f / D);
        float q = 0.f;
#pragma unroll
        for (int i = 0; i < 4; ++i) { const f32x4 d = v[i] - mean; q += (d[0] * d[0] + d[1] * d[1]) + (d[2] * d[2] + d[3] * d[3]); }
#pragma unroll
        for (int o = 32; o >= 1; o >>= 1) q += __shfl_xor(q, o);
        const float rstd = rsqrtf(q * (1.0f / D) + LN_EPS);
#pragma unroll
        for (int i = 0; i < 4; ++i) {
            const f32x4 y = (v[i] - mean) * rstd * gv[i] + bv[i];
            if (MODE == 0) { u32x2 w; w.x = cvt_pk_bf16(y[0], y[1]); w.y = cvt_pk_bf16(y[2], y[3]); *(u32x2*)(dstb + (size_t)row * D + 256 * i + lane * 4) = w;
                int q = 0; q = __builtin_amdgcn_cvt_pk_fp8_f32(y[0], y[1], q, false); q = __builtin_amdgcn_cvt_pk_fp8_f32(y[2], y[3], q, true);
                *(int*)(dstq + (size_t)row * D + 256 * i + lane * 4) = q; }
            else *(f32x4*)(dstf + (size_t)row * D + 256 * i + lane * 4) = y;
        }
    }
}

__device__ void phase_router(KArgs ka, LAS unsigned char* lds, int bid, int nb) {
    const Args a = ld_args(ka);
    WAVE_IDS();
    const bf16* x1b = (const bf16*)(a.ws + WS_XB); const bf16* wrt = (const bf16*)(a.ws + WS_WRT);
    unsigned char* ro = a.ws + WS_ROUT;
    int* ridx = (int*)(ro + RO_RIDX); float* rw = (float*)(ro + RO_RW); int* cnt = (int*)(ro + RO_CNT);
    const float* rbias = a.in[I_RB];
    LAS float* lg = (LAS float*)lds;
    LAS float* bi = lg + 128 * 65;
    LAS int* hist = (LAS int*)(bi + 128 * 65);
    for (int u = bid; u < T / 128; u += nb) {
        __syncthreads();
        if (tid < 64) hist[tid] = 0;
        {
            f32x4 c[4];
#pragma unroll
            for (int et = 0; et < 4; ++et) c[et] = (f32x4){0.f, 0.f, 0.f, 0.f};
            const bf16* xa = x1b + (size_t)(u * 128 + 16 * wid + fr) * D + 8 * fq;
#pragma unroll 4
            for (int k0 = 0; k0 < D; k0 += 32) {
                const bf16x8 xf = *(const bf16x8*)(xa + k0);
#pragma unroll
                for (int et = 0; et < 4; ++et) {
                    const bf16x8 wf = *(const bf16x8*)(wrt + (size_t)(16 * et + fr) * D + k0 + 8 * fq);
                    c[et] = __builtin_amdgcn_mfma_f32_16x16x32_bf16(wf, xf, c[et], 0, 0, 0);
                }
            }
#pragma unroll
            for (int et = 0; et < 4; ++et)
#pragma unroll
                for (int r = 0; r < 4; ++r) {
                    const int e = 16 * et + 4 * fq + r; const float s = sigmoidf_(c[et][r]);
                    lg[(16 * wid + fr) * 65 + e] = s; bi[(16 * wid + fr) * 65 + e] = s + rbias[e];
                }
        }
        __syncthreads();
        {
            const int tl = tid >> 2, p = tid & 3;
            const LAS float* mb = bi + tl * 65 + 16 * p; const LAS float* ms = lg + tl * 65 + 16 * p;
            float b[16], sg[16];
#pragma unroll
            for (int j = 0; j < 16; ++j) { b[j] = mb[j]; sg[j] = ms[j]; }
            float gsc[2];
#pragma unroll
            for (int g = 0; g < 2; ++g) {
                float m1 = -3e38f, m2 = -3e38f;
#pragma unroll
                for (int j = 0; j < 8; ++j) { const float v = b[8 * g + j]; const float lo = fminf(v, m1); m1 = fmaxf(v, m1); m2 = fmaxf(m2, lo); }
                gsc[g] = m1 + m2;
            }
            int rank0 = 0, rank1 = 0;
#pragma unroll
            for (int q = 0; q < 4; ++q) {
                const float o0 = __shfl(gsc[0], (lane & ~3) | q), o1 = __shfl(gsc[1], (lane & ~3) | q);
                const int og0 = 2 * q, og1 = 2 * q + 1, mg0 = 2 * p, mg1 = 2 * p + 1;
                rank0 += (o0 > gsc[0] || (o0 == gsc[0] && og0 < mg0)) ? 1 : 0; rank0 += (o1 > gsc[0] || (o1 == gsc[0] && og1 < mg0)) ? 1 : 0;
                rank1 += (o0 > gsc[1] || (o0 == gsc[1] && og0 < mg1)) ? 1 : 0; rank1 += (o1 > gsc[1] || (o1 == gsc[1] && og1 < mg1)) ? 1 : 0;
            }
#pragma unroll
            for (int j = 0; j < 16; ++j) { const bool ok = (j < 8) ? (rank0 < 4) : (rank1 < 4); b[j] = ok ? b[j] : -3e38f; }
            float wsel[8]; int sel[8]; float wsum = 0.f;
#pragma unroll
            for (int rnd = 0; rnd < 8; ++rnd) {
                float bv = -3e38f; int bi_ = 0; float bs = 0.f;
#pragma unroll
                for (int j = 0; j < 16; ++j) { const bool gt = b[j] > bv; bv = gt ? b[j] : bv; bi_ = gt ? j : bi_; bs = gt ? sg[j] : bs; }
                int gi = 16 * p + bi_;
#pragma unroll
                for (int o = 1; o <= 2; o <<= 1) {
                    const float ov = __shfl_xor(bv, o); const int oi = __shfl_xor(gi, o); const float os = __shfl_xor(bs, o);
                    const bool take = (ov > bv) || (ov == bv && oi < gi);
                    bv = take ? ov : bv; gi = take ? oi : gi; bs = take ? os : bs;
                }
                sel[rnd] = gi; wsel[rnd] = bs; wsum += bs;
#pragma unroll
                for (int j = 0; j < 16; ++j) b[j] = (gi == 16 * p + j) ? -3e38f : b[j];
            }
            const float sc = ROUTED_SCALE / wsum;
            const size_t t = (size_t)u * 128 + tl;
#pragma unroll
            for (int k = 0; k < 8; ++k) if ((k >> 1) == p) { ridx[t * 8 + k] = sel[k]; rw[t * 8 + k] = wsel[k] * sc; __hip_atomic_fetch_add(&hist[sel[k]], 1, __ATOMIC_RELAXED, __HIP_MEMORY_SCOPE_WORKGROUP); }
        }
        __syncthreads();
        if (tid < 64) cnt[u * 64 + tid] = hist[tid];
    }
}

__device__ void phase_sort(KArgs ka, LAS unsigned char* lds, int bid, int nb) {
    const Args a = ld_args(ka);
    const int tid = hidden_tid();
    unsigned char* ro = a.ws + WS_ROUT;
    const int* ridx = (const int*)(ro + RO_RIDX); const float* rw = (const float*)(ro + RO_RW); const int* cnt = (const int*)(ro + RO_CNT);
    int* stok = (int*)(ro + RO_STOK); int* dest = (int*)(ro + RO_DEST); float* rsc = (float*)(ro + RO_RSC); int* tile = (int*)(ro + RO_TILE);
    LAS int* tot = (LAS int*)lds; LAS int* pos0 = tot + 64; LAS int* lcnt = pos0 + 64; LAS int* base = lcnt + 64;
    LAS int* psum = base + 80;
    constexpr int UPC = TC / 128;
    for (int u = bid; u < T / 128; u += nb) {
        const int c = u / UPC, ul = u % UPC;
        __syncthreads();
        {
            const int e = tid & 63, part = tid >> 6;
            int tt = 0, pre = 0;
#pragma unroll 8
            for (int q = part * (UPC / 8); q < (part + 1) * (UPC / 8); ++q) { const int v = __hip_atomic_load(cnt + (c * UPC + q) * 64 + e, __ATOMIC_RELAXED, __HIP_MEMORY_SCOPE_AGENT); tt += v; pre += (q < ul) ? v : 0; }
            psum[part * 64 + e] = tt; psum[512 + part * 64 + e] = pre;
        }
        __syncthreads();
        if (tid < 64) {
            int tt = 0, pre = 0;
#pragma unroll
            for (int q = 0; q < 8; ++q) { tt += psum[q * 64 + tid]; pre += psum[512 + q * 64 + tid]; }
            tot[tid] = tt; pos0[tid] = pre; lcnt[tid] = 0;
        }
        __syncthreads();
        if (tid == 0) { int acc = 0; for (int e = 0; e < 64; ++e) { base[e] = acc; acc += (tot[e] + 255) & ~255; } base[64] = acc; }
        __syncthreads();
        int* stok_c = stok + (size_t)c * RMAX; int* dest_c = dest + (size_t)c * RMAX; float* rsc_c = rsc + (size_t)c * RMAX;
#pragma unroll
        for (int rep = 0; rep < 2; ++rep) {
            const int pr = tid + rep * NTHREADS, tl = pr >> 3, k = pr & 7;
            const size_t t = (size_t)u * 128 + tl;
            const int e = ridx[t * 8 + k];
            const int rank = __hip_atomic_fetch_add(&lcnt[e], 1, __ATOMIC_RELAXED, __HIP_MEMORY_SCOPE_WORKGROUP);
            const int pos = base[e] + pos0[e] + rank;
            stok_c[pos] = (int)t; dest_c[pos] = (int)(t - (size_t)c * TC) * 8 + k; rsc_c[pos] = rw[t * 8 + k];
        }
        if (ul < 64) {
            const int e = ul, lo = base[e] + tot[e], hi = base[e + 1];
            for (int r = lo + tid; r < hi; r += NTHREADS) { stok_c[r] = c * TC; dest_c[r] = TC * 8; rsc_c[r] = 0.f; }
        }
        if (ul == 0) {
            if (tid < 64) { for (int mt = base[tid] / 256; mt < base[tid + 1] / 256; ++mt) tile[c * TILE_STRIDE + mt] = tid; }
            if (tid == 0) tile[c * TILE_STRIDE + TILE_STRIDE - 1] = base[64] / 256;
        }
    }
}

struct SchedShared {
    int G, c;
    __device__ __forceinline__ bool next(int i, gf::Unit& u) const {
        constexpr int nU1 = (T / 256) * 2;
        const int L = i * G + c; if (L >= nU1) return false;
        u.rowidx = nullptr; u.keep = 0; u.x0 = 0; u.aux0 = 0; u.aux1 = 0;
        const int pm = L >> 1, pn = L & 1; u.A = (unsigned)WS_XB + (unsigned)pm * 256u * (D * 2); u.B = (unsigned)WS_WS13T + (unsigned)pn * 256u * (D * 2); u.lda = D * 2; u.ldb = D * 2; u.nt = D / 64; u.kind = 0; u.r0 = pm * 256; u.c0 = pn * 128;
        return true;
    }
};
struct EpiShared { bf16* hs;
    __device__ __forceinline__ void operator()(f32x4 (&acc)[2][2][4][2], const gf::Unit& u, int wr, int wc, int fr, int fq, const LAS int* aux) const { epi_gate(acc, hs, SDIM, u.r0, u.c0, wr, wc, fr, fq); }
};
__device__ void phase_shared(KArgs ka, LAS unsigned char* lds, int bid, int nb) {
    const Args a = ld_args(ka);
    SchedShared S{nb, vcu_of(bid, nb)};
    EpiShared E{(bf16*)(a.ws + WS_HS)};
    gf::gemm_fast<false, 0, false, 0>(lds, a.ws, S, E);
}

struct SchedBase {
    int G, c;
    __device__ __forceinline__ bool next(int i, gf::Unit& u) const {
        constexpr int nU = (T / 256) * 4;
        const int v = (i >> 1) * G + c, part = i & 1; if (v >= nU) return false;
        const int pm = v >> 2, pn = v & 3;
        u.rowidx = nullptr; u.x0 = 0; u.aux0 = 0; u.aux1 = 0; u.r0 = pm * 256; u.c0 = pn * 256; u.kind = part; u.keep = 1 - part;
        if (part == 0) { u.A = (unsigned)WS_XB + (unsigned)pm * 256u * (D * 2); u.B = (unsigned)WS_WGT + (unsigned)pn * 256u * (D * 2); u.lda = D * 2; u.ldb = D * 2; u.nt = D / 64; }
        else { u.A = (unsigned)WS_HS + (unsigned)pm * 256u * (SDIM * 2); u.B = (unsigned)WS_WS2T + (unsigned)pn * 256u * (SDIM * 2); u.lda = SDIM * 2; u.ldb = SDIM * 2; u.nt = SDIM / 64; }
        return true;
    }
};
struct EpiBase { const bf16* x1b; const bf16* pp; const float* bg; float* y;
    __device__ __forceinline__ void operator()(f32x4 (&acc)[2][2][4][2], const gf::Unit& u, int wr, int wc, int fr, int fq, const LAS int* aux) const {
        if (u.kind == 0) {
            f32x4 bgv[2][2];
#pragma unroll
            for (int bj = 0; bj < 2; ++bj) { const int col = u.c0 + 128 * bj + 32 * wc + 8 * fq; bgv[bj][0] = *(const f32x4*)(bg + col); bgv[bj][1] = *(const f32x4*)(bg + col + 4); }
#pragma unroll
            for (int am = 0; am < 4; ++am) {
                const int ai = am >> 1, m0 = (am & 1) * 2;
                asm volatile("" : "+v"(acc[ai][0][m0][0]), "+v"(acc[ai][0][m0][1]), "+v"(acc[ai][1][m0][0]), "+v"(acc[ai][1][m0][1]),
                                  "+v"(acc[ai][0][m0 + 1][0]), "+v"(acc[ai][0][m0 + 1][1]), "+v"(acc[ai][1][m0 + 1][0]), "+v"(acc[ai][1][m0 + 1][1]) :: "memory");
                u32x4 pw[2][2], xw[2][2];
#pragma unroll
                for (int mm = 0; mm < 2; ++mm) {
                    const size_t t = (size_t)(u.r0 + 128 * ai + 64 * wr + 16 * (m0 + mm) + fr);
#pragma unroll
                    for (int bj = 0; bj < 2; ++bj) { const int col = u.c0 + 128 * bj + 32 * wc + 8 * fq; pw[mm][bj] = *(const u32x4*)(pp + t * D + col); xw[mm][bj] = *(const u32x4*)(x1b + t * D + col); }
                }
#pragma unroll
                for (int mm = 0; mm < 2; ++mm)
#pragma unroll
                    for (int bj = 0; bj < 2; ++bj) {
                        const int m = m0 + mm;
                        const unsigned pws[4] = {pw[mm][bj].x, pw[mm][bj].y, pw[mm][bj].z, pw[mm][bj].w}, xws[4] = {xw[mm][bj].x, xw[mm][bj].y, xw[mm][bj].z, xw[mm][bj].w};
                        float v[8];
#pragma unroll
                        for (int j = 0; j < 8; ++j) {
                            const float gacc = acc[ai][bj][m][j >> 2][j & 3] + bgv[bj][j >> 2][j & 3];
                            const float ppv = (j & 1) ? bf2f(pws[j >> 1] >> 16) : bf2f(pws[j >> 1] & 0xffffu);
                            const float xv = (j & 1) ? bf2f(xws[j >> 1] >> 16) : bf2f(xws[j >> 1] & 0xffffu);
                            v[j] = sigmoidf_(gacc) * ppv + ALPHA * xv;
                        }
                        acc[ai][bj][m][0] = (f32x4){v[0], v[1], v[2], v[3]}; acc[ai][bj][m][1] = (f32x4){v[4], v[5], v[6], v[7]};
                    }
                asm volatile("" ::: "memory"); __builtin_amdgcn_sched_barrier(0);
            }
        } else {
#pragma unroll
            for (int ai = 0; ai < 2; ++ai)
#pragma unroll
                for (int m = 0; m < 4; ++m) {
                    const size_t off = (size_t)(u.r0 + 128 * ai + 64 * wr + 16 * m + fr) * D + u.c0 + 32 * wc + 8 * fq;
#pragma unroll
                    for (int bj = 0; bj < 2; ++bj)
#pragma unroll
                        for (int n = 0; n < 2; ++n) *(f32x4*)(y + off + 128 * bj + 4 * n) = acc[ai][bj][m][n];
                }
        }
    }
};
__device__ void phase_base(KArgs ka, LAS unsigned char* lds, int bid, int nb) {
    const Args a = ld_args(ka);
    SchedBase S{nb, vcu_of(bid, nb)};
    EpiBase E{(const bf16*)(a.ws + WS_XB), (const bf16*)(a.ws + WS_PP), a.in[I_BG], a.out};
    gf::gemm_fast<true, 0, true, 0>(lds, a.ws, S, E);
}

constexpr int LDS_TILECACHE = gf::STAGE_BYTES + 4 * 2048;
struct SchedMoeUp {
    const LAS int* ltile; unsigned stok_off; int nU, G, c;
    __device__ __forceinline__ bool next(int i, gf::Unit& u) const {
        const int L = i * G + c; if (L >= nU) return false;
        const int mt = L >> 1, pn = L & 1, e = __builtin_amdgcn_readfirstlane(ltile[mt]);
        u.A = (unsigned)WS_X1Q; u.rowidx = nullptr; u.B = (unsigned)WS_W13Q + ((unsigned)e * 512u + pn * 256u) * D; u.lda = D; u.ldb = D; u.nt = D / 128; u.keep = 0;
        u.kind = 0; u.r0 = mt * 256; u.c0 = pn * 128; u.x0 = 0; u.aux0 = stok_off + (unsigned)mt * 1024u; u.aux1 = 0; return true;
    }
};
struct EpiMoeUp { unsigned char* hsort;
    __device__ __forceinline__ void operator()(f32x4 (&acc)[2][2][4][2], const gf::Unit& u, int wr, int wc, int fr, int fq, const LAS int* aux) const {
#pragma unroll
        for (int ai = 0; ai < 2; ++ai)
#pragma unroll
            for (int m = 0; m < 4; ++m) {
                unsigned char* rp = hsort + (size_t)(u.r0 + 128 * ai + 64 * wr + 16 * m + fr) * EDIM + u.c0 + 32 * wc + 8 * fq;
                asm volatile("" : "+v"(acc[ai][0][m][0]), "+v"(acc[ai][0][m][1]), "+v"(acc[ai][1][m][0]), "+v"(acc[ai][1][m][1]) :: "memory");
                float h[8];
#pragma unroll
                for (int n = 0; n < 2; ++n)
#pragma unroll
                    for (int j = 0; j < 4; ++j) h[4 * n + j] = siluf_(acc[ai][0][m][n][j] * W8_INV) * (acc[ai][1][m][n][j] * W8_INV);
                int q0 = 0, q1 = 0;
                q0 = __builtin_amdgcn_cvt_pk_fp8_f32(h[0], h[1], q0, false); q0 = __builtin_amdgcn_cvt_pk_fp8_f32(h[2], h[3], q0, true);
                q1 = __builtin_amdgcn_cvt_pk_fp8_f32(h[4], h[5], q1, false); q1 = __builtin_amdgcn_cvt_pk_fp8_f32(h[6], h[7], q1, true);
                *(u32x2*)rp = (u32x2){(unsigned)q0, (unsigned)q1};
            }
    }
};
__device__ __forceinline__ int load_tile_cache(const Args& a, LAS unsigned char* lds, int c) {
    const int* tile = (const int*)(a.ws + WS_ROUT + RO_TILE) + c * TILE_STRIDE;
    const int ntl = uload(tile + TILE_STRIDE - 1);
    LAS int* ltile = (LAS int*)(lds + LDS_TILECACHE);
    for (int i = hidden_tid(); i < ntl; i += NTHREADS) ltile[i] = __hip_atomic_load(tile + i, __ATOMIC_RELAXED, __HIP_MEMORY_SCOPE_AGENT);
    __syncthreads();
    return ntl;
}
__device__ void phase_moe_up(KArgs ka, LAS unsigned char* lds, int c, int bid, int nb) {
    const Args a = ld_args(ka);
    const int ntl = load_tile_cache(a, lds, c);
    SchedMoeUp S{(const LAS int*)(lds + LDS_TILECACHE), (unsigned)(WS_ROUT + RO_STOK + (size_t)c * RMAX * 4), ntl * 2, nb, vcu_of(bid, nb)};
    EpiMoeUp E{a.ws + WS_HSORT};
    gf::gemm_fast<true, 1, false, 1>(lds, a.ws, S, E);
}
struct SchedMoeDown {
    const LAS int* ltile; unsigned dest_off, rsc_off; int nU, G, c;
    __device__ __forceinline__ bool next(int i, gf::Unit& u) const {
        const int L = i * G + c; if (L >= nU) return false;
        const int mt = L >> 2, pn = L & 3, e = __builtin_amdgcn_readfirstlane(ltile[mt]);
        u.A = (unsigned)WS_HSORT + (unsigned)mt * 256u * EDIM; u.rowidx = nullptr; u.B = (unsigned)WS_W2Q + ((unsigned)e * D + pn * 256u) * EDIM; u.lda = EDIM; u.ldb = EDIM; { int ntv = EDIM / 128; asm volatile("" : "+s"(ntv)); u.nt = ntv; } u.keep = 0;
        u.kind = 0; u.r0 = mt * 256; u.c0 = pn * 256; u.x0 = 0; u.aux0 = dest_off + (unsigned)mt * 1024u; u.aux1 = rsc_off + (unsigned)mt * 1024u; return true;
    }
};
struct EpiMoeDown { unsigned char* contrib;
    __device__ __forceinline__ void operator()(f32x4 (&acc)[2][2][4][2], const gf::Unit& u, int wr, int wc, int fr, int fq, const LAS int* aux) const {
#pragma unroll
        for (int ai = 0; ai < 2; ++ai) {
            int dr[4]; float sc[4];
#pragma unroll
            for (int m = 0; m < 4; ++m) { const int rl = 128 * ai + 64 * wr + 16 * m + fr; dr[m] = aux[rl]; sc[m] = __int_as_float(aux[256 + rl]) * (W8_INV * C8_SCALE); }
#pragma unroll
            for (int m = 0; m < 4; ++m) {
                const float s = sc[m];
                unsigned char* rp = contrib + (size_t)dr[m] * D + u.c0 + 64 * wc + 16 * fq;
                int w[4];
#pragma unroll
                for (int bj = 0; bj < 2; ++bj)
#pragma unroll
                    for (int n = 0; n < 2; ++n) {
                        const f32x4 v = acc[ai][bj][m][n] * s; int x = 0;
                        x = __builtin_amdgcn_cvt_pk_fp8_f32(v[0], v[1], x, false); x = __builtin_amdgcn_cvt_pk_fp8_f32(v[2], v[3], x, true);
                        w[2 * bj + n] = x;
                    }
                *(u32x4*)rp = (u32x4){(unsigned)w[0], (unsigned)w[1], (unsigned)w[2], (unsigned)w[3]};
            }
            asm volatile("" ::: "memory"); __builtin_amdgcn_sched_barrier(0);
        }
    }
};
__device__ void phase_moe_down(KArgs ka, LAS unsigned char* lds, int c, int bid, int nb) {
    const Args a = ld_args(ka);
    const int ntl = load_tile_cache(a, lds, c);
    SchedMoeDown S{(const LAS int*)(lds + LDS_TILECACHE), (unsigned)(WS_ROUT + RO_DEST + (size_t)c * RMAX * 4), (unsigned)(WS_ROUT + RO_RSC + (size_t)c * RMAX * 4), ntl * 4, nb, vcu_of(bid, nb)};
    EpiMoeDown E{a.ws + WS_CONTRIB};
    gf::gemm_fast<false, 2, false, 2>(lds, a.ws, S, E);
}
__device__ void phase_combine(KArgs ka, int c, int bid, int nb) {
    const Args a = ld_args(ka);
    typedef float f32x2 __attribute__((ext_vector_type(2)));
    const int tid = hidden_tid(), wid = tid >> 6, lane = tid & 63;
    const unsigned char* contrib = a.ws + WS_CONTRIB;
    const float* g = a.in[I_LN2G]; const float* bta = a.in[I_LN2B]; float* y = a.out;
    f32x4 gv[4], bv[4];
#pragma unroll
    for (int j = 0; j < 4; ++j) { gv[j] = *(const f32x4*)(g + 16 * lane + 4 * j); bv[j] = *(const f32x4*)(bta + 16 * lane + 4 * j); }
    for (int rl = bid * 8 + wid; rl < TC; rl += nb * 8) {
        float* row = y + ((size_t)c * TC + rl) * D;
        f32x4 v[4];
#pragma unroll
        for (int j = 0; j < 4; ++j) v[j] = *(const f32x4*)(row + 16 * lane + 4 * j);
        u32x4 cw[8];
#pragma unroll
        for (int k = 0; k < 8; ++k) cw[k] = *(const u32x4*)(contrib + ((size_t)rl * 8 + k) * D + 16 * lane);
        f32x4 s4[4];
#pragma unroll
        for (int j = 0; j < 4; ++j) s4[j] = (f32x4){0.f, 0.f, 0.f, 0.f};
#pragma unroll
        for (int k = 0; k < 8; ++k) {
            const unsigned ws4[4] = {cw[k].x, cw[k].y, cw[k].z, cw[k].w};
#pragma unroll
            for (int j = 0; j < 4; ++j) {
                const f32x2 lo = __builtin_amdgcn_cvt_pk_f32_fp8((int)ws4[j], false), hi = __builtin_amdgcn_cvt_pk_f32_fp8((int)ws4[j], true);
                s4[j][0] += lo.x; s4[j][1] += lo.y; s4[j][2] += hi.x; s4[j][3] += hi.y;
            }
        }
#pragma unroll
        for (int j = 0; j < 4; ++j) v[j] += s4[j] * C8_INV;
        float s = 0.f;
#pragma unroll
        for (int i = 0; i < 4; ++i) s += (v[i][0] + v[i][1]) + (v[i][2] + v[i][3]);
#pragma unroll
        for (int o = 32; o >= 1; o >>= 1) s += __shfl_xor(s, o);
        const float mean = s * (1.0f / D);
        float q = 0.f;
#pragma unroll
        for (int i = 0; i < 4; ++i) { const f32x4 d = v[i] - mean; q += (d[0] * d[0] + d[1] * d[1]) + (d[2] * d[2] + d[3] * d[3]); }
#pragma unroll
        for (int o = 32; o >= 1; o >>= 1) q += __shfl_xor(q, o);
        const float rstd = rsqrtf(q * (1.0f / D) + LN_EPS);
#pragma unroll
        for (int j = 0; j < 4; ++j) *(f32x4*)(row + 16 * lane + 4 * j) = (v[j] - mean) * rstd * gv[j] + bv[j];
    }
}

#define XB_TMO      128
#define XB_XCNT(j)  (256  + 64 * (j))
#define XB_XSUB(j)  (1280 + 64 * (j))
#define XB_XGEN(j)  (2304 + 64 * (j))
#define XB_TOP      3328
#define XB_TOPGEN   3392
#define XCD_BAR_WORDS 3456
#define XB_SPIN_CAP (1u << 18)

__device__ __forceinline__ unsigned xb_ld(unsigned* p)              { return __hip_atomic_load(p, __ATOMIC_RELAXED, __HIP_MEMORY_SCOPE_AGENT); }
__device__ __forceinline__ unsigned xb_add(unsigned* p, unsigned v) { return __hip_atomic_fetch_add(p, v, __ATOMIC_RELAXED, __HIP_MEMORY_SCOPE_AGENT); }
__device__ __forceinline__ unsigned xb_xcc_id() { return (unsigned)__builtin_amdgcn_s_getreg((3 << 11) | 20) & 0xFu; }
#define XB_SPIN(cond, bar) do { unsigned _sp = 0; while (cond) { __builtin_amdgcn_s_sleep(1); \
    if ((++_sp & 255u) == 0u) { if (xb_ld(&(bar)[XB_TMO])) break; if (_sp > XB_SPIN_CAP) { atomicAdd(&(bar)[XB_TMO], 1u); break; } } } } while (0)

struct XcdBarrier {
    unsigned* bar; unsigned x;
    volatile LAS unsigned* st;
};
__device__ __forceinline__ XcdBarrier xcd_barrier_post(unsigned* bar, volatile LAS unsigned* st) {
    XcdBarrier b; b.bar = bar; b.x = xb_xcc_id(); b.st = st;
    if (threadIdx.x == 0) (void)xb_add(&bar[XB_XCNT(b.x)], 1u);
    return b;
}
__device__ __forceinline__ void xcd_barrier_complete(unsigned* bar, unsigned x, unsigned& nloc, unsigned& nx) {
    const unsigned G = gridDim.x * gridDim.y * gridDim.z;
    unsigned sum, cnt, mine, sp = 0u;
    for (;;) {
        sum = 0u; cnt = 0u; mine = 0u;
#pragma unroll
        for (unsigned j = 0; j < 16; ++j) { const unsigned c = xb_ld(&bar[XB_XCNT(j)]); sum += c; cnt += (c > 0u) ? 1u : 0u; mine = (j == x) ? c : mine; }
        if (sum == G) break;
        __builtin_amdgcn_s_sleep(1);
        if ((++sp & 255u) == 0u) { if (xb_ld(&bar[XB_TMO])) break; if (sp > XB_SPIN_CAP) { atomicAdd(&bar[XB_TMO], 1u); break; } }
    }
    nloc = mine > 0u ? mine : 1u; nx = cnt > 0u ? cnt : 1u;
}
__device__ __forceinline__ void xcd_barrier(const XcdBarrier& b) {
    asm volatile("s_waitcnt vmcnt(0)" ::: "memory");
    __syncthreads();
    if (threadIdx.x == 0) {
        unsigned* bar = b.bar;
        __builtin_amdgcn_s_waitcnt(0);
        unsigned nloc = b.st[0], nx = b.st[1];
        if (nloc == 0u) { xcd_barrier_complete(bar, b.x, nloc, nx); b.st[0] = nloc; b.st[1] = nx; }
        const unsigned old = xb_add(&bar[XB_XSUB(b.x)], 1u);
        const unsigned gen = old / nloc;
        if (old + 1u == (gen + 1u) * nloc) {
            __builtin_amdgcn_fence(__ATOMIC_RELEASE, "agent");
            asm volatile("s_waitcnt vmcnt(0)" ::: "memory");
            const unsigned og = xb_add(&bar[XB_TOP], 1u);
            const unsigned tg = og / nx;
            if (og + 1u == (tg + 1u) * nx) xb_add(&bar[XB_TOPGEN], 1u);
            else XB_SPIN(xb_ld(&bar[XB_TOPGEN]) == tg, bar);
            __builtin_amdgcn_fence(__ATOMIC_ACQUIRE, "agent");
            xb_add(&bar[XB_XGEN(b.x)], 1u);
            asm volatile("s_waitcnt vmcnt(0)" ::: "memory");
        } else {
            XB_SPIN(xb_ld(&bar[XB_XGEN(b.x)]) == gen, bar);
            __builtin_amdgcn_fence(__ATOMIC_ACQUIRE, "agent");
            asm volatile("s_waitcnt vmcnt(0)" ::: "memory");
        }
    }
    __syncthreads();
}

constexpr int PH_PROLOGUE = 0, PH_PROJ = 1, PH_MIX_A = 2, PH_MIX_B = 3, PH_WOUT = 4, PH_LN1 = 5, PH_ROUTER = 6, PH_SORT = 7, PH_MOE0 = 8, PH_END = PH_MOE0 + 3 * NH;
constexpr int LDS_BYTES = 147456;
static_assert(LDS_TILECACHE + 1152 * 4 <= LDS_BYTES - 16, "LDS map");

constexpr int LDS_BAR_OFF = LDS_BYTES - 16;
#ifndef N_LAUNCHES
#define N_LAUNCHES 1
#endif
__global__ void __launch_bounds__(NTHREADS, 2) fwd(Args a) {
    extern __shared__ __attribute__((aligned(16))) unsigned char lds_raw[];
    LAS unsigned char* lds = (LAS unsigned char*)lds_raw;
    const int bid = blockIdx.x, nb = gridDim.x;
    if (threadIdx.x < 4) ((LAS unsigned*)(lds + LDS_BAR_OFF))[threadIdx.x] = 0u;
    __syncthreads();
    XcdBarrier bar = xcd_barrier_post((unsigned*)(a.ws + WS_CTL), (volatile LAS unsigned*)(lds + LDS_BAR_OFF));
    const int lo = a.ph_lo, hi = a.ph_hi;
#ifndef PHMASK
#define PHMASK 0xffffffffu
#endif
#define IN(k) (((PHMASK >> ((k) < PH_MOE0 ? (k) : 8 + ((k) - PH_MOE0) % 3)) & 1u) && lo <= (k) && (k) < hi)
#define SEAM(k) do { if (lo <= (k) && (k) + 1 < hi) xcd_barrier(bar); } while (0)
#define KA() ({ KArgs kp_ = (KArgs)__builtin_amdgcn_kernarg_segment_ptr(); asm volatile("" : "+s"(kp_)); kp_; })
    if (IN(PH_PROLOGUE)) phase_prologue(KA(), lds, bid, nb);
    SEAM(PH_PROLOGUE);
    if (IN(PH_PROJ)) phase_proj(KA(), lds, bid, nb);
    SEAM(PH_PROJ);
    if (IN(PH_MIX_A)) { phase_segtot(KA(), lds, bid, nb); phase_swa(KA(), lds, bid, nb); }
    SEAM(PH_MIX_A);
    if (IN(PH_MIX_B)) phase_retention(KA(), lds, bid, nb);
    SEAM(PH_MIX_B);
    if (IN(PH_WOUT)) phase_wout(KA(), lds, bid, nb);
    SEAM(PH_WOUT);
    if (IN(PH_LN1)) { KArgs k = KA(); phase_ln<0>(k->out, k->in[I_LN1G], k->in[I_LN1B], (bf16*)(k->ws + WS_XB), k->ws + WS_X1Q, nullptr, bid, nb); }
    SEAM(PH_LN1);
    if (IN(PH_ROUTER)) { phase_router(KA(), lds, bid, nb); __syncthreads(); phase_shared(KA(), lds, bid, nb); }
    SEAM(PH_ROUTER);
    if (IN(PH_SORT)) { phase_sort(KA(), lds, bid, nb); __syncthreads(); phase_base(KA(), lds, bid, nb); }
    SEAM(PH_SORT);
    for (int c = 0; c < NH; ++c) {
        if (IN(PH_MOE0 + 3 * c)) phase_moe_up(KA(), lds, c, bid, nb);
        SEAM(PH_MOE0 + 3 * c);
        if (IN(PH_MOE0 + 3 * c + 1)) phase_moe_down(KA(), lds, c, bid, nb);
        SEAM(PH_MOE0 + 3 * c + 1);
        if (IN(PH_MOE0 + 3 * c + 2)) phase_combine(KA(), c, bid, nb);
        SEAM(PH_MOE0 + 3 * c + 2);
    }
#undef IN
#undef SEAM
}

extern "C" void kernel_launch(void* const* d_in, const int* in_sizes, int n_in, void* d_out, int out_size, void* d_ws, size_t ws_size, hipStream_t stream) {
    static int grid = 0;
    if (grid == 0) {
        if (n_in != 22 || out_size != T * D || ws_size < WS_NEED) { fprintf(stderr, "kernel_launch: unexpected shapes: n_in %d out %d ws %zu (need %zu)\n", n_in, out_size, ws_size, (size_t)WS_NEED); grid = -1; return; }
        int dev = 0, cus = 0;
        (void)hipGetDevice(&dev); (void)hipDeviceGetAttribute(&cus, hipDeviceAttributeMultiprocessorCount, dev);
        if (hipFuncSetAttribute((const void*)fwd, hipFuncAttributeMaxDynamicSharedMemorySize, LDS_BYTES) != hipSuccess) { fprintf(stderr, "hipFuncSetAttribute failed\n"); grid = -1; return; }
        int per_cu = 0;
        if (hipOccupancyMaxActiveBlocksPerMultiprocessor(&per_cu, (const void*)fwd, NTHREADS, LDS_BYTES) != hipSuccess || per_cu < 1) { fprintf(stderr, "occupancy query: %d blocks per CU\n", per_cu); grid = -1; return; }
        (void)hipGetLastError();
        grid = cus > 0 ? cus : 256;
    }
    if (grid < 0) return;
    (void)hipMemsetAsync((char*)d_ws + WS_CTL, 0, 16384, stream);
    Args a{};
    for (int i = 0; i < 22; ++i) a.in[i] = (const float*)d_in[i];
    a.out = (float*)d_out; a.ws = (unsigned char*)d_ws;
#if N_LAUNCHES == 1
    a.ph_lo = 0; a.ph_hi = PH_END;
    hipLaunchKernelGGL(fwd, dim3(grid), dim3(NTHREADS), LDS_BYTES, stream, a);
#else
    for (int ph = 0; ph < PH_END; ++ph) {
        a.ph_lo = ph; a.ph_hi = ph + 1;
        hipLaunchKernelGGL(fwd, dim3(grid), dim3(NTHREADS), LDS_BYTES, stream, a);
    }
#endif
}
```
